# Optimizing an MI355X kernel written in HIP

```python
import jax, jax.numpy as jnp
from jax import lax
import numpy as np

D_MODEL = 1024
BATCH = 2
SEQ = 8192
DEPTH = 1
DEC_BATCH = 128
DEC_SEQ = 1
PAST_LEN = 2048
PAGE_SIZE = 128

N_HEADS = 8
KV_HEADS = 2
HEADS_PER_GROUP = N_HEADS // KV_HEADS
HEAD_DIM = 64
ROPE_DIM = HEAD_DIM // 4
ROPE_THETA = 500000.0
CMP_BLOCK = 32
CMP_STRIDE = 16
CMP_HIDDEN = 256
SEL_BLOCK = 64
N_SEL = 16
WINDOW = 512
Q_BLOCK = 128
FORCED_SCORE = 1e6
CONV_WIDTH = D_MODEL // 2
CONV_K = 3
ATTN_WIDTH = N_HEADS * HEAD_DIM
KV_WIDTH = KV_HEADS * HEAD_DIM
N_BRANCH = 2
SPLIT_SIZES = (ATTN_WIDTH, 6 * KV_WIDTH, 3 * N_HEADS, ATTN_WIDTH, 3 * CONV_WIDTH, CONV_WIDTH, N_BRANCH * D_MODEL)
IN_WIDTH = sum(SPLIT_SIZES)
RMS_EPS = 1e-6

kernel_name = "nsa_shortconv_gated_hybrid_step"


def rmsnorm(x, g):
    x32 = x.astype(jnp.float32)
    y = x32 * lax.rsqrt(jnp.mean(x32 * x32, axis=-1, keepdims=True) + RMS_EPS)
    return (y * g.astype(jnp.float32)).astype(x.dtype)


def rope(x, pos):
    half = ROPE_DIM // 2
    inv = ROPE_THETA ** (-jnp.arange(half, dtype=jnp.float32) / half)
    ang = pos.astype(jnp.float32)[:, None] * inv[None, :]
    cos = jnp.cos(ang)[None, :, None, :]
    sin = jnp.sin(ang)[None, :, None, :]
    xr = x[..., :ROPE_DIM].astype(jnp.float32)
    x1, x2 = xr[..., :half], xr[..., half:]
    rot = jnp.concatenate([x1 * cos - x2 * sin, x1 * sin + x2 * cos], axis=-1).astype(x.dtype)
    return jnp.concatenate([rot, x[..., ROPE_DIM:]], axis=-1)


def masked_softmax(s, mask):
    s = jnp.where(mask, s, -jnp.inf)
    m = jnp.max(s, axis=-1, keepdims=True)
    m = jnp.where(jnp.isfinite(m), m, 0.0)
    e = jnp.exp(s - m)
    return e / jnp.maximum(jnp.sum(e, axis=-1, keepdims=True), 1e-30)


def compress(k, pe, w1, w2):
    B, T, G, hd = k.shape
    r = CMP_BLOCK // CMP_STRIDE
    n_chunk = T // CMP_STRIDE
    n_cmp = n_chunk - r + 1
    kc = k[:, :n_chunk * CMP_STRIDE].reshape(B, n_chunk, CMP_STRIDE, G, hd)
    blocks = jnp.concatenate([kc[:, i:i + n_cmp] for i in range(r)], axis=2)
    blocks = blocks + pe[None, None, :, None, :].astype(k.dtype)
    flat = jnp.transpose(blocks, (0, 1, 3, 2, 4)).reshape(B, n_cmp, G, CMP_BLOCK * hd)
    return jax.nn.silu(flat @ w1) @ w2


def cmp_sel_overlap(n_cmp, n_selb):
    cs = jnp.arange(n_cmp) * CMP_STRIDE
    ss = jnp.arange(n_selb) * SEL_BLOCK
    ov = (cs[:, None] < ss[None, :] + SEL_BLOCK) & (cs[:, None] + CMP_BLOCK > ss[None, :])
    return ov.astype(jnp.float32)


def sel_blocks(k):
    B, T, G, hd = k.shape
    n_selb = -(-T // SEL_BLOCK)
    k = jnp.pad(k, ((0, 0), (0, n_selb * SEL_BLOCK - T), (0, 0), (0, 0)))
    return jnp.transpose(k.reshape(B, n_selb, SEL_BLOCK, G, hd), (0, 3, 1, 2, 4))


def gather_blocks(blocks, idx):
    return jax.vmap(jax.vmap(lambda blk, ix: blk[ix]))(blocks, idx)


def nsa_attend(q, gates, qpos, kc, vc, ksb, vsb, ovl, kw, vw, kwpos):
    f32 = jnp.float32
    scale = HEAD_DIM ** -0.5
    n_cmp = kc.shape[1]
    s = jnp.einsum('bqghd,bcgd->bghqc', q, kc, preferred_element_type=f32) * scale
    c_end = jnp.arange(n_cmp) * CMP_STRIDE + (CMP_BLOCK - 1)
    p_cmp = masked_softmax(s, c_end[None, :] <= qpos[:, None])
    o_cmp = jnp.einsum('bghqc,bcgd->bqghd', p_cmp.astype(vc.dtype), vc)
    n_selb = ksb.shape[2]
    imp = jnp.einsum('bghqc,cj->bgqj', p_cmp, ovl)
    j = jnp.arange(n_selb)[None, :]
    cur = (qpos // SEL_BLOCK)[:, None]
    forced = (j == 0) | (j == cur) | (j == cur - 1)
    valid = j <= cur
    score = jnp.where(forced, FORCED_SCORE, jnp.where(valid, imp, -1.0))
    _, idx = lax.top_k(score, min(N_SEL, n_selb))
    B, G, Tq, kk = idx.shape
    kg = gather_blocks(ksb, idx).reshape(B, G, Tq, kk * SEL_BLOCK, HEAD_DIM)
    vg = gather_blocks(vsb, idx).reshape(B, G, Tq, kk * SEL_BLOCK, HEAD_DIM)
    kpos = (idx[..., None] * SEL_BLOCK + jnp.arange(SEL_BLOCK)).reshape(B, G, Tq, kk * SEL_BLOCK)
    s = jnp.einsum('bqghd,bgqsd->bghqs', q, kg, preferred_element_type=f32) * scale
    p = masked_softmax(s, (kpos <= qpos[:, None])[:, :, None])
    o_sel = jnp.einsum('bghqs,bgqsd->bqghd', p.astype(vg.dtype), vg)
    s = jnp.einsum('bqghd,bsgd->bghqs', q, kw, preferred_element_type=f32) * scale
    dt = qpos[:, None] - kwpos[None, :]
    p = masked_softmax(s, (dt >= 0) & (dt < WINDOW) & (kwpos >= 0)[None, :])
    o_win = jnp.einsum('bghqs,bsgd->bqghd', p.astype(vw.dtype), vw)
    return gates[..., 0:1] * o_cmp + gates[..., 1:2] * o_sel + gates[..., 2:3] * o_win


def project(x, c, pos, p):
    B, T, _ = x.shape
    mod = jax.nn.silu(c) @ p['w_ada'] + p['b_ada']
    shift, scale, gate = jnp.split(mod[:, None, :], 3, axis=-1)
    h = rmsnorm(x, p['g_pre']) * (1 + scale) + shift
    z = h @ p['w_in']
    zq, zkv, zg, za, zconv, zcg, zm = jnp.split(z, np.cumsum(SPLIT_SIZES)[:-1].tolist(), axis=-1)
    q = rope(zq.reshape(B, T, N_HEADS, HEAD_DIM), pos).reshape(B, T, KV_HEADS, HEADS_PER_GROUP, HEAD_DIM)
    kv = zkv.reshape(B, T, 6, KV_HEADS, HEAD_DIM)
    kv = jnp.stack([rope(kv[:, :, i], pos) if i % 2 == 0 else kv[:, :, i] for i in range(6)], axis=2)
    nsa_g = jax.nn.sigmoid(zg).reshape(B, T, KV_HEADS, HEADS_PER_GROUP, 3)
    cb, cc, cx = jnp.split(zconv, 3, axis=-1)
    return dict(q=q, kv=kv, nsa_g=nsa_g, a_gate=za, cb=cb, u=cc * cx, cgate=zcg, merge=zm, gate=gate)


def causal_conv(up, w):
    T = up.shape[1] - (CONV_K - 1)
    out = w[0] * up[:, 0:T]
    for j in range(1, CONV_K):
        out = out + w[j] * up[:, j:j + T]
    return out


def finish(x, o_attn, conv_out, pr, p):
    ya = (o_attn * jax.nn.silu(pr['a_gate'])) @ p['w_br_a']
    yb = (pr['cb'] * conv_out * jax.nn.silu(pr['cgate'])) @ p['w_br_b']
    ga, gb = jnp.split(jax.nn.sigmoid(pr['merge']), 2, axis=-1)
    o = (ga * ya + gb * yb) @ p['w_out']
    return x + pr['gate'] * rmsnorm(o, p['g_post'])


def prompt_layer(x, c, p):
    B, T, _ = x.shape
    pr = project(x, c, jnp.arange(T), p)
    kv = pr['kv']
    kc = compress(kv[:, :, 0], p['pe_cmp'][0], p['w_cmp1'][0], p['w_cmp2'][0])
    vc = compress(kv[:, :, 1], p['pe_cmp'][1], p['w_cmp1'][1], p['w_cmp2'][1])
    ksb = sel_blocks(kv[:, :, 2])
    vsb = sel_blocks(kv[:, :, 3])
    ovl = cmp_sel_overlap(kc.shape[1], ksb.shape[2])
    kwp = jnp.pad(kv[:, :, 4:6], ((0, 0), (WINDOW, 0), (0, 0), (0, 0), (0, 0)))
    n_qb = T // Q_BLOCK
    qb = jnp.moveaxis(pr['q'].reshape(B, n_qb, Q_BLOCK, KV_HEADS, HEADS_PER_GROUP, HEAD_DIM), 1, 0)
    gb = jnp.moveaxis(pr['nsa_g'].reshape(B, n_qb, Q_BLOCK, KV_HEADS, HEADS_PER_GROUP, 3), 1, 0)

    def body(args):
        q_blk, g_blk, b = args
        qpos = b * Q_BLOCK + jnp.arange(Q_BLOCK)
        kw = lax.dynamic_slice_in_dim(kwp, b * Q_BLOCK, WINDOW + Q_BLOCK, axis=1)
        kwpos = b * Q_BLOCK - WINDOW + jnp.arange(WINDOW + Q_BLOCK)
        return nsa_attend(q_blk, g_blk, qpos, kc, vc, ksb, vsb, ovl, kw[:, :, 0], kw[:, :, 1], kwpos)

    o = lax.map(body, (qb, gb, jnp.arange(n_qb)))
    o = jnp.moveaxis(o, 0, 1).reshape(B, T, ATTN_WIDTH)
    up = jnp.pad(pr['u'], ((0, 0), (CONV_K - 1, 0), (0, 0)))
    y = finish(x, o, causal_conv(up, p['conv_w']), pr, p)
    return y, kv[:, :, :4], kv[:, T - min(WINDOW, T):, 4:6], up[:, -(CONV_K - 1):]


def sample_layer(x, c, cache_pages, page_table, win_buf, conv_buf, p):
    B, T, _ = x.shape
    past_len = page_table.shape[1] * cache_pages.shape[1]
    pos = past_len + jnp.arange(T)
    pr = project(x, c, pos, p)
    kv = pr['kv']
    past = cache_pages[page_table].reshape(B, past_len, 4, KV_HEADS, HEAD_DIM)
    full = jnp.concatenate([past, kv[:, :, :4]], axis=1)
    kc = compress(full[:, :, 0], p['pe_cmp'][0], p['w_cmp1'][0], p['w_cmp2'][0])
    vc = compress(full[:, :, 1], p['pe_cmp'][1], p['w_cmp1'][1], p['w_cmp2'][1])
    ksb = sel_blocks(full[:, :, 2])
    vsb = sel_blocks(full[:, :, 3])
    ovl = cmp_sel_overlap(kc.shape[1], ksb.shape[2])
    wbuf = win_buf.shape[1]
    wk = jnp.concatenate([win_buf, kv[:, :, 4:6]], axis=1)
    kwpos = past_len - wbuf + jnp.arange(wbuf + T)
    o = nsa_attend(pr['q'], pr['nsa_g'], pos, kc, vc, ksb, vsb, ovl, wk[:, :, 0], wk[:, :, 1], kwpos)
    o = o.reshape(B, T, ATTN_WIDTH)
    up = jnp.concatenate([conv_buf, pr['u']], axis=1)
    y = finish(x, o, causal_conv(up, p['conv_w']), pr, p)
    n_keep = min(WINDOW, wbuf + T)
    return y, kv[:, :, :4], wk[:, wbuf + T - n_keep:], up[:, -(CONV_K - 1):]


def setup_inputs(seed: int = 0) -> dict:
    key = jax.random.key(seed)
    ks = jax.random.split(key, 24)
    n_pages = PAST_LEN // PAGE_SIZE
    n_phys = (5 * DEC_BATCH * n_pages) // 4
    wbuf = min(WINDOW, PAST_LEN)
    f32 = jnp.float32

    def nrm(k, shape, s):
        return jax.random.normal(k, shape, f32) * s

    page_table = jax.random.permutation(ks[0], n_phys)[:DEC_BATCH * n_pages].reshape(DEC_BATCH, n_pages).astype(jnp.int32)
    return {
        "x_prompt": nrm(ks[1], (BATCH, SEQ, D_MODEL), 1.0),
        "x_sample": nrm(ks[2], (DEC_BATCH, DEC_SEQ, D_MODEL), 1.0),
        "cache_kv_pages": nrm(ks[3], (DEPTH, n_phys, PAGE_SIZE, 4, KV_HEADS, HEAD_DIM), 1.0),
        "state_win_kv": nrm(ks[4], (DEPTH, DEC_BATCH, wbuf, 2, KV_HEADS, HEAD_DIM), 1.0),
        "state_conv": nrm(ks[5], (DEPTH, DEC_BATCH, CONV_K - 1, CONV_WIDTH), 1.0),
        "page_table": page_table,
        "c_prompt": nrm(ks[6], (BATCH, D_MODEL), 1.0),
        "c_sample": nrm(ks[7], (DEC_BATCH, D_MODEL), 1.0),
        "w_ada": nrm(ks[8], (DEPTH, D_MODEL, 3 * D_MODEL), 0.5 * D_MODEL ** -0.5),
        "b_ada": nrm(ks[9], (DEPTH, 3 * D_MODEL), 0.01),
        "g_pre": 1.0 + nrm(ks[10], (DEPTH, D_MODEL), 0.02),
        "g_post": 1.0 + nrm(ks[11], (DEPTH, D_MODEL), 0.02),
        "w_in": nrm(ks[12], (DEPTH, D_MODEL, IN_WIDTH), D_MODEL ** -0.5),
        "pe_cmp": nrm(ks[13], (DEPTH, 2, CMP_BLOCK, HEAD_DIM), 0.02),
        "w_cmp1": nrm(ks[14], (DEPTH, 2, CMP_BLOCK * HEAD_DIM, CMP_HIDDEN), (CMP_BLOCK * HEAD_DIM) ** -0.5),
        "w_cmp2": nrm(ks[15], (DEPTH, 2, CMP_HIDDEN, HEAD_DIM), CMP_HIDDEN ** -0.5),
        "conv_w": nrm(ks[16], (DEPTH, CONV_K, CONV_WIDTH), CONV_K ** -0.5),
        "w_br_a": nrm(ks[17], (DEPTH, ATTN_WIDTH, D_MODEL), ATTN_WIDTH ** -0.5),
        "w_br_b": nrm(ks[18], (DEPTH, CONV_WIDTH, D_MODEL), CONV_WIDTH ** -0.5),
        "w_out": nrm(ks[19], (DEPTH, D_MODEL, D_MODEL), D_MODEL ** -0.5),
    }


def reference(x_prompt, x_sample, cache_kv_pages, state_win_kv, state_conv, page_table, c_prompt, c_sample,
              w_ada, b_ada, g_pre, g_post, w_in, pe_cmp, w_cmp1, w_cmp2, conv_w, w_br_a, w_br_b, w_out):
    hp, hs = x_prompt, x_sample
    kvp_l, wp_l, cp_l, kvs_l, ws_l, cs_l = [], [], [], [], [], []
    for l in range(DEPTH):
        p = dict(w_ada=w_ada[l], b_ada=b_ada[l], g_pre=g_pre[l], g_post=g_post[l], w_in=w_in[l],
                 pe_cmp=pe_cmp[l], w_cmp1=w_cmp1[l], w_cmp2=w_cmp2[l], conv_w=conv_w[l],
                 w_br_a=w_br_a[l], w_br_b=w_br_b[l], w_out=w_out[l])
        hp, kvp, wp, cp = prompt_layer(hp, c_prompt, p)
        hs, kvs, ws, cs = sample_layer(hs, c_sample, cache_kv_pages[l], page_table, state_win_kv[l], state_conv[l], p)
        kvp_l.append(kvp); wp_l.append(wp); cp_l.append(cp)
        kvs_l.append(kvs); ws_l.append(ws); cs_l.append(cs)
    kv_rows_prompt = jnp.stack(kvp_l)
    win_kv_prompt = jnp.stack(wp_l)
    conv_state_prompt = jnp.stack(cp_l)
    kv_rows_sample = jnp.stack(kvs_l)
    win_kv_sample = jnp.stack(ws_l)
    conv_state_sample = jnp.stack(cs_l)
    return (hp, hs, kv_rows_prompt, win_kv_prompt, conv_state_prompt, kv_rows_sample, win_kv_sample, conv_state_sample)
```

```cpp
#include <hip/hip_runtime.h>
#include <cstdio>
#include <cstdint>
#include <cmath>
namespace orc {
constexpr int DM = 1024, TB = 2, TS = 8192, SB = 128, PAST = 2048, NH = 8, G = 2, HPG = 4, HD = 64;
constexpr int INW = 5912, MP = TB * TS, MALL = MP + SB;
constexpr int C_Q = 0, C_KV = 512, C_G = 1280, C_A = 1304, C_CB = 1816, C_CC = 2328, C_CX = 2840, C_CG = 3352, C_GA = 3864, C_GB = 4888;
constexpr size_t O_YP = 0, O_YS = 16777216, O_KVP = 16908288, O_WINP = 25296896, O_CSP = 25559040, O_KVS = 25561088, O_WINS = 25626624, O_CSS = 42403840;

__device__ __forceinline__ float silu_f(float x) { return x / (1.f + expf(-x)); }
__device__ __forceinline__ float sigm_f(float x) { return 1.f / (1.f + expf(-x)); }

template <int AMODE  , int EMODE  >
__global__ void __launch_bounds__(256) sgemm(const float* __restrict__ A, size_t lda, const float* __restrict__ B, size_t ldb, float* __restrict__ C, size_t ldc,
                                             int M, int N, int K, const float* __restrict__ avec, const float* __restrict__ bias) {
    __shared__ float As[16][65], Bs[16][65];
    const int tx = threadIdx.x & 15, ty = threadIdx.x >> 4, m0 = blockIdx.y * 64, n0 = blockIdx.x * 64;
    float acc[4][4] = {};
    for (int k0 = 0; k0 < K; k0 += 16) {
        for (int i = threadIdx.x; i < 64 * 16; i += 256) { const int m = i >> 4, k = i & 15; float v = 0.f;
            if (m0 + m < M && k0 + k < K) { v = A[(size_t)(m0 + m) * lda + k0 + k]; if (AMODE == 1) v = silu_f(v); if (AMODE == 2) v += avec[k0 + k]; }
            As[k][m] = v; }
        for (int i = threadIdx.x; i < 64 * 16; i += 256) { const int k = i >> 6, n = i & 63; float v = 0.f;
            if (n0 + n < N && k0 + k < K) v = B[(size_t)(k0 + k) * ldb + n0 + n];
            Bs[k][n] = v; }
        __syncthreads();
#pragma unroll
        for (int k = 0; k < 16; ++k) { float a[4], b[4];
#pragma unroll
            for (int i = 0; i < 4; ++i) { a[i] = As[k][ty * 4 + i]; b[i] = Bs[k][tx * 4 + i]; }
#pragma unroll
            for (int i = 0; i < 4; ++i)
#pragma unroll
                for (int j = 0; j < 4; ++j) acc[i][j] += a[i] * b[j]; }
        __syncthreads();
    }
    for (int i = 0; i < 4; ++i) for (int j = 0; j < 4; ++j) { const int m = m0 + ty * 4 + i, n = n0 + tx * 4 + j;
        if (m < M && n < N) { float v = acc[i][j] + (bias ? bias[n] : 0.f); if (EMODE == 1) v = silu_f(v); C[(size_t)m * ldc + n] = v; } }
}
template <int AMODE, int EMODE>
static void gemm(hipStream_t s, const float* A, size_t lda, const float* B, size_t ldb, float* C, size_t ldc, int M, int N, int K, const float* avec, const float* bias) {
    dim3 grid((N + 63) / 64, (M + 63) / 64);
    sgemm<AMODE, EMODE><<<grid, 256, 0, s>>>(A, lda, B, ldb, C, ldc, M, N, K, avec, bias);
}

__global__ void __launch_bounds__(256) k_h(const float* xp, const float* xs, const float* mod, const float* g_pre, float* h) {
    const int row = blockIdx.x; const float* x = row < MP ? xp + (size_t)row * DM : xs + (size_t)(row - MP) * DM;
    const int mrow = row < MP ? (row >> 13) : 2 + (row - MP);
    __shared__ float red[256];
    float s = 0.f; for (int k = threadIdx.x; k < DM; k += 256) s += x[k] * x[k];
    red[threadIdx.x] = s; __syncthreads();
    for (int o = 128; o > 0; o >>= 1) { if (threadIdx.x < o) red[threadIdx.x] += red[threadIdx.x + o]; __syncthreads(); }
    const float rs = rsqrtf(red[0] / DM + 1e-6f);
    const float* md = mod + (size_t)mrow * 3072;
    for (int k = threadIdx.x; k < DM; k += 256) h[(size_t)row * DM + k] = x[k] * rs * g_pre[k] * (1.f + md[1024 + k]) + md[k];
}
__global__ void k_rope(float* z) {
    const int idx = blockIdx.x * blockDim.x + threadIdx.x; if (idx >= MALL * 14 * 8) return;
    const int i = idx & 7, hs = (idx >> 3) % 14, row = idx / (14 * 8);
    const int pos = row < MP ? (row & (TS - 1)) : PAST;
    int col; if (hs < 8) col = C_Q + hs * 64; else { const int kk = (hs - 8) >> 1, g = (hs - 8) & 1; col = C_KV + (2 * kk) * 128 + g * 64; }
    const float inv = powf(500000.0f, -(float)i / 8.0f); const float ang = (float)pos * inv;
    const float c = cosf(ang), s = sinf(ang);
    float* p = z + (size_t)row * INW + col; const float x1 = p[i], x2 = p[i + 8];
    p[i] = x1 * c - x2 * s; p[i + 8] = x1 * s + x2 * c;
}
__global__ void k_outs(const float* z, const float* state_win, const float* state_conv, float* out) {
    const size_t idx = (size_t)blockIdx.x * blockDim.x + threadIdx.x;
    if (idx < (size_t)MP * 512) { const int row = idx / 512, c = idx % 512; out[O_KVP + idx] = z[(size_t)row * INW + C_KV + c]; }
    if (idx < (size_t)TB * 512 * 256) { const int b = idx / (512 * 256), j = (idx / 256) % 512, c = idx % 256; out[O_WINP + idx] = z[(size_t)(b * TS + TS - 512 + j) * INW + C_KV + 512 + c]; }
    if (idx < (size_t)TB * 2 * 512) { const int b = idx / 1024, j = (idx / 512) % 2, c = idx % 512; const size_t r = (size_t)(b * TS + TS - 2 + j) * INW; out[O_CSP + idx] = z[r + C_CC + c] * z[r + C_CX + c]; }
    if (idx < (size_t)SB * 512) { const int bs = idx / 512, c = idx % 512; out[O_KVS + idx] = z[(size_t)(MP + bs) * INW + C_KV + c]; }
    if (idx < (size_t)SB * 512 * 256) { const int bs = idx / (512 * 256), j = (idx / 256) % 512, c = idx % 256;
        out[O_WINS + idx] = j < 511 ? state_win[((size_t)bs * 512 + j + 1) * 256 + c] : z[(size_t)(MP + bs) * INW + C_KV + 512 + c]; }
    if (idx < (size_t)SB * 2 * 512) { const int bs = idx / 1024, j = (idx / 512) % 2, c = idx % 512; const size_t r = (size_t)(MP + bs) * INW;
        out[O_CSS + idx] = j == 0 ? state_conv[((size_t)bs * 2 + 1) * 512 + c] : z[r + C_CC + c] * z[r + C_CX + c]; }
}
__global__ void k_streams(const float* z, const float* cache, const int* page_table, float* PS, float* SS) {
    const size_t idx = (size_t)blockIdx.x * blockDim.x + threadIdx.x;
    if (idx < (size_t)2 * TB * G * TS * 64) { const int d = idx & 63; const int t = (idx >> 6) % TS; const int g = (idx / (64 * TS)) % G; const int b = (idx / ((size_t)64 * TS * G)) % TB; const int kind = idx / ((size_t)64 * TS * G * TB);
        PS[idx] = z[(size_t)(b * TS + t) * INW + C_KV + kind * 128 + g * 64 + d]; }
    if (idx < (size_t)2 * SB * G * PAST * 64) { const int d = idx & 63; const int t = (idx >> 6) % PAST; const int g = (idx / (64 * PAST)) % G; const int bs = (idx / ((size_t)64 * PAST * G)) % SB; const int kind = idx / ((size_t)64 * PAST * G * SB);
        const int phys = page_table[bs * 16 + (t >> 7)];
        SS[idx] = cache[(((size_t)phys * 128 + (t & 127)) * 4 + kind) * 128 + g * 64 + d]; }
}
struct AttnSrc { const float* z; const float* kc_p; const float* vc_p; const float* kc_s; const float* vc_s; const float* cache; const int* page_table; const float* out; const float* ng; };
__global__ void __launch_bounds__(64) k_attn(AttnSrc S, float* oattn) {
    const int row = blockIdx.x >> 1, g = blockIdx.x & 1, lane = threadIdx.x;
    const bool samp = row >= MP; const int b = samp ? row - MP : row >> 13; const int t = samp ? PAST : (row & (TS - 1));
    __shared__ float q[4][64], sc[4][1040], imp[128], red[64], osum[4][64]; __shared__ int sel[16];
    for (int i = lane; i < 256; i += 64) q[i >> 6][i & 63] = S.z[(size_t)row * INW + C_Q + (g * 4 + (i >> 6)) * 64 + (i & 63)];
    for (int i = lane; i < 256; i += 64) osum[i >> 6][i & 63] = 0.f;
    __syncthreads();
    const float scale = 0.125f;
    float gate[4][3];
    for (int h = 0; h < 4; ++h) for (int i = 0; i < 3; ++i) gate[h][i] = sigm_f(S.z[(size_t)row * INW + C_G + g * 12 + h * 3 + i]);
    auto softmax_rows = [&](int n) {
        for (int h = 0; h < 4; ++h) {
            float m = -INFINITY; for (int i = lane; i < n; i += 64) m = fmaxf(m, sc[h][i]);
            red[lane] = m; __syncthreads(); for (int o = 32; o > 0; o >>= 1) { if (lane < o) red[lane] = fmaxf(red[lane], red[lane + o]); __syncthreads(); }
            m = red[0]; __syncthreads(); if (!(m > -INFINITY)) m = 0.f;
            float s = 0.f; for (int i = lane; i < n; i += 64) { const float e = expf(sc[h][i] - m); sc[h][i] = e; s += e; }
            red[lane] = s; __syncthreads(); for (int o = 32; o > 0; o >>= 1) { if (lane < o) red[lane] += red[lane + o]; __syncthreads(); }
            s = fmaxf(red[0], 1e-30f); __syncthreads();
            for (int i = lane; i < n; i += 64) sc[h][i] /= s;
            __syncthreads();
        }
    };
    const int ncmp = samp ? 127 : 511; const int nselb = samp ? 33 : 128;
    const float* kc = samp ? S.kc_s + (size_t)(b * 2 + g) * 128 * 64 : S.kc_p + (size_t)(b * 2 + g) * 512 * 64;
    const float* vc = samp ? S.vc_s + (size_t)(b * 2 + g) * 128 * 64 : S.vc_p + (size_t)(b * 2 + g) * 512 * 64;
    for (int c = lane; c < ncmp; c += 64) { const bool ok = (16 * c + 31) <= t;
        for (int h = 0; h < 4; ++h) { float s = 0.f; for (int d = 0; d < 64; ++d) s += q[h][d] * kc[c * 64 + d]; sc[h][c] = ok ? s * scale : -INFINITY; } }
    __syncthreads(); softmax_rows(ncmp);
    for (int h = 0; h < 4; ++h) { float o = 0.f; for (int c = 0; c < ncmp; ++c) o += sc[h][c] * vc[c * 64 + lane]; osum[h][lane] += gate[h][0] * o; }
    for (int j = lane; j < nselb; j += 64) { float s = 0.f; for (int c = 4 * j - 1; c <= 4 * j + 3; ++c) if (c >= 0 && c < ncmp) for (int h = 0; h < 4; ++h) s += sc[h][c];
        const int cur = t >> 6; const bool forced = (j == 0) || (j == cur) || (j == cur - 1); imp[j] = forced ? 1e6f : (j <= cur ? s : -1.f); }
    __syncthreads();
    const int kk = nselb < 16 ? nselb : 16;
    if (lane == 0) { for (int r = 0; r < kk; ++r) { int best = -1; float bv = -INFINITY; for (int j = 0; j < nselb; ++j) if (imp[j] > bv) { bv = imp[j]; best = j; } sel[r] = best; imp[best] = -INFINITY; } }
    __syncthreads();
    auto ksel_ptr = [&](int pos, int which  ) -> const float* {
        if (!samp) return S.z + (size_t)(b * TS + pos) * INW + C_KV + which * 128 + g * 64;
        if (pos < PAST) { const int phys = S.page_table[b * 16 + (pos >> 7)]; return S.cache + (((size_t)phys * 128 + (pos & 127)) * 4 + which) * 128 + g * 64; }
        return S.z + (size_t)row * INW + C_KV + which * 128 + g * 64; };
    const int tmax = samp ? PAST : TS - 1;
    for (int r = 0; r < kk; ++r) { const int pos = sel[r] * 64 + lane; const bool ok = pos <= t && pos <= tmax;
        for (int h = 0; h < 4; ++h) { float s = 0.f; if (ok) { const float* kp = ksel_ptr(pos, 2); for (int d = 0; d < 64; ++d) s += q[h][d] * kp[d]; } sc[h][r * 64 + lane] = ok ? s * scale : -INFINITY; } }
    __syncthreads(); softmax_rows(kk * 64);
    for (int h = 0; h < 4; ++h) { float o = 0.f; for (int r = 0; r < kk; ++r) for (int i = 0; i < 64; ++i) { const int pos = sel[r] * 64 + i; if (pos <= t && pos <= tmax) o += sc[h][r * 64 + i] * ksel_ptr(pos, 3)[lane]; } osum[h][lane] += gate[h][1] * o; }
    __syncthreads();
    for (int i = lane; i < 512; i += 64) { const int pos = t - 511 + i; const bool ok = pos >= 0;
        for (int h = 0; h < 4; ++h) { float s = 0.f; if (ok) { const float* kp = samp ? S.out + O_WINS + ((size_t)(b * 512 + i) * 2 + 0) * 128 + g * 64 : S.z + (size_t)(b * TS + pos) * INW + C_KV + 4 * 128 + g * 64;
                for (int d = 0; d < 64; ++d) s += q[h][d] * kp[d]; } sc[h][i] = ok ? s * scale : -INFINITY; } }
    __syncthreads(); softmax_rows(512);
    for (int h = 0; h < 4; ++h) { float o = 0.f; for (int i = 0; i < 512; ++i) { const int pos = t - 511 + i; if (pos >= 0) { const float* vp = samp ? S.out + O_WINS + ((size_t)(b * 512 + i) * 2 + 1) * 128 + g * 64 : S.z + (size_t)(b * TS + pos) * INW + C_KV + 5 * 128 + g * 64; o += sc[h][i] * vp[lane]; } } osum[h][lane] += gate[h][2] * o; }
    for (int h = 0; h < 4; ++h) oattn[(size_t)row * 512 + (g * 4 + h) * 64 + lane] = osum[h][lane];
}
__global__ void k_prep(const float* z, const float* oattn, const float* conv_w, const float* state_conv, float* pa, float* pb) {
    const size_t idx = (size_t)blockIdx.x * blockDim.x + threadIdx.x; if (idx >= (size_t)MALL * 512) return;
    const int row = idx / 512, c = idx % 512; const float* zr = z + (size_t)row * INW;
    pa[idx] = oattn[idx] * silu_f(zr[C_A + c]);
    float u0, u1, u2 = zr[C_CC + c] * zr[C_CX + c];
    if (row < MP) { const int t = row & (TS - 1); const float* z1 = zr - INW; const float* z2 = zr - 2 * (size_t)INW;
        u1 = t >= 1 ? z1[C_CC + c] * z1[C_CX + c] : 0.f; u0 = t >= 2 ? z2[C_CC + c] * z2[C_CX + c] : 0.f; }
    else { const int bs = row - MP; u0 = state_conv[((size_t)bs * 2 + 0) * 512 + c]; u1 = state_conv[((size_t)bs * 2 + 1) * 512 + c]; }
    const float conv = conv_w[c] * u0 + conv_w[512 + c] * u1 + conv_w[1024 + c] * u2;
    pb[idx] = zr[C_CB + c] * conv * silu_f(zr[C_CG + c]);
}
__global__ void k_merge(const float* z, const float* ya, const float* yb, float* om) {
    const size_t idx = (size_t)blockIdx.x * blockDim.x + threadIdx.x; if (idx >= (size_t)MALL * 1024) return;
    const int row = idx / 1024, c = idx % 1024; const float* zr = z + (size_t)row * INW;
    om[idx] = sigm_f(zr[C_GA + c]) * ya[idx] + sigm_f(zr[C_GB + c]) * yb[idx];
}
__global__ void __launch_bounds__(256) k_final(const float* xp, const float* xs, const float* mod, const float* g_post, const float* o, float* out) {
    const int row = blockIdx.x; const float* x = row < MP ? xp + (size_t)row * DM : xs + (size_t)(row - MP) * DM;
    const int mrow = row < MP ? (row >> 13) : 2 + (row - MP);
    float* y = row < MP ? out + O_YP + (size_t)row * DM : out + O_YS + (size_t)(row - MP) * DM;
    __shared__ float red[256]; const float* orow = o + (size_t)row * DM;
    float s = 0.f; for (int k = threadIdx.x; k < DM; k += 256) s += orow[k] * orow[k];
    red[threadIdx.x] = s; __syncthreads();
    for (int of = 128; of > 0; of >>= 1) { if (threadIdx.x < of) red[threadIdx.x] += red[threadIdx.x + of]; __syncthreads(); }
    const float rs = rsqrtf(red[0] / DM + 1e-6f); const float* md = mod + (size_t)mrow * 3072 + 2048;
    for (int k = threadIdx.x; k < DM; k += 256) y[k] = x[k] + md[k] * orow[k] * rs * g_post[k];
}
struct Bufs { float *mod, *c_all, *h, *z, *PS, *SS, *hid, *kc_p, *vc_p, *kc_s, *vc_s, *oattn, *pa, *pb, *ya, *yb, *om, *o; };
static Bufs carve(unsigned char* base) {
    Bufs b; size_t off = 0; auto take = [&](size_t nfloat) { float* p = (float*)(base + off); off += ((nfloat * 4 + 255) / 256) * 256; return p; };
    b.mod = take(130 * 3072); b.c_all = take(130 * 1024); b.h = take((size_t)MALL * DM); b.z = take((size_t)MALL * INW + 64);
    b.PS = take((size_t)2 * TB * G * TS * 64 + 4096); b.SS = take((size_t)2 * SB * G * PAST * 64 + 4096); b.hid = take((size_t)(SB * G * 128) * 256);
    b.kc_p = take(TB * G * 512 * 64); b.vc_p = take(TB * G * 512 * 64); b.kc_s = take(SB * G * 128 * 64); b.vc_s = take(SB * G * 128 * 64);
    b.oattn = take((size_t)MALL * 512); b.pa = take((size_t)MALL * 512); b.pb = take((size_t)MALL * 512); b.ya = take((size_t)MALL * 1024); b.yb = take((size_t)MALL * 1024);
    b.om = take((size_t)MALL * 1024); b.o = take((size_t)MALL * 1024);
    return b;
}
static Bufs run(void* const* d_in, float* out, unsigned char* wsbase, hipStream_t s) {
    const float* xp = (const float*)d_in[0]; const float* xs = (const float*)d_in[1]; const float* cache = (const float*)d_in[2]; const float* swin = (const float*)d_in[3];
    const float* sconv = (const float*)d_in[4]; const int* ptab = (const int*)d_in[5]; const float* cp = (const float*)d_in[6]; const float* cs = (const float*)d_in[7];
    const float* w_ada = (const float*)d_in[8]; const float* b_ada = (const float*)d_in[9]; const float* g_pre = (const float*)d_in[10]; const float* g_post = (const float*)d_in[11];
    const float* w_in = (const float*)d_in[12]; const float* pe = (const float*)d_in[13]; const float* w1 = (const float*)d_in[14]; const float* w2 = (const float*)d_in[15];
    const float* conv_w = (const float*)d_in[16]; const float* wba = (const float*)d_in[17]; const float* wbb = (const float*)d_in[18]; const float* wout = (const float*)d_in[19];
    Bufs B = carve(wsbase);
    (void)hipMemcpyAsync(B.c_all, cp, 2 * 1024 * 4, hipMemcpyDeviceToDevice, s); (void)hipMemcpyAsync(B.c_all + 2 * 1024, cs, 128 * 1024 * 4, hipMemcpyDeviceToDevice, s);
    gemm<1, 0>(s, B.c_all, 1024, w_ada, 3072, B.mod, 3072, 130, 3072, 1024, nullptr, b_ada);
    k_h<<<MALL, 256, 0, s>>>(xp, xs, B.mod, g_pre, B.h);
    gemm<0, 0>(s, B.h, 1024, w_in, INW, B.z, INW, MALL, INW, 1024, nullptr, nullptr);
    k_rope<<<(MALL * 14 * 8 + 255) / 256, 256, 0, s>>>(B.z);
    k_outs<<<(int)(((size_t)SB * 512 * 256 + 255) / 256), 256, 0, s>>>(B.z, swin, sconv, out);
    k_streams<<<(int)(((size_t)2 * SB * G * PAST * 64 + 255) / 256), 256, 0, s>>>(B.z, cache, ptab, B.PS, B.SS);
    for (int kind = 0; kind < 2; ++kind) {
        gemm<2, 1>(s, B.PS + (size_t)kind * TB * G * TS * 64, 1024, w1 + (size_t)kind * 2048 * 256, 256, B.hid, 256, TB * G * 512, 256, 2048, pe + kind * 2048, nullptr);
        gemm<0, 0>(s, B.hid, 256, w2 + (size_t)kind * 256 * 64, 64, kind ? B.vc_p : B.kc_p, 64, TB * G * 512, 64, 256, nullptr, nullptr);
        gemm<2, 1>(s, B.SS + (size_t)kind * SB * G * PAST * 64, 1024, w1 + (size_t)kind * 2048 * 256, 256, B.hid, 256, SB * G * 128, 256, 2048, pe + kind * 2048, nullptr);
        gemm<0, 0>(s, B.hid, 256, w2 + (size_t)kind * 256 * 64, 64, kind ? B.vc_s : B.kc_s, 64, SB * G * 128, 64, 256, nullptr, nullptr);
    }
    AttnSrc S{B.z, B.kc_p, B.vc_p, B.kc_s, B.vc_s, cache, ptab, out, nullptr};
    k_attn<<<MALL * 2, 64, 0, s>>>(S, B.oattn);
    k_prep<<<(int)(((size_t)MALL * 512 + 255) / 256), 256, 0, s>>>(B.z, B.oattn, conv_w, sconv, B.pa, B.pb);
    gemm<0, 0>(s, B.pa, 512, wba, 1024, B.ya, 1024, MALL, 1024, 512, nullptr, nullptr);
    gemm<0, 0>(s, B.pb, 512, wbb, 1024, B.yb, 1024, MALL, 1024, 512, nullptr, nullptr);
    k_merge<<<(int)(((size_t)MALL * 1024 + 255) / 256), 256, 0, s>>>(B.z, B.ya, B.yb, B.om);
    gemm<0, 0>(s, B.om, 1024, wout, 1024, B.o, 1024, MALL, 1024, 1024, nullptr, nullptr);
    k_final<<<MALL, 256, 0, s>>>(xp, xs, B.mod, g_post, B.o, out);
    return B;
}
}
extern "C" void kernel_launch(void* const* d_in, const int* in_sizes, int n_in, void* d_out, int out_size, void* d_ws, size_t ws_size, hipStream_t stream) {
    (void)in_sizes; (void)n_in; (void)out_size; (void)ws_size;
    orc::run(d_in, (float*)d_out, (unsigned char*)d_ws, stream);
}
```

```cpp
#include <hip/hip_runtime.h>
#include <hip/hip_cooperative_groups.h>
#include <cstdio>
#include <cstdint>
#include <cmath>
namespace cg = cooperative_groups;
#define LAS __attribute__((address_space(3)))
typedef unsigned short bf16_t;
typedef short bf16x8 __attribute__((ext_vector_type(8)));
typedef float f32x4 __attribute__((ext_vector_type(4)));
typedef float f32x2 __attribute__((ext_vector_type(2)));
typedef float f32x16 __attribute__((ext_vector_type(16)));
typedef unsigned u32x4 __attribute__((ext_vector_type(4)));
typedef unsigned u32x2 __attribute__((ext_vector_type(2)));

namespace mk {
constexpr int DM = 1024, TS = 8192, MP = 16384, SB = 128, MALL = 16512, MPAD = 16640, INW = 5912, NV = 5888;
constexpr int C_G = 1280, C_A = 1304, C_CB = 1816, C_CC = 2328, C_CX = 2840, C_CG = 3352, C_GA = 3864;
constexpr size_t O_YP = 0, O_YS = 16777216, O_KVP = 16908288, O_WINP = 25296896, O_CSP = 25559040, O_KVS = 25561088, O_WINS = 25626624, O_CSS = 42403840, O_END = 42534912;
constexpr float QSCALE = 0.125f * 1.4426950408889634f;
constexpr int NWAVES = 8, NTHR = 512;

constexpr size_t MiB = 1u << 20;
constexpr size_t WS_CTL = 0;
constexpr size_t CTL_BYTES = 4 * MiB;
constexpr size_t WS_MOD = 4 * MiB;
constexpr size_t WS_ROPE = 6 * MiB;
constexpr size_t WS_PEBP = 7 * MiB;
constexpr size_t WS_PEB = 7 * MiB + 65536;
constexpr size_t WS_NG = 8 * MiB;
constexpr size_t WS_SSQP = 11 * MiB;
constexpr size_t WS_WINT = 16 * MiB;
constexpr size_t WS_WBR = 28 * MiB;
constexpr size_t WS_WOUT = 30 * MiB;
constexpr size_t WS_WC1 = 32 * MiB;
constexpr size_t WS_WC2 = 34 * MiB;
constexpr size_t WS_H = 36 * MiB;
constexpr size_t WS_QB = 72 * MiB;
constexpr size_t WS_SA = 90 * MiB;
constexpr size_t WS_U = 108 * MiB;
constexpr size_t WS_CBG = 126 * MiB;
constexpr size_t WS_GA = 144 * MiB;
constexpr size_t WS_GB = 178 * MiB;
constexpr size_t WS_KVI = 212 * MiB;
constexpr size_t WS_KC = 230 * MiB;
constexpr size_t KC_KIND_BYTES = (size_t)34816 * 64 * 2;
constexpr size_t WS_HID = 240 * MiB;
constexpr size_t HID_KIND_BYTES = (size_t)34816 * 256 * 2;
constexpr size_t WS_CMPA = 276 * MiB;
constexpr size_t CMPA_KIND_BYTES = (size_t)(34816 + 2) * 1024 * 2;
constexpr size_t WS_AOY = 420 * MiB;
constexpr size_t WS_T1 = 456 * MiB;
constexpr size_t WS_OPRE = 524 * MiB;
constexpr size_t WS_O = 560 * MiB;
constexpr size_t WS_END = 628 * MiB;
constexpr size_t WS_OUT2 = 640 * MiB;
constexpr size_t WS_ORC = 1024 * MiB;

struct Params {
    const float *xp, *xs, *cache, *swin, *sconv; const int* ptab; const float *cp, *cs, *w_ada, *b_ada, *g_pre, *g_post, *w_in, *pe, *w1, *w2, *conv_w, *wba, *wbb, *wout;
    float* out; unsigned char* ws; int ph_lo, ph_hi;
};

__device__ __forceinline__ float fast_rcp(float x) { return __builtin_amdgcn_rcpf(x); }
__device__ __forceinline__ float sigm(float x) { return fast_rcp(1.f + __expf(-x)); }
__device__ __forceinline__ float silu(float x) { return x * fast_rcp(1.f + __expf(-x)); }
__device__ __forceinline__ unsigned f2bf(float f) { unsigned u = __builtin_bit_cast(unsigned, f); return (u + 0x7fffu + ((u >> 16) & 1u)) >> 16; }
__device__ __forceinline__ unsigned pk2(float lo, float hi) { return f2bf(lo) | (f2bf(hi) << 16); }
__device__ __forceinline__ float bf2f(unsigned short b) { return __builtin_bit_cast(float, (unsigned)b << 16); }
__device__ __forceinline__ float bflo(unsigned w) { return __builtin_bit_cast(float, w << 16); }
__device__ __forceinline__ float bfhi(unsigned w) { return __builtin_bit_cast(float, w & 0xffff0000u); }

namespace pg8 {
constexpr int BM = 256, BK = 64, HALF = 128, HTB = HALF * BK * 2, STAGE_BYTES = 8 * HTB, NXCD = 8, WGM = 8;
__host__ __device__ __forceinline__ int lds_byte(int r, int c) { const int st = (r >> 4) * 2 + (c >> 5), rr = r & 15, cc = c & 31, ob = rr * 64 + cc * 2; return st * 1024 + (ob ^ (((ob >> 9) & 1) << 5)); }
__host__ __device__ __forceinline__ void stage_rc(int b, int& R, int& C) { const int st = b / 1024, sb = b % 1024, swz = sb ^ (((sb >> 9) & 1) << 5); R = (st >> 1) * 16 + swz / 64; C = (st & 1) * 32 + (swz % 64) / 2; }
__host__ __device__ __forceinline__ int perm32(int rho) { const int n = rho >> 4, i = rho & 15; return 8 * (i >> 2) + 4 * n + (i & 3); }

struct Unit { int pm, pn, aux; size_t aoff, boff; };
struct Gemm { const bf16_t* A; const bf16_t* Bt; int lda, ldb, K; };

__device__ __forceinline__ bool static_tile(int i, int G, int c, int nM, int nN, int& pm, int& pn) {
    const int nwg = nM * nN; const long L = (long)i * G + c; if (L >= nwg) return false;
    int wgid = (int)L; { const int q = nwg / NXCD, r = nwg % NXCD, xcd = wgid % NXCD, off = wgid / NXCD; wgid = (xcd < r ? xcd * (q + 1) : r * (q + 1) + (xcd - r) * q) + off; }
    const int nig = WGM * nN, gid = wgid / nig, fm = gid * WGM, gsz = (nM - fm) < WGM ? (nM - fm) : WGM;
    pm = fm + ((wgid % nig) % gsz); pn = (wgid % nig) / gsz; return true;
}

template <class Epi, class Sched>
__device__ __forceinline__ void gemm_phase(LAS unsigned char* lds, const Gemm g, const Sched& S, const Epi& E) {
    const int tid = threadIdx.x, wid = __builtin_amdgcn_readfirstlane(tid >> 6), lane = tid & 63, wr = wid >> 2, wc = wid & 3, fr = lane & 15, fq = lane >> 4;
    const int nt = g.K / BK;
    unsigned voffA[2], voffB[2];
#pragma unroll
    for (int i = 0; i < 2; ++i) { int R, C; stage_rc(tid * 16 + i * 8192, R, C); const int Rb = Epi::PERM ? ((R & ~31) + perm32(R & 31)) : R;
        voffA[i] = (unsigned)(R * g.lda + C) * 2u; voffB[i] = (unsigned)(Rb * g.ldb + C) * 2u; }
    const size_t kstep = (size_t)(BK * 2);
    const size_t hstepA = (size_t)HALF * g.lda * 2, hstepB = (size_t)HALF * g.ldb * 2;
    const unsigned ldsw = (unsigned)wid * 1024u;
    const int aoff = lds_byte(wr * 64 + fr, fq * 8), boff = lds_byte(wc * 32 + fr, fq * 8);
#define PG8_SA(b, h) (((b) * 2 + (h)) * HTB)
#define PG8_SB(b, h) ((4 + (b) * 2 + (h)) * HTB)
#define PG8_STAGE(bufoff, gbase, voff) do { _Pragma("unroll") for (int _i = 0; _i < 2; ++_i) \
        __builtin_amdgcn_global_load_lds((const unsigned*)((const char*)(gbase) + (voff)[_i]), (LAS unsigned*)(lds + (bufoff) + ldsw + _i * 8192), 16, 0, 0); } while (0)
#define PG8_LDA(dst, b, h) do { _Pragma("unroll") for (int m = 0; m < 4; ++m) _Pragma("unroll") for (int k = 0; k < 2; ++k) dst[m][k] = *(const LAS bf16x8*)(lds + PG8_SA(b, h) + aoff + m * 2048 + k * 1024); } while (0)
#define PG8_LDB(dst, b, h) do { _Pragma("unroll") for (int n = 0; n < 2; ++n) _Pragma("unroll") for (int k = 0; k < 2; ++k) dst[n][k] = *(const LAS bf16x8*)(lds + PG8_SB(b, h) + boff + n * 2048 + k * 1024); } while (0)
#define PG8_MMA(ai, bj, At, Bt) do { __builtin_amdgcn_s_setprio(1); _Pragma("unroll") for (int m = 0; m < 4; ++m) _Pragma("unroll") for (int n = 0; n < 2; ++n) _Pragma("unroll") for (int k = 0; k < 2; ++k) \
        acc[ai][bj][m][n] = __builtin_amdgcn_mfma_f32_16x16x32_bf16(Bt[n][k], At[m][k], acc[ai][bj][m][n], 0, 0, 0); __builtin_amdgcn_s_setprio(0); } while (0)
#define PG8_WAIT_V(n) asm volatile("s_waitcnt vmcnt(" #n ")" ::: "memory")
#define PG8_WAIT_L(n) asm volatile("s_waitcnt lgkmcnt(" #n ")" ::: "memory")
#define PG8_BAR __builtin_amdgcn_s_barrier()
#define PG8_SCHED __builtin_amdgcn_sched_barrier(0)
    Unit cur, nxt; int ui = 0;
    if (!S.next(0, cur)) return;
    f32x4 acc[2][2][4][2];
#pragma unroll
    for (int a = 0; a < 2; ++a)
#pragma unroll
        for (int b = 0; b < 2; ++b)
#pragma unroll
            for (int m = 0; m < 4; ++m)
#pragma unroll
                for (int n = 0; n < 2; ++n) acc[a][b][m][n] = (f32x4){0.f, 0.f, 0.f, 0.f};
    bf16x8 At[4][2], B0[2][2], B1[2][2];
    const char* cA = (const char*)g.A + cur.aoff; const char* cB = (const char*)g.Bt + cur.boff;
    PG8_STAGE(PG8_SB(0, 0), cB, voffB); PG8_STAGE(PG8_SB(0, 1), cB + hstepB, voffB); PG8_STAGE(PG8_SA(0, 0), cA, voffA); PG8_STAGE(PG8_SA(0, 1), cA + hstepA, voffA);
    if (wr == 1) PG8_BAR;
    PG8_WAIT_V(2); PG8_BAR;
    PG8_STAGE(PG8_SB(1, 0), cB + kstep, voffB); PG8_STAGE(PG8_SA(1, 0), cA + kstep, voffA); PG8_STAGE(PG8_SB(1, 1), cB + hstepB + kstep, voffB);
    PG8_WAIT_V(6); PG8_BAR;
    for (;;) {
        const bool has_next = S.next(ui + 1, nxt);
        const char* nA = has_next ? (const char*)g.A + nxt.aoff : cA; const char* nB = has_next ? (const char*)g.Bt + nxt.boff : cB;
        for (int t = 0; t < nt; t += 2) {
            const bool last = (t == nt - 2);
            const char* a1 = cA + (size_t)(t + 1) * kstep;
            const char* a2 = last ? nA : cA + (size_t)(t + 2) * kstep; const char* b2 = last ? nB : cB + (size_t)(t + 2) * kstep;
            const char* a3 = a2 + kstep; const char* b3 = b2 + kstep;
            PG8_LDB(B0, 0, 0); PG8_LDB(B1, 0, 1); PG8_SCHED; PG8_LDA(At, 0, 0); PG8_STAGE(PG8_SA(1, 1), a1 + hstepA, voffA);
            PG8_WAIT_V(8); PG8_WAIT_L(0); PG8_BAR; PG8_MMA(0, 0, At, B0); PG8_MMA(0, 1, At, B1); PG8_BAR; PG8_SCHED;
            PG8_LDA(At, 0, 1); PG8_STAGE(PG8_SB(0, 0), b2, voffB); PG8_STAGE(PG8_SB(0, 1), b2 + hstepB, voffB); PG8_STAGE(PG8_SA(0, 0), a2, voffA);
            PG8_WAIT_V(8); PG8_WAIT_L(0); PG8_BAR; PG8_MMA(1, 0, At, B0); PG8_MMA(1, 1, At, B1); PG8_BAR; PG8_SCHED;
            PG8_LDB(B0, 1, 0); PG8_LDB(B1, 1, 1); PG8_SCHED; PG8_LDA(At, 1, 0); PG8_STAGE(PG8_SA(0, 1), a2 + hstepA, voffA);
            PG8_WAIT_V(8); PG8_WAIT_L(0); PG8_BAR; PG8_MMA(0, 0, At, B0); PG8_MMA(0, 1, At, B1); PG8_BAR; PG8_SCHED;
            PG8_LDA(At, 1, 1); PG8_STAGE(PG8_SB(1, 0), b3, voffB); PG8_STAGE(PG8_SB(1, 1), b3 + hstepB, voffB); PG8_STAGE(PG8_SA(1, 0), a3, voffA);
            PG8_WAIT_V(8); PG8_WAIT_L(0); PG8_BAR; PG8_MMA(1, 0, At, B0); PG8_MMA(1, 1, At, B1); PG8_BAR; PG8_SCHED;
        }
        if (wr == 0) PG8_BAR;
        { int fr_ = fr, fq_ = fq; asm volatile("" : "+v"(fr_), "+v"(fq_)); E(acc, cur, wr, wc, fr_, fq_); }
        if (!has_next) break;
#pragma unroll
        for (int a = 0; a < 2; ++a)
#pragma unroll
            for (int b = 0; b < 2; ++b)
#pragma unroll
                for (int m = 0; m < 4; ++m)
#pragma unroll
                    for (int n = 0; n < 2; ++n) acc[a][b][m][n] = (f32x4){0.f, 0.f, 0.f, 0.f};
        cur = nxt; cA = nA; cB = nB; ++ui;
        if (wr == 1) PG8_BAR;
    }
    PG8_WAIT_V(0);
    PG8_BAR;
#undef PG8_SA
#undef PG8_SB
#undef PG8_STAGE
#undef PG8_LDA
#undef PG8_LDB
#undef PG8_MMA
#undef PG8_WAIT_V
#undef PG8_WAIT_L
#undef PG8_BAR
#undef PG8_SCHED
}
}

typedef f32x4 Acc[2][2][4][2];

struct EpiMain {
    static constexpr bool PERM = true;
    float* out; bf16_t *Qb, *CMPAp0, *CMPAp1, *KVI, *SA, *U, *CBG, *GA, *GB; const float* rope;
    __device__ __forceinline__ void operator()(const Acc& acc, const pg8::Unit& u, int wr, int wc, int fr, int fq) const {
        const int pn = u.pn;
        const int lane16 = fq;
#pragma unroll
        for (int ai = 0; ai < 2; ++ai)
#pragma unroll
            for (int m = 0; m < 4; ++m) {
                asm volatile("" ::: "memory");
                const int row = u.pm * 256 + ai * 128 + wr * 64 + m * 16 + fr;
                const bool rok = row < MALL;
                const bool prompt = row < MP;
                const int pos = prompt ? (row & (TS - 1)) : 2048;
                if (pn < 5) {
                    const bool isq = pn < 2;
                    f32x4 cs0 = {0.f, 0.f, 0.f, 0.f}, cs1 = cs0, sn0 = cs0, sn1 = cs0;
                    const bool ropelane = ((wc & 1) == 0) && (lane16 < 2);
                    if (ropelane) { const float* rp = rope + (size_t)pos * 16; cs0 = *(const f32x4*)(rp); cs1 = *(const f32x4*)(rp + 4); sn0 = *(const f32x4*)(rp + 8); sn1 = *(const f32x4*)(rp + 12); }
#pragma unroll
                    for (int bj = 0; bj < 2; ++bj) {
                        f32x4 v0 = acc[ai][bj][m][0], v1 = acc[ai][bj][m][1];
                        const bool dorope = isq || (bj == 0);
                        if (dorope) {
                            f32x4 p0, p1;
#pragma unroll
                            for (int j = 0; j < 4; ++j) { p0[j] = __shfl_xor(v0[j], 16); p1[j] = __shfl_xor(v1[j], 16); }
                            if (ropelane) {
                                if (lane16 == 0) { v0 = v0 * cs0 - p0 * sn0; v1 = v1 * cs1 - p1 * sn1; }
                                else { v0 = p0 * sn0 + v0 * cs0; v1 = p1 * sn1 + v1 * cs1; }
                            }
                        }
                        if (!rok) continue;
                        if (isq) {
                            u32x4 w; w.x = pk2(v0[0] * QSCALE, v0[1] * QSCALE); w.y = pk2(v0[2] * QSCALE, v0[3] * QSCALE); w.z = pk2(v1[0] * QSCALE, v1[1] * QSCALE); w.w = pk2(v1[2] * QSCALE, v1[3] * QSCALE);
                            *(u32x4*)(Qb + (size_t)row * 512 + pn * 256 + bj * 128 + wc * 32 + fq * 8) = w;
                        } else {
                            const int kind = 2 * (pn - 2) + bj, g = wc >> 1, dim0 = 32 * (wc & 1) + 8 * fq;
                            if (prompt) {
                                const int b = row >> 13, t = row & (TS - 1), bg = b * 2 + g;
                                if (kind < 4) { float* o = out + O_KVP + ((size_t)row * 4 + kind) * 128 + g * 64 + dim0; *(f32x4*)o = v0; *(f32x4*)(o + 4) = v1; }
                                else if (t >= TS - 512) { float* o = out + O_WINP + ((size_t)(b * 512 + t - (TS - 512)) * 2 + (kind - 4)) * 128 + g * 64 + dim0; *(f32x4*)o = v0; *(f32x4*)(o + 4) = v1; }
                                u32x4 w; w.x = pk2(v0[0], v0[1]); w.y = pk2(v0[2], v0[3]); w.z = pk2(v1[0], v1[1]); w.w = pk2(v1[2], v1[3]);
                                if (kind < 2) { bf16_t* base = kind ? CMPAp1 : CMPAp0; *(u32x4*)(base + ((size_t)bg * TS + t) * 64 + dim0) = w; }
                                else {
                                    unsigned char* img = (unsigned char*)KVI + ((size_t)((kind - 2) * 4 + bg) * 128 + (t >> 6)) * 8192; const int key = t & 63;
                                    if ((kind & 1) == 0) *(u32x4*)(img + (dim0 >> 3) * 1024 + key * 16) = w;
                                    else *(u32x4*)(img + (dim0 >> 5) * 4096 + (key >> 4) * 1024 + (key & 15) * 64 + (dim0 & 31) * 2) = w;
                                }
                            } else {
                                const int bs = row - MP;
                                float* o = kind < 4 ? out + O_KVS + ((size_t)bs * 4 + kind) * 128 + g * 64 + dim0 : out + O_WINS + ((size_t)(bs * 512 + 511) * 2 + (kind - 4)) * 128 + g * 64 + dim0;
                                *(f32x4*)o = v0; *(f32x4*)(o + 4) = v1;
                            }
                        }
                    }
                } else if (pn < 7) {
                    if (!rok) continue;
#pragma unroll
                    for (int bj = 0; bj < 2; ++bj) { const f32x4 v0 = acc[ai][bj][m][0], v1 = acc[ai][bj][m][1];
                        u32x4 w; w.x = pk2(silu(v0[0]), silu(v0[1])); w.y = pk2(silu(v0[2]), silu(v0[3])); w.z = pk2(silu(v1[0]), silu(v1[1])); w.w = pk2(silu(v1[2]), silu(v1[3]));
                        *(u32x4*)(SA + (size_t)row * 512 + (pn - 5) * 256 + bj * 128 + wc * 32 + fq * 8) = w; }
                } else if (pn < 15) {
                    if (!rok) continue;
                    const f32x4 cb = acc[ai][0][m][0], cg = acc[ai][0][m][1], cc = acc[ai][1][m][0], cx = acc[ai][1][m][1];
                    const int c0 = 64 * (pn - 7) + 16 * wc + 4 * fq;
                    const f32x4 uu = cc * cx; f32x4 cbg;
#pragma unroll
                    for (int j = 0; j < 4; ++j) cbg[j] = cb[j] * silu(cg[j]);
                    u32x2 wu, wc2; wu.x = pk2(uu[0], uu[1]); wu.y = pk2(uu[2], uu[3]); wc2.x = pk2(cbg[0], cbg[1]); wc2.y = pk2(cbg[2], cbg[3]);
                    *(u32x2*)(U + (size_t)row * 512 + c0) = wu; *(u32x2*)(CBG + (size_t)row * 512 + c0) = wc2;
                    if (prompt) { const int t = row & (TS - 1); if (t >= TS - 2) *(f32x4*)(out + O_CSP + ((size_t)(row >> 13) * 2 + (t - (TS - 2))) * 512 + c0) = uu; }
                    else *(f32x4*)(out + O_CSS + ((size_t)(row - MP) * 2 + 1) * 512 + c0) = uu;
                } else {
                    if (!rok) continue;
                    const int mi = pn - 15; bf16_t* dst = (mi < 4 ? GA : GB) + (size_t)row * 1024 + (mi & 3) * 256;
#pragma unroll
                    for (int bj = 0; bj < 2; ++bj) { const f32x4 v0 = acc[ai][bj][m][0], v1 = acc[ai][bj][m][1];
                        u32x4 w; w.x = pk2(sigm(v0[0]), sigm(v0[1])); w.y = pk2(sigm(v0[2]), sigm(v0[3])); w.z = pk2(sigm(v1[0]), sigm(v1[1])); w.w = pk2(sigm(v1[2]), sigm(v1[3]));
                        *(u32x4*)(dst + bj * 128 + wc * 32 + fq * 8) = w; }
                }
            }
    }
};
struct SchedMain {
    int G, c;
    __device__ __forceinline__ bool next(int i, pg8::Unit& u) const {
        int pm, pn; if (!pg8::static_tile(i, G, c, 65, 23, pm, pn)) return false;
        u.pm = pm; u.pn = pn; u.aux = 0; u.aoff = (size_t)pm * 256 * 1024 * 2; u.boff = (size_t)pn * 256 * 1024 * 2; return true; }
};

struct EpiCmp1 {
    static constexpr bool PERM = true;
    bf16_t* HID; const float* peb;
    __device__ __forceinline__ void operator()(const Acc& acc, const pg8::Unit& u, int wr, int wc, int fr, int fq) const {
        const int kind = u.aux; bf16_t* H = HID + (size_t)kind * (HID_KIND_BYTES / 2);
        f32x4 bv[2][2];
#pragma unroll
        for (int bj = 0; bj < 2; ++bj)
#pragma unroll
            for (int n = 0; n < 2; ++n) bv[bj][n] = *(const f32x4*)(peb + kind * 256 + bj * 128 + wc * 32 + fq * 8 + n * 4);
#pragma unroll
        for (int ai = 0; ai < 2; ++ai)
#pragma unroll
            for (int m = 0; m < 4; ++m) { const int row = u.pm * 256 + ai * 128 + wr * 64 + m * 16 + fr;
#pragma unroll
                for (int bj = 0; bj < 2; ++bj) { const f32x4 v0 = acc[ai][bj][m][0] + bv[bj][0], v1 = acc[ai][bj][m][1] + bv[bj][1];
                    u32x4 w; w.x = pk2(silu(v0[0]), silu(v0[1])); w.y = pk2(silu(v0[2]), silu(v0[3])); w.z = pk2(silu(v1[0]), silu(v1[1])); w.w = pk2(silu(v1[2]), silu(v1[3]));
                    *(u32x4*)(H + (size_t)row * 256 + bj * 128 + wc * 32 + fq * 8) = w; } }
    }
};
struct SchedCmp {
    int G, c, pm0, npm;
    __device__ __forceinline__ bool next(int i, pg8::Unit& u) const {
        const int L = i * G + c; if (c < 0 || L >= 2 * npm) return false;
        const int kind = L / npm, pm = pm0 + L % npm;
        u.pm = pm; u.pn = 0; u.aux = kind; u.aoff = (size_t)kind * CMPA_KIND_BYTES + (size_t)pm * 256 * 1024 * 2; u.boff = (size_t)kind * 256 * 2048 * 2; return true; }
};

struct EpiE1 {
    static constexpr bool PERM = true;
    const bf16_t *GA, *GB; float* T1; bf16_t* OPRE;
    __device__ __forceinline__ void operator()(const Acc& acc, const pg8::Unit& u, int wr, int wc, int fr, int fq) const {
        const int pass = u.aux; const bf16_t* GT = pass ? GB : GA;
#pragma unroll
        for (int ai = 0; ai < 2; ++ai)
#pragma unroll
            for (int m = 0; m < 4; ++m) { const int row = u.pm * 256 + ai * 128 + wr * 64 + m * 16 + fr; if (row >= MALL) continue;
#pragma unroll
                for (int bj = 0; bj < 2; ++bj) { const int col = u.pn * 256 + bj * 128 + wc * 32 + fq * 8;
                    const u32x4 gw = *(const u32x4*)(GT + (size_t)row * 1024 + col);
                    f32x4 v0 = acc[ai][bj][m][0], v1 = acc[ai][bj][m][1];
                    v0[0] *= bflo(gw.x); v0[1] *= bfhi(gw.x); v0[2] *= bflo(gw.y); v0[3] *= bfhi(gw.y); v1[0] *= bflo(gw.z); v1[1] *= bfhi(gw.z); v1[2] *= bflo(gw.w); v1[3] *= bfhi(gw.w);
                    float* tp = T1 + (size_t)row * 1024 + col;
                    if (pass == 0) { *(f32x4*)tp = v0; *(f32x4*)(tp + 4) = v1; }
                    else { v0 += *(const f32x4*)tp; v1 += *(const f32x4*)(tp + 4);
                        u32x4 w; w.x = pk2(v0[0], v0[1]); w.y = pk2(v0[2], v0[3]); w.z = pk2(v1[0], v1[1]); w.w = pk2(v1[2], v1[3]);
                        *(u32x4*)(OPRE + (size_t)row * 1024 + col) = w; } } }
    }
};
struct SchedE1 {
    int G, c;
    __device__ __forceinline__ bool next(int i, pg8::Unit& u) const {
        int pm, pn; if (!pg8::static_tile(i >> 1, G, c, 65, 4, pm, pn)) return false;
        const int pass = i & 1; u.pm = pm; u.pn = pn; u.aux = pass;
        u.aoff = (size_t)pm * 256 * 1024 * 2 + pass * 1024; u.boff = (size_t)pn * 256 * 1024 * 2 + pass * 1024; return true; }
};
struct EpiE2 {
    static constexpr bool PERM = false;
    float* O; float* SSQP;
    __device__ __forceinline__ void operator()(const Acc& acc, const pg8::Unit& u, int wr, int wc, int fr, int fq) const {
#pragma unroll
        for (int ai = 0; ai < 2; ++ai)
#pragma unroll
            for (int m = 0; m < 4; ++m) { const int row = u.pm * 256 + ai * 128 + wr * 64 + m * 16 + fr; float s = 0.f;
#pragma unroll
                for (int bj = 0; bj < 2; ++bj)
#pragma unroll
                    for (int n = 0; n < 2; ++n) { const f32x4 v = acc[ai][bj][m][n]; s += (v[0] * v[0] + v[1] * v[1]) + (v[2] * v[2] + v[3] * v[3]);
                        *(f32x4*)(O + (size_t)row * 1024 + u.pn * 256 + bj * 128 + wc * 32 + n * 16 + fq * 4) = v; }
                s += __shfl_xor(s, 16); s += __shfl_xor(s, 32);
                if (fq == 0) SSQP[(size_t)row * 16 + u.pn * 4 + wc] = s; }
    }
};
struct SchedE2 {
    int G, c;
    __device__ __forceinline__ bool next(int i, pg8::Unit& u) const {
        int pm, pn; if (!pg8::static_tile(i, G, c, 65, 4, pm, pn)) return false;
        u.pm = pm; u.pn = pn; u.aux = 0; u.aoff = (size_t)pm * 256 * 1024 * 2; u.boff = (size_t)pn * 256 * 1024 * 2; return true; }
};
struct Frame { LAS unsigned char* lds; int tid, lane, wave, vcu, G; };

__device__ __forceinline__ float wave_sum(float v) {
#pragma unroll
    for (int o = 1; o < 64; o <<= 1) v += __shfl_xor(v, o);
    return v;
}
__device__ __forceinline__ int win_src(int v) {
    const int pn = v >> 8, w = v & 255;
    if (pn < 5) return v;
    if (pn < 7) return C_A + (v - 5 * 256);
    if (pn < 15) { const int ti = pn - 7, bj = w >> 7, wc = (w >> 5) & 3, fq = (w >> 3) & 3, e = w & 7, tsel = e >> 2, e3 = e & 3;
        const int ch = 64 * ti + 16 * wc + 4 * fq + e3, type = bj * 2 + tsel;
        return (type == 0 ? C_CB : type == 1 ? C_CG : type == 2 ? C_CC : C_CX) + ch; }
    return C_GA + (v - 15 * 256);
}
template <class SrcMap>
__device__ __forceinline__ void transpose_item(const float* W, int N, bf16_t* WT, int ldt, int kcol0, LAS float* scr, int k0, int n0, int lane, const SrcMap& src) {
    const int sc = src(n0 + (lane & 31));
#pragma unroll 8
    for (int i = 0; i < 32; ++i) { const int kk = 2 * i + (lane >> 5); scr[kk * 33 + (lane & 31)] = W[(size_t)(k0 + kk) * N + sc]; }
    asm volatile("s_waitcnt lgkmcnt(0)" ::: "memory");
    const int c = lane & 7;
#pragma unroll
    for (int j = 0; j < 4; ++j) { const int n = (lane >> 3) + 8 * j; const LAS float* s = scr + (8 * c) * 33 + n;
        u32x4 o; o.x = pk2(s[0 * 33], s[1 * 33]); o.y = pk2(s[2 * 33], s[3 * 33]); o.z = pk2(s[4 * 33], s[5 * 33]); o.w = pk2(s[6 * 33], s[7 * 33]);
        *(u32x4*)(WT + (size_t)(n0 + n) * ldt + kcol0 + k0 + 8 * c) = o; }
    asm volatile("s_waitcnt lgkmcnt(0)" ::: "memory");
}
struct IdMap { __device__ __forceinline__ int operator()(int n) const { return n; } };
struct WinMap { __device__ __forceinline__ int operator()(int n) const { return win_src(n); } };

__device__ __forceinline__ void phase0(const Params& p, const Frame& F) {
    LAS float* scr = (LAS float*)(F.lds + F.wave * 16384);
    unsigned char* ws = p.ws; const int lane = F.lane;
    const int gw = F.vcu * NWAVES + F.wave, NGW = F.G * NWAVES;
    constexpr int I_MOD = 48 * 26, I_PEB = 64, I_ROPE = 1024, I_WIN = 16 * 184, I_WBA = 8 * 32, I_WBB = 8 * 32, I_WOUT = 16 * 32, I_WC1 = 2 * 32 * 8, I_WC2 = 2 * 4 * 2,
                  I_CACHE = 65536, I_WINC = (128 * 511 + 3) / 4, I_CSC = 256;
    constexpr int TOTAL = I_MOD + I_PEB + I_ROPE + I_WIN + I_WBA + I_WBB + I_WOUT + I_WC1 + I_WC2 + I_CACHE + I_WINC + I_CSC;
    float* mod = (float*)(ws + WS_MOD);
    for (int it = gw; it < TOTAL; it += NGW) {
        int r = it;
        if (r < I_MOD) {
            const int nb = r % 48, rb = r / 48, n = nb * 64 + lane;
            float acc[5]; const float* crow[5];
#pragma unroll
            for (int j = 0; j < 5; ++j) { const int rr = rb * 5 + j; crow[j] = rr < 2 ? p.cp + (size_t)rr * 1024 : p.cs + (size_t)(rr - 2) * 1024; acc[j] = p.b_ada[n]; }
            for (int k0 = 0; k0 < 1024; k0 += 64) {
                float cv[5];
#pragma unroll
                for (int j = 0; j < 5; ++j) { const float x = crow[j][k0 + lane]; cv[j] = x / (1.f + __expf(-x)); }
#pragma unroll
                for (int kk = 0; kk < 64; ++kk) { const float w = p.w_ada[(size_t)(k0 + kk) * 3072 + n];
#pragma unroll
                    for (int j = 0; j < 5; ++j) acc[j] += __builtin_bit_cast(float, __builtin_amdgcn_readlane(__builtin_bit_cast(int, cv[j]), kk)) * w; }
            }
#pragma unroll
            for (int j = 0; j < 5; ++j) mod[(size_t)(rb * 5 + j) * 3072 + n] = acc[j];
            continue;
        }
        r -= I_MOD;
        if (r < I_PEB) {
            const int kind = r >> 5, nb = (r >> 3) & 3, kc = r & 7, n = nb * 64 + lane; float s = 0.f;
            const float* pe = p.pe + kind * 2048 + kc * 256; const float* w = p.w1 + ((size_t)kind * 2048 + kc * 256) * 256 + n;
#pragma unroll 8
            for (int k = 0; k < 256; ++k) s += pe[k] * w[(size_t)k * 256];
            ((float*)(ws + WS_PEBP))[(kind * 8 + kc) * 256 + n] = s;
            continue;
        }
        r -= I_PEB;
        if (r < I_ROPE) {
            const int idx = r * 64 + lane, pos = idx >> 3, i = idx & 7;
            const float inv = (float)pow(500000.0, -(double)i / 8.0); const float ang = (float)pos * inv;
            float* rp = (float*)(ws + WS_ROPE) + (size_t)pos * 16;
            rp[i] = (float)cos((double)ang); rp[8 + i] = (float)sin((double)ang);
            continue;
        }
        r -= I_ROPE;
        if (r < I_WIN) { transpose_item(p.w_in, INW, (bf16_t*)(ws + WS_WINT), 1024, 0, scr, 64 * (r / 184), 32 * (r % 184), lane, WinMap()); continue; }
        r -= I_WIN;
        if (r < I_WBA) { transpose_item(p.wba, 1024, (bf16_t*)(ws + WS_WBR), 1024, 0, scr, 64 * (r / 32), 32 * (r % 32), lane, IdMap()); continue; }
        r -= I_WBA;
        if (r < I_WBB) { transpose_item(p.wbb, 1024, (bf16_t*)(ws + WS_WBR), 1024, 512, scr, 64 * (r / 32), 32 * (r % 32), lane, IdMap()); continue; }
        r -= I_WBB;
        if (r < I_WOUT) { transpose_item(p.wout, 1024, (bf16_t*)(ws + WS_WOUT), 1024, 0, scr, 64 * (r / 32), 32 * (r % 32), lane, IdMap()); continue; }
        r -= I_WOUT;
        if (r < I_WC1) { const int kind = r / 256, q = r % 256; transpose_item(p.w1 + (size_t)kind * 2048 * 256, 256, (bf16_t*)(ws + WS_WC1) + (size_t)kind * 256 * 2048, 2048, 0, scr, 64 * (q / 8), 32 * (q % 8), lane, IdMap()); continue; }
        r -= I_WC1;
        if (r < I_WC2) { const int kind = r / 8, q = r % 8; transpose_item(p.w2 + (size_t)kind * 256 * 64, 64, (bf16_t*)(ws + WS_WC2) + (size_t)kind * 64 * 256, 256, 0, scr, 64 * (q / 2), 32 * (q % 2), lane, IdMap()); continue; }
        r -= I_WC2;
        if (r < I_CACHE) {
#pragma unroll
            for (int j = 0; j < 4; ++j) { const int tok = r * 4 + j, bs = tok >> 11, t = tok & 2047; const int phys = p.ptab[bs * 16 + (t >> 7)];
                const f32x4 v = *(const f32x4*)(p.cache + ((size_t)phys * 128 + (t & 127)) * 512 + lane * 4);
                const int kind = lane >> 5, g = (lane >> 4) & 1, d = (lane & 15) * 4;
                u32x2 w; w.x = pk2(v[0], v[1]); w.y = pk2(v[2], v[3]);
                *(u32x2*)((bf16_t*)(ws + WS_CMPA + (size_t)kind * CMPA_KIND_BYTES) + ((size_t)(bs * 2 + g) * 2048 + t) * 64 + d) = w; }
            continue;
        }
        r -= I_CACHE;
        if (r < I_WINC) {
#pragma unroll
            for (int j = 0; j < 4; ++j) { const int ridx = r * 4 + j; if (ridx < 128 * 511) { const int bs = ridx / 511, jj = ridx % 511;
                *(f32x4*)(p.out + O_WINS + ((size_t)bs * 512 + jj) * 256 + lane * 4) = *(const f32x4*)(p.swin + ((size_t)bs * 512 + jj + 1) * 256 + lane * 4); } }
            continue;
        }
        r -= I_WINC;
        { const int idx = r * 256 + lane * 4, bs = idx >> 9, c = idx & 511;
          *(f32x4*)(p.out + O_CSS + ((size_t)bs * 2) * 512 + c) = *(const f32x4*)(p.sconv + ((size_t)bs * 2 + 1) * 512 + c); }
    }
}

__device__ __forceinline__ void phase1(const Params& p, const Frame& F) {
    unsigned char* ws = p.ws; const int lane = F.lane;
    LAS float* wg = (LAS float*)F.lds;
    for (int k = F.tid; k < 1024; k += NTHR) { const float* src = p.w_in + (size_t)k * INW + C_G;
#pragma unroll
        for (int q4 = 0; q4 < 6; ++q4) { const f32x4 v = *(const f32x4*)(src + 4 * q4); wg[(4 * q4 + 0) * 1024 + k] = v[0]; wg[(4 * q4 + 1) * 1024 + k] = v[1]; wg[(4 * q4 + 2) * 1024 + k] = v[2]; wg[(4 * q4 + 3) * 1024 + k] = v[3]; } }
    __syncthreads();
    const int gw = F.vcu * NWAVES + F.wave, NGW = F.G * NWAVES;
    const float* mod = (const float*)(ws + WS_MOD); bf16_t* H = (bf16_t*)(ws + WS_H); float* NG = (float*)(ws + WS_NG);
    if (gw < 8) { const int kind = gw >> 2, n = (gw & 3) * 64 + lane; float s = 0.f; const float* pp = (const float*)(ws + WS_PEBP) + kind * 8 * 256 + n;
#pragma unroll
        for (int kc = 0; kc < 8; ++kc) s += pp[kc * 256];
        ((float*)(ws + WS_PEB))[kind * 256 + n] = s; }
    for (int row = gw; row < MALL; row += NGW) {
        const float* x = row < MP ? p.xp + (size_t)row * DM : p.xs + (size_t)(row - MP) * DM;
        const float* md = mod + (size_t)(row < MP ? (row >> 13) : 2 + (row - MP)) * 3072;
        f32x4 v[4]; float s = 0.f;
#pragma unroll
        for (int j = 0; j < 4; ++j) { v[j] = *(const f32x4*)(x + j * 256 + lane * 4); s += (v[j][0] * v[j][0] + v[j][1] * v[j][1]) + (v[j][2] * v[j][2] + v[j][3] * v[j][3]); }
        const float rs = rsqrtf(wave_sum(s) * (1.f / DM) + 1e-6f);
#pragma unroll
        for (int j = 0; j < 4; ++j) { const int k = j * 256 + lane * 4; const f32x4 gp = *(const f32x4*)(p.g_pre + k), sh = *(const f32x4*)(md + k), sc = *(const f32x4*)(md + 1024 + k);
            v[j] = v[j] * rs * gp * (1.f + sc) + sh;
            u32x2 w; w.x = pk2(v[j][0], v[j][1]); w.y = pk2(v[j][2], v[j][3]); *(u32x2*)(H + (size_t)row * DM + k) = w; }
        float gsum = 0.f;
#pragma unroll 2
        for (int c = 0; c < 24; ++c) { float d = 0.f;
#pragma unroll
            for (int j = 0; j < 4; ++j) { const f32x4 w = *(const LAS f32x4*)(wg + c * 1024 + j * 256 + lane * 4); d += (v[j][0] * w[0] + v[j][1] * w[1]) + (v[j][2] * w[2] + v[j][3] * w[3]); }
            d = wave_sum(d); if (lane == c) gsum = d; }
        if (lane < 24) NG[(size_t)row * 32 + lane] = sigm(gsum);
    }
}

__device__ __forceinline__ void cmp2_item(unsigned char* ws, int kind, int row0, int lane) {
    const bf16_t* H = (const bf16_t*)(ws + WS_HID + (size_t)kind * HID_KIND_BYTES); const bf16_t* W = (const bf16_t*)(ws + WS_WC2) + (size_t)kind * 64 * 256;
    const int r32 = lane & 31, hi = lane >> 5;
    f32x16 acc0 = {}, acc1 = {};
#pragma unroll 4
    for (int s = 0; s < 16; ++s) {
        const bf16x8 a = *(const bf16x8*)(H + (size_t)(row0 + r32) * 256 + s * 16 + hi * 8);
        const bf16x8 b0 = *(const bf16x8*)(W + (size_t)r32 * 256 + s * 16 + hi * 8), b1 = *(const bf16x8*)(W + (size_t)(32 + r32) * 256 + s * 16 + hi * 8);
        acc0 = __builtin_amdgcn_mfma_f32_32x32x16_bf16(a, b0, acc0, 0, 0, 0); acc1 = __builtin_amdgcn_mfma_f32_32x32x16_bf16(a, b1, acc1, 0, 0, 0);
    }
    unsigned char* img = ws + WS_KC + (size_t)kind * KC_KIND_BYTES;
#pragma unroll
    for (int r = 0; r < 16; ++r) { const int row = row0 + (r & 3) + 8 * (r >> 2) + 4 * hi, tile = row >> 6, key = row & 63;
#pragma unroll
        for (int h2 = 0; h2 < 2; ++h2) { const int d = r32 + 32 * h2; const float v = h2 ? acc1[r] : acc0[r];
            size_t off;
            if (kind == 0) off = (size_t)tile * 8192 + (d >> 3) * 1024 + key * 16 + (d & 7) * 2;
            else off = (size_t)tile * 8192 + (d >> 5) * 4096 + (key >> 4) * 1024 + (key & 15) * 64 + (d & 31) * 2;
            *(bf16_t*)(img + off) = (bf16_t)f2bf(v); } }
}
__device__ __forceinline__ void ybin_row(const Params& p, int row, int lane) {
    unsigned char* ws = p.ws; const bf16_t* U = (const bf16_t*)(ws + WS_U); const bf16_t* CBG = (const bf16_t*)(ws + WS_CBG); bf16_t* AOY = (bf16_t*)(ws + WS_AOY);
    const int c = lane * 8;
    float u0[8], u1[8], u2[8];
    { const u32x4 w = *(const u32x4*)(U + (size_t)row * 512 + c); u2[0] = bflo(w.x); u2[1] = bfhi(w.x); u2[2] = bflo(w.y); u2[3] = bfhi(w.y); u2[4] = bflo(w.z); u2[5] = bfhi(w.z); u2[6] = bflo(w.w); u2[7] = bfhi(w.w); }
    if (row < MP) { const int t = row & (TS - 1);
        if (t >= 1) { const u32x4 w = *(const u32x4*)(U + (size_t)(row - 1) * 512 + c); u1[0] = bflo(w.x); u1[1] = bfhi(w.x); u1[2] = bflo(w.y); u1[3] = bfhi(w.y); u1[4] = bflo(w.z); u1[5] = bfhi(w.z); u1[6] = bflo(w.w); u1[7] = bfhi(w.w); }
        else {
#pragma unroll
            for (int j = 0; j < 8; ++j) u1[j] = 0.f; }
        if (t >= 2) { const u32x4 w = *(const u32x4*)(U + (size_t)(row - 2) * 512 + c); u0[0] = bflo(w.x); u0[1] = bfhi(w.x); u0[2] = bflo(w.y); u0[3] = bfhi(w.y); u0[4] = bflo(w.z); u0[5] = bfhi(w.z); u0[6] = bflo(w.w); u0[7] = bfhi(w.w); }
        else {
#pragma unroll
            for (int j = 0; j < 8; ++j) u0[j] = 0.f; }
    } else { const int bs = row - MP; const float* s0 = p.sconv + ((size_t)bs * 2) * 512 + c; const float* s1 = s0 + 512;
#pragma unroll
        for (int j = 0; j < 8; ++j) { u0[j] = s0[j]; u1[j] = s1[j]; } }
    const u32x4 wcb = *(const u32x4*)(CBG + (size_t)row * 512 + c);
    float cb[8] = {bflo(wcb.x), bfhi(wcb.x), bflo(wcb.y), bfhi(wcb.y), bflo(wcb.z), bfhi(wcb.z), bflo(wcb.w), bfhi(wcb.w)};
    float o[8];
#pragma unroll
    for (int j = 0; j < 8; ++j) o[j] = cb[j] * (p.conv_w[c + j] * u0[j] + p.conv_w[512 + c + j] * u1[j] + p.conv_w[1024 + c + j] * u2[j]);
    u32x4 w; w.x = pk2(o[0], o[1]); w.y = pk2(o[2], o[3]); w.z = pk2(o[4], o[5]); w.w = pk2(o[6], o[7]);
    *(u32x4*)(AOY + (size_t)row * 1024 + 512 + c) = w;
}
__device__ __forceinline__ void final_row(const Params& p, float* outbase, int row, int lane) {
    unsigned char* ws = p.ws; const float* O = (const float*)(ws + WS_O) + (size_t)row * 1024; const float* sq = (const float*)(ws + WS_SSQP) + (size_t)row * 16;
    float s = 0.f;
#pragma unroll
    for (int j = 0; j < 16; ++j) s += sq[j];
    const float rs = rsqrtf(s * (1.f / DM) + 1e-6f);
    const float* x = row < MP ? p.xp + (size_t)row * DM : p.xs + (size_t)(row - MP) * DM;
    float* y = row < MP ? outbase + O_YP + (size_t)row * DM : outbase + O_YS + (size_t)(row - MP) * DM;
    const float* gate = (const float*)(ws + WS_MOD) + (size_t)(row < MP ? (row >> 13) : 2 + (row - MP)) * 3072 + 2048;
#pragma unroll
    for (int j = 0; j < 4; ++j) { const int k = j * 256 + lane * 4; const f32x4 xv = *(const f32x4*)(x + k), ov = *(const f32x4*)(O + k), gv = *(const f32x4*)(gate + k), gp = *(const f32x4*)(p.g_post + k);
        *(f32x4*)(y + k) = xv + gv * ov * rs * gp; }
}
namespace att {
constexpr int L_K = 0, L_V = 16384, L_GS = 32768, L_LS = 65536, L_SELM = 98304, L_WSF = 99328, L_UN = 101376, L_Q = 101632, L_END = 134400;
typedef short s16x4 __attribute__((ext_vector_type(4)));
typedef LAS const unsigned char* lptr;
__device__ __forceinline__ int crow(int r, int hi) { return (r & 3) + 8 * (r >> 2) + 4 * hi; }
__device__ __forceinline__ s16x4 vtr(lptr p) { return __builtin_bit_cast(s16x4, __builtin_amdgcn_ds_read_tr16_b64_v4i16((LAS s16x4*)p)); }
__device__ __forceinline__ float half_swap_max(float m) { auto rr = __builtin_amdgcn_permlane32_swap(__float_as_uint(m), __float_as_uint(m), false, false); return fmaxf(__uint_as_float(rr[0]), __uint_as_float(rr[1])); }
__device__ __forceinline__ float half_swap_sum(float m) { auto rr = __builtin_amdgcn_permlane32_swap(__float_as_uint(m), __float_as_uint(m), false, false); return __uint_as_float(rr[0]) + __uint_as_float(rr[1]); }
__device__ __forceinline__ unsigned cvtpk(float lo, float hi) { typedef __bf16 bf16x2_t __attribute__((ext_vector_type(2))); f32x2 v = {lo, hi}; bf16x2_t b = __builtin_convertvector(v, bf16x2_t); return __builtin_bit_cast(unsigned, b); }
__device__ __forceinline__ float quad_sum(float v) { v += __shfl_xor(v, 1); v += __shfl_xor(v, 2); return v; }

struct Tile16 { u32x4 k, v; };
__device__ __forceinline__ void qkt(f32x16& p0, f32x16& p1, lptr kslot, const LAS bf16x8* qr, int r32, int hi) {
    lptr kb = kslot + hi * 1024 + r32 * 16;
    p0 = f32x16{}; p1 = f32x16{};
#pragma unroll
    for (int d0 = 0; d0 < 4; ++d0) {
        const bf16x8 b0 = *(const LAS bf16x8*)(kb + d0 * 2048), b1 = *(const LAS bf16x8*)(kb + d0 * 2048 + 512);
        const bf16x8 qf = qr[d0 * 64]; p0 = __builtin_amdgcn_mfma_f32_32x32x16_bf16(b0, qf, p0, 0, 0, 0); p1 = __builtin_amdgcn_mfma_f32_32x32x16_bf16(b1, qf, p1, 0, 0, 0);
    }
}
__device__ __forceinline__ void pv(f32x16* o, lptr vslot, const f32x16& p0, const f32x16& p1, int lane, int hi) {
    u32x4 pw[4];
    pw[0] = (u32x4){cvtpk(p0[0], p0[1]), cvtpk(p0[2], p0[3]), cvtpk(p0[4], p0[5]), cvtpk(p0[6], p0[7])};
    pw[1] = (u32x4){cvtpk(p0[8], p0[9]), cvtpk(p0[10], p0[11]), cvtpk(p0[12], p0[13]), cvtpk(p0[14], p0[15])};
    pw[2] = (u32x4){cvtpk(p1[0], p1[1]), cvtpk(p1[2], p1[3]), cvtpk(p1[4], p1[5]), cvtpk(p1[6], p1[7])};
    pw[3] = (u32x4){cvtpk(p1[8], p1[9]), cvtpk(p1[10], p1[11]), cvtpk(p1[12], p1[13]), cvtpk(p1[14], p1[15])};
    lptr vp = vslot + ((lane >> 4) & 1) * 32 + (lane & 3) * 8 + (4 * hi + ((lane & 15) >> 2)) * 64;
#pragma unroll
    for (int d0 = 0; d0 < 2; ++d0)
#pragma unroll
        for (int ks = 0; ks < 4; ++ks) {
            const s16x4 lo = vtr(vp + d0 * 4096 + ks * 1024), hh = vtr(vp + d0 * 4096 + ks * 1024 + 512);
            const bf16x8 vf = (bf16x8){lo[0], lo[1], lo[2], lo[3], hh[0], hh[1], hh[2], hh[3]};
            o[d0] = __builtin_amdgcn_mfma_f32_32x32x16_bf16(__builtin_bit_cast(bf16x8, pw[ks]), vf, o[d0], 0, 0, 0);
        }
}
__device__ __forceinline__ void mask_range(f32x16& p0, f32x16& p1, int lo, int hi_, int hi) {
    const int lo2 = lo - 4 * hi, hi2 = hi_ - 4 * hi;
#pragma unroll
    for (int r = 0; r < 16; ++r) { const int c = (r & 3) + 8 * (r >> 2);
        p0[r] = (c >= lo2 && c <= hi2) ? p0[r] : -INFINITY; p1[r] = (c + 32 >= lo2 && c + 32 <= hi2) ? p1[r] : -INFINITY; }
}
__device__ __forceinline__ void mask_rows(f32x16& p0, f32x16& p1, float bias) {
#pragma unroll
    for (int r = 0; r < 16; ++r) { p0[r] += bias; p1[r] += bias; }
}
__device__ __forceinline__ void online_step(f32x16& p0, f32x16& p1, float& m, float& l, f32x16* o, LAS float* wsf, int r32, int hi) {
    float rm = p0[0];
#pragma unroll
    for (int r = 1; r < 16; ++r) rm = fmaxf(rm, p0[r]);
#pragma unroll
    for (int r = 0; r < 16; ++r) rm = fmaxf(rm, p1[r]);
    rm = half_swap_max(rm);
    const float mn = fmaxf(m, rm);
    const float alpha = __builtin_amdgcn_exp2f(m - mn);
    float s = 0.f;
#pragma unroll
    for (int r = 0; r < 16; ++r) { p0[r] = __builtin_amdgcn_exp2f(p0[r] - mn); p1[r] = __builtin_amdgcn_exp2f(p1[r] - mn); s += p0[r] + p1[r]; }
    l = l * alpha + s; m = mn;
    if (__any(alpha != 1.f)) {
        if (hi == 0) wsf[r32] = alpha;
        asm volatile("s_waitcnt lgkmcnt(0)" ::: "memory");
#pragma unroll
        for (int r = 0; r < 16; ++r) { const float a = wsf[crow(r, hi)]; o[0][r] *= a; o[1][r] *= a; }
    }
}
__device__ __forceinline__ void accum_scaled(f32x16* otot, const f32x16* o, float coef, LAS float* wsf, int r32, int hi) {
    if (hi == 0) wsf[32 + r32] = coef;
    asm volatile("s_waitcnt lgkmcnt(0)" ::: "memory");
#pragma unroll
    for (int r = 0; r < 16; ++r) { const float a = wsf[32 + crow(r, hi)]; otot[0][r] += a * o[0][r]; otot[1][r] += a * o[1][r]; }
}
__device__ __forceinline__ unsigned pick4(unsigned a0, unsigned a1, unsigned a2, unsigned a3, int i) { unsigned r = a0; r = (i == 1) ? a1 : r; r = (i == 2) ? a2 : r; r = (i == 3) ? a3 : r; return r; }
__device__ __forceinline__ int next_bit(unsigned u0, unsigned u1, unsigned u2, unsigned u3, int j, int jmax) {
    while (j <= jmax) { const unsigned w = pick4(u0, u1, u2, u3, j >> 5) >> (j & 31); if (w) { j += __builtin_ctz(w); return j <= jmax ? j : jmax + 1; } j = (j | 31) + 1; }
    return jmax + 1;
}

__device__ __forceinline__ void prompt_unit(const Params& p, const Frame& F, int b, int g, int cur) {
    unsigned char* ws = p.ws; LAS unsigned char* lds = F.lds;
    const int tid = F.tid, lane = F.lane, wid = F.wave, r32 = lane & 31, hi = lane >> 5;
    const int bg = b * 2 + g, t0 = cur * 64, tokl = 8 * wid + (r32 >> 2), head = r32 & 3, t = t0 + tokl;
    const size_t grow = (size_t)b * TS + t;
    LAS float* wsf = (LAS float*)(lds + L_WSF) + wid * 64;
    LAS float* GS = (LAS float*)(lds + L_GS); LAS float* LS = (LAS float*)(lds + L_LS);
    LAS bf16x8* qr = (LAS bf16x8*)(lds + L_Q + wid * 4096) + hi * 32 + r32;
    __syncthreads();
    { const bf16_t* qp = (const bf16_t*)(ws + WS_QB) + grow * 512 + (g * 4 + head) * 64 + hi * 8;
#pragma unroll
      for (int d0 = 0; d0 < 4; ++d0) qr[d0 * 64] = *(const bf16x8*)(qp + d0 * 16); }
    const float* ngp = (const float*)(ws + WS_NG) + grow * 32 + g * 12 + head * 3;
    const float g_cmp = ngp[0], g_sel = ngp[1], g_win = ngp[2];
    f32x16 otot[2]; otot[0] = f32x16{}; otot[1] = f32x16{};
    f32x16 o[2]; f32x16 p0, p1;
    const unsigned char* kc_img = ws + WS_KC + (size_t)(512 + bg * 8) * 8192;
    const unsigned char* vc_img = ws + WS_KC + KC_KIND_BYTES + (size_t)(512 + bg * 8) * 8192;
    const unsigned char* ks_img = ws + WS_KVI + (size_t)(0 * 4 + bg) * 128 * 8192;
    const unsigned char* vs_img = ws + WS_KVI + (size_t)(1 * 4 + bg) * 128 * 8192;
    const unsigned char* kw_img = ws + WS_KVI + (size_t)(2 * 4 + bg) * 128 * 8192;
    const unsigned char* vw_img = ws + WS_KVI + (size_t)(3 * 4 + bg) * 128 * 8192;
#define LOADT(dst, kimg, vimg, tile, needv) do { unsigned to_ = toff; asm volatile("" : "+v"(to_)); const unsigned char* kb_ = (kimg) + (size_t)(tile) * 8192; dst.k = *(const u32x4*)(kb_ + to_); if (needv) { const unsigned char* vb_ = (vimg) + (size_t)(tile) * 8192; dst.v = *(const u32x4*)(vb_ + to_); } } while (0)
#define STORET(src, slot, needv) do { *(LAS u32x4*)(lds + L_K + (slot) * 8192 + tid * 16) = src.k; if (needv) *(LAS u32x4*)(lds + L_V + (slot) * 8192 + tid * 16) = src.v; } while (0)
    Tile16 tl; const unsigned toff = (unsigned)tid * 16u;
    const int cmaxl = (t >= 31) ? ((t - 31) >> 4) : -1;
    const int nct = (4 * cur + 3 + 63) >> 6;
    float m = -1e30f, l = 0.f;
    LOADT(tl, kc_img, vc_img, 0, false); STORET(tl, 0, false); __syncthreads();
#pragma unroll 1
    for (int ct = 0; ct < nct; ++ct) {
        if (ct + 1 < nct) LOADT(tl, kc_img, vc_img, ct + 1, false);
        qkt(p0, p1, (lptr)(lds + L_K + (ct & 1) * 8192), qr, r32, hi);
        mask_range(p0, p1, 0, cmaxl - 64 * ct, hi);
        float rm = p0[0];
#pragma unroll
        for (int r = 1; r < 16; ++r) rm = fmaxf(rm, p0[r]);
#pragma unroll
        for (int r = 0; r < 16; ++r) rm = fmaxf(rm, p1[r]);
        rm = half_swap_max(rm);
        const float mn = fmaxf(m, rm); float s = 0.f;
#pragma unroll
        for (int r = 0; r < 16; ++r) s += __builtin_amdgcn_exp2f(p0[r] - mn) + __builtin_amdgcn_exp2f(p1[r] - mn);
        l = l * __builtin_amdgcn_exp2f(m - mn) + s; m = mn;
        if (ct + 1 < nct) STORET(tl, (ct + 1) & 1, false);
        __syncthreads();
    }
    l = half_swap_sum(l);
    const float linv = 1.f / fmaxf(l, 1e-30f);
    o[0] = f32x16{}; o[1] = f32x16{};
    LOADT(tl, kc_img, vc_img, 0, true); STORET(tl, 0, true); __syncthreads();
#pragma unroll 1
    for (int ct = 0; ct < nct; ++ct) {
        if (ct + 1 < nct) LOADT(tl, kc_img, vc_img, ct + 1, true);
        qkt(p0, p1, (lptr)(lds + L_K + (ct & 1) * 8192), qr, r32, hi);
        mask_range(p0, p1, 0, cmaxl - 64 * ct, hi);
#pragma unroll
        for (int r = 0; r < 16; ++r) { p0[r] = __builtin_amdgcn_exp2f(p0[r] - m) * linv; p1[r] = __builtin_amdgcn_exp2f(p1[r] - m) * linv; }
#pragma unroll
        for (int q = 0; q < 4; ++q) {
            const float ga = quad_sum((p0[4 * q] + p0[4 * q + 1]) + (p0[4 * q + 2] + p0[4 * q + 3])), la = quad_sum(p0[4 * q + 3]);
            const float gb = quad_sum((p1[4 * q] + p1[4 * q + 1]) + (p1[4 * q + 2] + p1[4 * q + 3])), lb = quad_sum(p1[4 * q + 3]);
            const int j = 16 * ct + 2 * q + hi;
            if (head == 0) { GS[tokl * 128 + j] = ga; LS[tokl * 128 + j] = la; GS[tokl * 128 + j + 8] = gb; LS[tokl * 128 + j + 8] = lb; }
        }
        pv(o, (lptr)(lds + L_V + (ct & 1) * 8192), p0, p1, lane, hi);
        if (ct + 1 < nct) STORET(tl, (ct + 1) & 1, true);
        __syncthreads();
    }
    accum_scaled(otot, o, g_cmp, wsf, r32, hi);
    for (int e = tid; e < 64 * 128; e += NTHR) { const int j = e & 127;
        float sc; if (j == 0 || j == cur || j == cur - 1) sc = 1e6f; else if (j <= cur) sc = GS[e] + LS[e - 1]; else sc = -1.f;
        GS[e] = sc; }
    __syncthreads();
    unsigned wm0 = 0, wm1 = 0, wm2 = 0, wm3 = 0;
#pragma unroll 1
    for (int tk = 0; tk < 8; ++tk) { const int tok = 8 * wid + tk; const LAS float* sp = GS + tok * 128;
        const float sa = sp[lane], sb = sp[lane + 64]; int ra = 0, rb = 0;
#pragma unroll 4
        for (int i4 = 0; i4 < 32; ++i4) { const f32x4 v = *(const LAS f32x4*)(sp + 4 * i4);
#pragma unroll
            for (int e = 0; e < 4; ++e) { const int i = 4 * i4 + e; ra += (v[e] > sa || (v[e] == sa && i < lane)) ? 1 : 0; rb += (v[e] > sb || (v[e] == sb && i < lane + 64)) ? 1 : 0; } }
        const unsigned long long ma = __ballot(ra < 16), mb = __ballot(rb < 16);
        const unsigned a0 = (unsigned)ma, a1 = (unsigned)(ma >> 32), b0 = (unsigned)mb, b1 = (unsigned)(mb >> 32);
        if (lane == 0) { LAS unsigned* sm = (LAS unsigned*)(lds + L_SELM) + tok * 4; sm[0] = a0; sm[1] = a1; sm[2] = b0; sm[3] = b1; }
        wm0 |= a0; wm1 |= a1; wm2 |= b0; wm3 |= b1; }
    if (lane == 0) { LAS unsigned* un = (LAS unsigned*)(lds + L_UN) + wid * 4; un[0] = wm0; un[1] = wm1; un[2] = wm2; un[3] = wm3; }
    __syncthreads();
    unsigned um0 = 0, um1 = 0, um2 = 0, um3 = 0;
    { const LAS unsigned* un = (const LAS unsigned*)(lds + L_UN);
#pragma unroll
      for (int w = 0; w < 8; ++w) { um0 |= un[w * 4 + 0]; um1 |= un[w * 4 + 1]; um2 |= un[w * 4 + 2]; um3 |= un[w * 4 + 3]; } }
    um0 = __builtin_amdgcn_readfirstlane(um0); um1 = __builtin_amdgcn_readfirstlane(um1); um2 = __builtin_amdgcn_readfirstlane(um2); um3 = __builtin_amdgcn_readfirstlane(um3);
    unsigned sm0, sm1, sm2, sm3; { const LAS unsigned* sm = (const LAS unsigned*)(lds + L_SELM) + tokl * 4; sm0 = sm[0]; sm1 = sm[1]; sm2 = sm[2]; sm3 = sm[3]; }
    wm0 = __builtin_amdgcn_readfirstlane(wm0); wm1 = __builtin_amdgcn_readfirstlane(wm1); wm2 = __builtin_amdgcn_readfirstlane(wm2); wm3 = __builtin_amdgcn_readfirstlane(wm3);
    m = -1e30f; l = 0.f; o[0] = f32x16{}; o[1] = f32x16{};
    {
        int j = next_bit(um0, um1, um2, um3, 0, cur), slot = 0;
        if (j <= cur) { LOADT(tl, ks_img, vs_img, j, true); STORET(tl, 0, true); }
        __syncthreads();
#pragma unroll 1
        while (j <= cur) {
            const int jn = next_bit(um0, um1, um2, um3, j + 1, cur);
            if (jn <= cur) LOADT(tl, ks_img, vs_img, jn, true);
            const bool wave_on = (pick4(wm0, wm1, wm2, wm3, j >> 5) >> (j & 31)) & 1u;
            if (wave_on) {
                qkt(p0, p1, (lptr)(lds + L_K + slot * 8192), qr, r32, hi);
                const bool en = (pick4(sm0, sm1, sm2, sm3, j >> 5) >> (j & 31)) & 1u;
                mask_rows(p0, p1, en ? 0.f : -INFINITY);
                if (j == cur) mask_range(p0, p1, 0, tokl, hi);
                online_step(p0, p1, m, l, o, wsf, r32, hi);
                pv(o, (lptr)(lds + L_V + slot * 8192), p0, p1, lane, hi);
            }
            if (jn <= cur) STORET(tl, slot ^ 1, true);
            __syncthreads();
            j = jn; slot ^= 1;
        }
    }
    l = half_swap_sum(l);
    accum_scaled(otot, o, g_sel / fmaxf(l, 1e-30f), wsf, r32, hi);
    m = -1e30f; l = 0.f; o[0] = f32x16{}; o[1] = f32x16{};
    {
        const int j0 = cur >= 8 ? cur - 8 : 0;
        LOADT(tl, kw_img, vw_img, j0, true); STORET(tl, 0, true); __syncthreads();
        int slot = 0;
#pragma unroll 1
        for (int j = j0; j <= cur; ++j) {
            if (j < cur) LOADT(tl, kw_img, vw_img, j + 1, true);
            qkt(p0, p1, (lptr)(lds + L_K + slot * 8192), qr, r32, hi);
            if (j == cur - 8 || j == cur) { const int lo = (j == cur - 8) ? tokl + 1 : 0, hh = (j == cur) ? tokl : 63; mask_range(p0, p1, lo, hh, hi); }
            online_step(p0, p1, m, l, o, wsf, r32, hi);
            pv(o, (lptr)(lds + L_V + slot * 8192), p0, p1, lane, hi);
            if (j < cur) STORET(tl, slot ^ 1, true);
            __syncthreads();
            slot ^= 1;
        }
    }
    l = half_swap_sum(l);
    accum_scaled(otot, o, g_win / fmaxf(l, 1e-30f), wsf, r32, hi);
    { const size_t rowb = (size_t)b * TS + t0 + 8 * wid + hi;
      const bf16_t* sab = (const bf16_t*)(ws + WS_SA) + rowb * 512 + g * 256 + r32; bf16_t* aob = (bf16_t*)(ws + WS_AOY) + rowb * 1024 + g * 256 + r32;
#pragma unroll
      for (int r = 0; r < 16; ++r)
#pragma unroll
        for (int d0 = 0; d0 < 2; ++d0) { const int co = (r & 3) * 64 + d0 * 32;
            aob[(2 * (r >> 2)) * 1024 + co] = (bf16_t)f2bf(otot[d0][r] * bf2f(sab[(2 * (r >> 2)) * 512 + co])); } }
#undef LOADT
#undef STORET
}

__device__ __forceinline__ void sample_unit(const Params& p, const Frame& F, int bs, int g) {
    unsigned char* ws = p.ws; LAS unsigned char* lds = F.lds;
    const int tid = F.tid, lane = F.lane, wid = F.wave;
    LAS float* q = (LAS float*)lds; LAS float* sc = (LAS float*)(lds + 1024); LAS float* impv = (LAS float*)(lds + 1024 + 4 * 1664 * 4);
    LAS int* sel = (LAS int*)(impv + 64); LAS float* red = (LAS float*)(sel + 16); LAS float* osum = red + 64;
    const size_t row = (size_t)MP + bs;
    __syncthreads();
    if (tid < 256) q[tid] = bf2f(((const bf16_t*)(ws + WS_QB))[row * 512 + g * 256 + tid]);
    __syncthreads();
    const int bg = bs * 2 + g;
    for (int c = tid; c < 128; c += NTHR) {
        float s[4] = {0.f, 0.f, 0.f, 0.f};
        if (c < 127) { const unsigned char* img = ws + WS_KC + (size_t)(bg * 2 + (c >> 6)) * 8192; const int key = c & 63;
            for (int ch = 0; ch < 8; ++ch) { const u32x4 w = *(const u32x4*)(img + ch * 1024 + key * 16);
                const float kf[8] = {bflo(w.x), bfhi(w.x), bflo(w.y), bfhi(w.y), bflo(w.z), bfhi(w.z), bflo(w.w), bfhi(w.w)};
#pragma unroll
                for (int h = 0; h < 4; ++h)
#pragma unroll
                    for (int e = 0; e < 8; ++e) s[h] += q[h * 64 + ch * 8 + e] * kf[e]; } }
#pragma unroll
        for (int h = 0; h < 4; ++h) sc[h * 1664 + c] = c < 127 ? s[h] : -INFINITY;
    }
    for (int i = tid; i < 512; i += NTHR) { const float* kp = p.out + O_WINS + ((size_t)(bs * 512 + i) * 2 + 0) * 128 + g * 64;
        float s[4] = {0.f, 0.f, 0.f, 0.f};
        for (int d4 = 0; d4 < 16; ++d4) { const f32x4 kv = *(const f32x4*)(kp + d4 * 4);
#pragma unroll
            for (int h = 0; h < 4; ++h) s[h] += (q[h * 64 + d4 * 4] * kv[0] + q[h * 64 + d4 * 4 + 1] * kv[1]) + (q[h * 64 + d4 * 4 + 2] * kv[2] + q[h * 64 + d4 * 4 + 3] * kv[3]); }
#pragma unroll
        for (int h = 0; h < 4; ++h) sc[h * 1664 + 1152 + i] = s[h]; }
    __syncthreads();
    auto softmax_head = [&](int off, int n) {
        if (wid < 4) { LAS float* sp = sc + wid * 1664 + off; float mx = -INFINITY;
            for (int i = lane; i < n; i += 64) mx = fmaxf(mx, sp[i]);
#pragma unroll
            for (int o2 = 1; o2 < 64; o2 <<= 1) mx = fmaxf(mx, __shfl_xor(mx, o2));
            float sm = 0.f;
            for (int i = lane; i < n; i += 64) { const float e = __builtin_amdgcn_exp2f(sp[i] - mx); sp[i] = e; sm += e; }
            sm = wave_sum(sm); const float inv = 1.f / fmaxf(sm, 1e-30f);
            for (int i = lane; i < n; i += 64) sp[i] *= inv; }
        __syncthreads();
    };
    softmax_head(0, 128);
    softmax_head(1152, 512);
    if (tid < 64) { float s = -1.f; const int j = tid;
        if (j < 33) { s = 0.f; for (int c = 4 * j - 1; c <= 4 * j + 3; ++c) if (c >= 0 && c < 127) s += (sc[c] + sc[1664 + c]) + (sc[2 * 1664 + c] + sc[3 * 1664 + c]);
            if (j == 0 || j == 31 || j == 32) s = 1e6f; }
        impv[j] = j < 33 ? s : -2.f; }
    __syncthreads();
    if (tid < 64) { const float sj = impv[tid]; int rk = 0; for (int i = 0; i < 33; ++i) { const float v = impv[i]; rk += (v > sj || (v == sj && i < tid)) ? 1 : 0; }
        if (tid < 33 && rk < 16) sel[rk] = tid; }
    __syncthreads();
    for (int e = tid; e < 1024; e += NTHR) { const int r = e >> 6, i = e & 63, j = sel[r], pos = j * 64 + i;
        float s[4] = {0.f, 0.f, 0.f, 0.f}; const bool ok = pos <= 2048;
        if (ok) { const float* kp = pos < 2048 ? p.cache + (((size_t)p.ptab[bs * 16 + (pos >> 7)] * 128 + (pos & 127)) * 4 + 2) * 128 + g * 64 : p.out + O_KVS + ((size_t)bs * 4 + 2) * 128 + g * 64;
            for (int d4 = 0; d4 < 16; ++d4) { const f32x4 kv = *(const f32x4*)(kp + d4 * 4);
#pragma unroll
                for (int h = 0; h < 4; ++h) s[h] += (q[h * 64 + d4 * 4] * kv[0] + q[h * 64 + d4 * 4 + 1] * kv[1]) + (q[h * 64 + d4 * 4 + 2] * kv[2] + q[h * 64 + d4 * 4 + 3] * kv[3]); } }
#pragma unroll
        for (int h = 0; h < 4; ++h) sc[h * 1664 + 128 + e] = ok ? s[h] : -INFINITY; }
    __syncthreads();
    softmax_head(128, 1024);
    const float* ngp = (const float*)(ws + WS_NG) + row * 32 + g * 12;
    float gc[4], gs[4], gwn[4];
#pragma unroll
    for (int h = 0; h < 4; ++h) { gc[h] = ngp[h * 3]; gs[h] = ngp[h * 3 + 1]; gwn[h] = ngp[h * 3 + 2]; }
    float acc[4] = {0.f, 0.f, 0.f, 0.f};
    for (int c = wid; c < 127; c += NWAVES) { const unsigned char* img = ws + WS_KC + KC_KIND_BYTES + (size_t)(bg * 2 + (c >> 6)) * 8192; const int key = c & 63;
        const float v = bf2f(*(const bf16_t*)(img + (lane >> 5) * 4096 + (key >> 4) * 1024 + (key & 15) * 64 + (lane & 31) * 2));
#pragma unroll
        for (int h = 0; h < 4; ++h) acc[h] += gc[h] * sc[h * 1664 + c] * v; }
    for (int e = wid; e < 1024; e += NWAVES) { const int r = e >> 6, i = e & 63, j = sel[r], pos = j * 64 + i;
        if (pos <= 2048) { const float* vp = pos < 2048 ? p.cache + (((size_t)p.ptab[bs * 16 + (pos >> 7)] * 128 + (pos & 127)) * 4 + 3) * 128 + g * 64 : p.out + O_KVS + ((size_t)bs * 4 + 3) * 128 + g * 64;
            const float v = vp[lane];
#pragma unroll
            for (int h = 0; h < 4; ++h) acc[h] += gs[h] * sc[h * 1664 + 128 + e] * v; } }
    for (int i = wid; i < 512; i += NWAVES) { const float v = p.out[O_WINS + ((size_t)(bs * 512 + i) * 2 + 1) * 128 + g * 64 + lane];
#pragma unroll
        for (int h = 0; h < 4; ++h) acc[h] += gwn[h] * sc[h * 1664 + 1152 + i] * v; }
#pragma unroll
    for (int h = 0; h < 4; ++h) osum[(wid * 4 + h) * 64 + lane] = acc[h];
    __syncthreads();
    if (tid < 256) { const int h = tid >> 6, d = tid & 63; float s = 0.f;
#pragma unroll
        for (int w = 0; w < 8; ++w) s += osum[(w * 4 + h) * 64 + d];
        const int col = (g * 4 + h) * 64 + d;
        ((bf16_t*)(ws + WS_AOY))[row * 1024 + col] = (bf16_t)f2bf(s * bf2f(((const bf16_t*)(ws + WS_SA))[row * 512 + col])); }
}
}
constexpr int LDS_BYTES = 147456;
constexpr int NPHASE = 8;

__global__ void __launch_bounds__(NTHR, 2) mk_fwd(Params p) {
    extern __shared__ __attribute__((aligned(16))) unsigned char lds_raw[];
    cg::grid_group grid = cg::this_grid();
    Frame F; F.lds = (LAS unsigned char*)lds_raw; F.tid = threadIdx.x; F.lane = F.tid & 63; F.wave = __builtin_amdgcn_readfirstlane(F.tid >> 6);
    F.G = gridDim.x; { const int bx = blockIdx.x; F.vcu = (F.G % 8 == 0) ? (bx % 8) * (F.G / 8) + bx / 8 : bx; }
    unsigned char* ws = p.ws;
    const int lo = p.ph_lo, hi = p.ph_hi;
#ifndef MK_PHASE_MASK
#define MK_PHASE_MASK 0xff
#endif
#define IN(k) (((MK_PHASE_MASK >> (k)) & 1) && lo <= (k) && (k) < hi)
#define SEAM(k) do { if (IN(k) && IN((k) + 1)) grid.sync(); } while (0)
    if (IN(0)) { phase0(p, F); } SEAM(0);
    if (IN(1)) { phase1(p, F); } SEAM(1);
    if (IN(2)) {
        { pg8::Gemm g{(const bf16_t*)(ws + WS_H), (const bf16_t*)(ws + WS_WINT), 1024, 1024, 1024}; SchedMain S{F.G, (int)blockIdx.x};
          EpiMain E{p.out, (bf16_t*)(ws + WS_QB), (bf16_t*)(ws + WS_CMPA) + (size_t)32768 * 1024, (bf16_t*)(ws + WS_CMPA + CMPA_KIND_BYTES) + (size_t)32768 * 1024, (bf16_t*)(ws + WS_KVI),
                    (bf16_t*)(ws + WS_SA), (bf16_t*)(ws + WS_U), (bf16_t*)(ws + WS_CBG), (bf16_t*)(ws + WS_GA), (bf16_t*)(ws + WS_GB), (const float*)(ws + WS_ROPE)};
          pg8::gemm_phase(F.lds, g, S, E); }
        { pg8::Gemm g{(const bf16_t*)(ws + WS_CMPA), (const bf16_t*)(ws + WS_WC1), 1024, 2048, 2048}; SchedCmp S{F.G, (int)blockIdx.x, 0, 128};
          EpiCmp1 E{(bf16_t*)(ws + WS_HID), (const float*)(ws + WS_PEB)};
          pg8::gemm_phase(F.lds, g, S, E); }
    }
    SEAM(2);
    if (IN(3)) {
        const int c = (int)blockIdx.x;
        if (c < 16) {
            pg8::Gemm g{(const bf16_t*)(ws + WS_CMPA), (const bf16_t*)(ws + WS_WC1), 1024, 2048, 2048}; SchedCmp S{F.G, c, 128, 8};
            EpiCmp1 E{(bf16_t*)(ws + WS_HID), (const float*)(ws + WS_PEB)};
            pg8::gemm_phase(F.lds, g, S, E);
            __threadfence(); __syncthreads();
            cmp2_item(ws, c / 8, (128 + c % 8) * 256 + F.wave * 32, F.lane);
        } else {
            const int gw = (c - 16) * NWAVES + F.wave, NGW = (F.G - 16) * NWAVES;
            for (int it = gw; it < 2048 + MALL; it += NGW) {
                if (it < 2048) cmp2_item(ws, it >> 10, (it & 1023) * 32, F.lane);
                else ybin_row(p, it - 2048, F.lane);
            }
        }
    }
    SEAM(3);
    if (IN(4)) {
        for (int u = F.vcu; u < 256; u += F.G) { const int bgi = u >> 6, x = u & 63;
#pragma unroll 1
            for (int i2 = 0; i2 < 2; ++i2) att::prompt_unit(p, F, bgi >> 1, bgi & 1, i2 == 0 ? 127 - x : x); }
        for (int u = F.vcu; u < 256; u += F.G) att::sample_unit(p, F, u >> 1, u & 1);
    }
    SEAM(4);
    if (IN(5)) { pg8::Gemm g{(const bf16_t*)(ws + WS_AOY), (const bf16_t*)(ws + WS_WBR), 1024, 1024, 512}; SchedE1 S{F.G, (int)blockIdx.x};
        EpiE1 E{(const bf16_t*)(ws + WS_GA), (const bf16_t*)(ws + WS_GB), (float*)(ws + WS_T1), (bf16_t*)(ws + WS_OPRE)};
        pg8::gemm_phase(F.lds, g, S, E); }
    SEAM(5);
    if (IN(6)) { pg8::Gemm g{(const bf16_t*)(ws + WS_OPRE), (const bf16_t*)(ws + WS_WOUT), 1024, 1024, 1024}; SchedE2 S{F.G, (int)blockIdx.x};
        EpiE2 E{(float*)(ws + WS_O), (float*)(ws + WS_SSQP)};
        pg8::gemm_phase(F.lds, g, S, E); }
    SEAM(6);
    if (IN(7)) { const int gw = F.vcu * NWAVES + F.wave, NGW = F.G * NWAVES;
        for (int row = gw; row < MALL; row += NGW) final_row(p, p.out, row, F.lane); }
#undef IN
#undef SEAM
}
}

static mk::Params make_params(void* const* d_in, float* out, unsigned char* ws) {
    mk::Params p{};
    p.xp = (const float*)d_in[0]; p.xs = (const float*)d_in[1]; p.cache = (const float*)d_in[2]; p.swin = (const float*)d_in[3]; p.sconv = (const float*)d_in[4]; p.ptab = (const int*)d_in[5];
    p.cp = (const float*)d_in[6]; p.cs = (const float*)d_in[7]; p.w_ada = (const float*)d_in[8]; p.b_ada = (const float*)d_in[9]; p.g_pre = (const float*)d_in[10]; p.g_post = (const float*)d_in[11];
    p.w_in = (const float*)d_in[12]; p.pe = (const float*)d_in[13]; p.w1 = (const float*)d_in[14]; p.w2 = (const float*)d_in[15]; p.conv_w = (const float*)d_in[16];
    p.wba = (const float*)d_in[17]; p.wbb = (const float*)d_in[18]; p.wout = (const float*)d_in[19];
    p.out = out; p.ws = ws; p.ph_lo = 0; p.ph_hi = mk::NPHASE;
    return p;
}
static int mk_grid() {
    static int grid = 0;
    if (grid == 0) {
        int dev = 0, cus = 0, per_cu = 0;
        (void)hipGetDevice(&dev); (void)hipDeviceGetAttribute(&cus, hipDeviceAttributeMultiprocessorCount, dev);
        (void)hipFuncSetAttribute((const void*)mk::mk_fwd, hipFuncAttributeMaxDynamicSharedMemorySize, mk::LDS_BYTES);
        (void)hipOccupancyMaxActiveBlocksPerMultiprocessor(&per_cu, (const void*)mk::mk_fwd, mk::NTHR, mk::LDS_BYTES);
        if (per_cu < 1) { fprintf(stderr, "mk: occupancy query says %d blocks per CU\n", per_cu); per_cu = 1; }
        grid = cus;
        (void)hipGetLastError();
    }
    return grid;
}
static void mk_launch(mk::Params p, int lo, int hi, hipStream_t stream) {
    p.ph_lo = lo; p.ph_hi = hi; const int grid = mk_grid();
    if (hi - lo > 1) { void* args[] = {&p}; hipError_t e = hipLaunchCooperativeKernel((const void*)mk::mk_fwd, dim3(grid), dim3(mk::NTHR), args, mk::LDS_BYTES, stream);
        if (e != hipSuccess) fprintf(stderr, "cooperative launch failed: %s (grid %d)\n", hipGetErrorString(e), grid); }
    else hipLaunchKernelGGL(mk::mk_fwd, dim3(grid), dim3(mk::NTHR), mk::LDS_BYTES, stream, p);
}
extern "C" void kernel_launch(void* const* d_in, const int* in_sizes, int n_in, void* d_out, int out_size, void* d_ws, size_t ws_size, hipStream_t stream) {
    (void)in_sizes; (void)n_in; (void)out_size; (void)ws_size;
    mk::Params p = make_params(d_in, (float*)d_out, (unsigned char*)d_ws);
#if defined(MK_MULTI_LAUNCH)
    for (int ph = 0; ph < mk::NPHASE; ++ph) mk_launch(p, ph, ph + 1, stream);
#else
    mk_launch(p, 0, mk::NPHASE, stream);
#endif
}
```

```cpp
#include <hip/hip_runtime.h>
#include <hip/hip_cooperative_groups.h>
#include <cstdio>
#include <cstdint>
#include <cmath>
namespace cg = cooperative_groups;
#define LAS __attribute__((address_space(3)))
typedef unsigned short bf16_t;
typedef short bf16x8 __attribute__((ext_vector_type(8)));
typedef float f32x4 __attribute__((ext_vector_type(4)));
typedef float f32x2 __attribute__((ext_vector_type(2)));
typedef float f32x16 __attribute__((ext_vector_type(16)));
typedef unsigned u32x4 __attribute__((ext_vector_type(4)));
typedef unsigned u32x2 __attribute__((ext_vector_type(2)));

namespace mk {
constexpr int DM = 1024, TS = 8192, MP = 16384, SB = 128, MALL = 16512, MPAD = 16640, INW = 5912, NV = 5888;
constexpr int C_G = 1280, C_A = 1304, C_CB = 1816, C_CC = 2328, C_CX = 2840, C_CG = 3352, C_GA = 3864;
constexpr size_t O_YP = 0, O_YS = 16777216, O_KVP = 16908288, O_WINP = 25296896, O_CSP = 25559040, O_KVS = 25561088, O_WINS = 25626624, O_CSS = 42403840, O_END = 42534912;
constexpr float QSCALE = 0.125f * 1.4426950408889634f;
constexpr int NWAVES = 8, NTHR = 512;

constexpr size_t MiB = 1u << 20;
constexpr size_t WS_CTL = 0;
constexpr size_t CTL_BYTES = 4 * MiB;
constexpr size_t WS_MOD = 4 * MiB;
constexpr size_t WS_ROPE = 6 * MiB;
constexpr size_t WS_PEBP = 7 * MiB;
constexpr size_t WS_PEB = 7 * MiB + 65536;
constexpr size_t WS_WGT = 7 * MiB + 262144;
constexpr size_t WS_NG = 8 * MiB;
constexpr size_t WS_SPART = 13 * MiB;
constexpr size_t WS_SSQP = 11 * MiB;
constexpr size_t WS_WINT = 16 * MiB;
constexpr size_t WS_WBR = 28 * MiB;
constexpr size_t WS_WOUT = 30 * MiB;
constexpr size_t WS_WC1 = 32 * MiB;
constexpr size_t WS_WC2 = 34 * MiB;
constexpr size_t WS_H = 36 * MiB;
constexpr size_t WS_QB = 72 * MiB;
constexpr size_t WS_SA = 90 * MiB;
constexpr size_t WS_U = 108 * MiB;
constexpr size_t WS_CBG = 126 * MiB;
constexpr size_t WS_GA = 144 * MiB;
constexpr size_t WS_GB = 178 * MiB;
constexpr size_t WS_KVI = 212 * MiB;
constexpr size_t WS_KC = 230 * MiB;
constexpr size_t KC_KIND_BYTES = (size_t)34816 * 64 * 2;
constexpr size_t WS_HID = 240 * MiB;
constexpr size_t HID_KIND_BYTES = (size_t)34816 * 256 * 2;
constexpr size_t WS_CMPA = 276 * MiB;
constexpr size_t CMPA_KIND_BYTES = (size_t)(34816 + 2) * 1024 * 2;
constexpr size_t WS_AOY = 420 * MiB;
constexpr size_t WS_T1 = 456 * MiB;
constexpr size_t WS_OPRE = 524 * MiB;
constexpr size_t WS_O = 560 * MiB;
constexpr size_t WS_END = 628 * MiB;
constexpr size_t WS_OUT2 = 640 * MiB;
constexpr size_t WS_ORC = 1024 * MiB;

struct Params {
    const float *xp, *xs, *cache, *swin, *sconv; const int* ptab; const float *cp, *cs, *w_ada, *b_ada, *g_pre, *g_post, *w_in, *pe, *w1, *w2, *conv_w, *wba, *wbb, *wout;
    float* out; unsigned char* ws; int ph_lo, ph_hi;
};

__device__ __forceinline__ float fast_rcp(float x) { return __builtin_amdgcn_rcpf(x); }
__device__ __forceinline__ float sigm(float x) { return fast_rcp(1.f + __expf(-x)); }
__device__ __forceinline__ float silu(float x) { return x * fast_rcp(1.f + __expf(-x)); }
__device__ __forceinline__ unsigned f2bf(float f) { unsigned u = __builtin_bit_cast(unsigned, f); return (u + 0x7fffu + ((u >> 16) & 1u)) >> 16; }
__device__ __forceinline__ unsigned pk2(float lo, float hi) { typedef __bf16 bf16x2_t __attribute__((ext_vector_type(2))); f32x2 v = {lo, hi}; bf16x2_t b = __builtin_convertvector(v, bf16x2_t); return __builtin_bit_cast(unsigned, b); }
__device__ __forceinline__ float bf2f(unsigned short b) { return __builtin_bit_cast(float, (unsigned)b << 16); }
__device__ __forceinline__ float bflo(unsigned w) { return __builtin_bit_cast(float, w << 16); }
__device__ __forceinline__ float bfhi(unsigned w) { return __builtin_bit_cast(float, w & 0xffff0000u); }

namespace pg8 {
constexpr int BM = 256, BK = 64, HALF = 128, HTB = HALF * BK * 2, STAGE_BYTES = 8 * HTB, NXCD = 8, WGM = 8;
__host__ __device__ __forceinline__ int lds_byte(int r, int c) { const int st = (r >> 4) * 2 + (c >> 5), rr = r & 15, cc = c & 31, ob = rr * 64 + cc * 2; return st * 1024 + (ob ^ (((ob >> 9) & 1) << 5)); }
__host__ __device__ __forceinline__ void stage_rc(int b, int& R, int& C) { const int st = b / 1024, sb = b % 1024, swz = sb ^ (((sb >> 9) & 1) << 5); R = (st >> 1) * 16 + swz / 64; C = (st & 1) * 32 + (swz % 64) / 2; }
__host__ __device__ __forceinline__ int perm32(int rho) { const int n = rho >> 4, i = rho & 15; return 8 * (i >> 2) + 4 * n + (i & 3); }

struct Unit { int pm, pn, aux; size_t aoff, boff; };
struct Gemm { const bf16_t* A; const bf16_t* Bt; int lda, ldb, K; };

__device__ __forceinline__ bool static_tile_L(long L, int nM, int nN, int& pm, int& pn);
__device__ __forceinline__ bool static_tile(int i, int G, int c, int nM, int nN, int& pm, int& pn) { return static_tile_L((long)i * G + c, nM, nN, pm, pn); }
__device__ __forceinline__ bool static_tile_L(long L, int nM, int nN, int& pm, int& pn) {
    const int nwg = nM * nN; if (L >= nwg) return false;
    int wgid = (int)L; { const int q = nwg / NXCD, r = nwg % NXCD, xcd = wgid % NXCD, off = wgid / NXCD; wgid = (xcd < r ? xcd * (q + 1) : r * (q + 1) + (xcd - r) * q) + off; }
    const int nig = WGM * nN, gid = wgid / nig, fm = gid * WGM, gsz = (nM - fm) < WGM ? (nM - fm) : WGM;
    pm = fm + ((wgid % nig) % gsz); pn = (wgid % nig) / gsz; return true;
}

template <class Epi, class Sched>
__device__ __forceinline__ void gemm_phase(LAS unsigned char* lds, const Gemm g, const Sched& S, const Epi& E) {
    const int tid = threadIdx.x, wid = __builtin_amdgcn_readfirstlane(tid >> 6), lane = tid & 63, wr = wid >> 2, wc = wid & 3, fr = lane & 15, fq = lane >> 4;
    const int nt = g.K / BK;
    unsigned voffA[2], voffB[2];
#pragma unroll
    for (int i = 0; i < 2; ++i) { int R, C; stage_rc(tid * 16 + i * 8192, R, C); const int Rb = Epi::PERM ? ((R & ~31) + perm32(R & 31)) : R;
        voffA[i] = (unsigned)(R * g.lda + C) * 2u; voffB[i] = (unsigned)(Rb * g.ldb + C) * 2u; }
    const size_t kstep = (size_t)(BK * 2);
    const size_t hstepA = (size_t)HALF * g.lda * 2, hstepB = (size_t)HALF * g.ldb * 2;
    const unsigned ldsw = (unsigned)wid * 1024u;
    const int aoff = lds_byte(wr * 64 + fr, fq * 8), boff = lds_byte(wc * 32 + fr, fq * 8);
#define PG8_SA(b, h) (((b) * 2 + (h)) * HTB)
#define PG8_SB(b, h) ((4 + (b) * 2 + (h)) * HTB)
#define PG8_STAGE(bufoff, gbase, voff) do { _Pragma("unroll") for (int _i = 0; _i < 2; ++_i) \
        __builtin_amdgcn_global_load_lds((const unsigned*)((const char*)(gbase) + (voff)[_i]), (LAS unsigned*)(lds + (bufoff) + ldsw + _i * 8192), 16, 0, 0); } while (0)
#define PG8_LDA(dst, b, h) do { _Pragma("unroll") for (int m = 0; m < 4; ++m) _Pragma("unroll") for (int k = 0; k < 2; ++k) dst[m][k] = *(const LAS bf16x8*)(lds + PG8_SA(b, h) + aoff + m * 2048 + k * 1024); } while (0)
#define PG8_LDB(dst, b, h) do { _Pragma("unroll") for (int n = 0; n < 2; ++n) _Pragma("unroll") for (int k = 0; k < 2; ++k) dst[n][k] = *(const LAS bf16x8*)(lds + PG8_SB(b, h) + boff + n * 2048 + k * 1024); } while (0)
#define PG8_MMA(ai, bj, At, Bt) do { __builtin_amdgcn_s_setprio(1); _Pragma("unroll") for (int m = 0; m < 4; ++m) _Pragma("unroll") for (int n = 0; n < 2; ++n) _Pragma("unroll") for (int k = 0; k < 2; ++k) \
        acc[ai][bj][m][n] = __builtin_amdgcn_mfma_f32_16x16x32_bf16(Bt[n][k], At[m][k], acc[ai][bj][m][n], 0, 0, 0); __builtin_amdgcn_s_setprio(0); } while (0)
#define PG8_WAIT_V(n) asm volatile("s_waitcnt vmcnt(" #n ")" ::: "memory")
#define PG8_WAIT_L(n) asm volatile("s_waitcnt lgkmcnt(" #n ")" ::: "memory")
#define PG8_BAR __builtin_amdgcn_s_barrier()
#define PG8_SCHED __builtin_amdgcn_sched_barrier(0)
    Unit cur, nxt; int ui = 0;
    if (!S.next(0, cur)) return;
    f32x4 acc[2][2][4][2];
#pragma unroll
    for (int a = 0; a < 2; ++a)
#pragma unroll
        for (int b = 0; b < 2; ++b)
#pragma unroll
            for (int m = 0; m < 4; ++m)
#pragma unroll
                for (int n = 0; n < 2; ++n) acc[a][b][m][n] = (f32x4){0.f, 0.f, 0.f, 0.f};
    bf16x8 At[4][2], B0[2][2], B1[2][2];
    const char* cA = (const char*)g.A + cur.aoff; const char* cB = (const char*)g.Bt + cur.boff;
    PG8_STAGE(PG8_SB(0, 0), cB, voffB); PG8_STAGE(PG8_SB(0, 1), cB + hstepB, voffB); PG8_STAGE(PG8_SA(0, 0), cA, voffA); PG8_STAGE(PG8_SA(0, 1), cA + hstepA, voffA);
    if (wr == 1) PG8_BAR;
    PG8_WAIT_V(2); PG8_BAR;
    PG8_STAGE(PG8_SB(1, 0), cB + kstep, voffB); PG8_STAGE(PG8_SA(1, 0), cA + kstep, voffA); PG8_STAGE(PG8_SB(1, 1), cB + hstepB + kstep, voffB);
    PG8_WAIT_V(6); PG8_BAR;
    for (;;) {
        const bool has_next = S.next(ui + 1, nxt);
        const char* nA = has_next ? (const char*)g.A + nxt.aoff : cA; const char* nB = has_next ? (const char*)g.Bt + nxt.boff : cB;
        for (int t = 0; t < nt; t += 2) {
            if constexpr (Epi::HAS_MID) { if (t == (nt >> 1)) { int fr_ = fr, fq_ = fq; asm volatile("" : "+v"(fr_), "+v"(fq_)); E.mid(acc, cur, wr, wc, fr_, fq_); } }
            const bool last = (t == nt - 2);
            const char* a1 = cA + (size_t)(t + 1) * kstep;
            const char* a2 = last ? nA : cA + (size_t)(t + 2) * kstep; const char* b2 = last ? nB : cB + (size_t)(t + 2) * kstep;
            const char* a3 = a2 + kstep; const char* b3 = b2 + kstep;
            PG8_LDB(B0, 0, 0); PG8_LDB(B1, 0, 1); PG8_SCHED; PG8_LDA(At, 0, 0); PG8_STAGE(PG8_SA(1, 1), a1 + hstepA, voffA);
            PG8_WAIT_V(8); PG8_WAIT_L(0); PG8_BAR; PG8_MMA(0, 0, At, B0); PG8_MMA(0, 1, At, B1); PG8_BAR; PG8_SCHED;
            PG8_LDA(At, 0, 1); PG8_STAGE(PG8_SB(0, 0), b2, voffB); PG8_STAGE(PG8_SB(0, 1), b2 + hstepB, voffB); PG8_STAGE(PG8_SA(0, 0), a2, voffA);
            PG8_WAIT_V(8); PG8_WAIT_L(0); PG8_BAR; PG8_MMA(1, 0, At, B0); PG8_MMA(1, 1, At, B1); PG8_BAR; PG8_SCHED;
            PG8_LDB(B0, 1, 0); PG8_LDB(B1, 1, 1); PG8_SCHED; PG8_LDA(At, 1, 0); PG8_STAGE(PG8_SA(0, 1), a2 + hstepA, voffA);
            PG8_WAIT_V(8); PG8_WAIT_L(0); PG8_BAR; PG8_MMA(0, 0, At, B0); PG8_MMA(0, 1, At, B1); PG8_BAR; PG8_SCHED;
            PG8_LDA(At, 1, 1); PG8_STAGE(PG8_SB(1, 0), b3, voffB); PG8_STAGE(PG8_SB(1, 1), b3 + hstepB, voffB); PG8_STAGE(PG8_SA(1, 0), a3, voffA);
            PG8_WAIT_V(8); PG8_WAIT_L(0); PG8_BAR; PG8_MMA(1, 0, At, B0); PG8_MMA(1, 1, At, B1); PG8_BAR; PG8_SCHED;
        }
        if (wr == 0) PG8_BAR;
        { int fr_ = fr, fq_ = fq; asm volatile("" : "+v"(fr_), "+v"(fq_)); E(acc, cur, wr, wc, fr_, fq_); }
        if constexpr (Epi::HAS_BETWEEN) E.between(ui, wid, lane);
        if (!has_next) break;
#pragma unroll
        for (int a = 0; a < 2; ++a)
#pragma unroll
            for (int b = 0; b < 2; ++b)
#pragma unroll
                for (int m = 0; m < 4; ++m)
#pragma unroll
                    for (int n = 0; n < 2; ++n) acc[a][b][m][n] = (f32x4){0.f, 0.f, 0.f, 0.f};
        cur = nxt; cA = nA; cB = nB; ++ui;
        if (wr == 1) PG8_BAR;
    }
    PG8_WAIT_V(0);
    PG8_BAR;
#undef PG8_SA
#undef PG8_SB
#undef PG8_STAGE
#undef PG8_LDA
#undef PG8_LDB
#undef PG8_MMA
#undef PG8_WAIT_V
#undef PG8_WAIT_L
#undef PG8_BAR
#undef PG8_SCHED
}
}

typedef f32x4 Acc[2][2][4][2];

constexpr int N_CACHE_ITEMS = 16384;
__device__ __forceinline__ void cache_load(const float* cache, const int* ptab, int r, int lane, f32x4 (&v)[16]) {
    const int tok0 = r * 16, bs = tok0 >> 11, t0 = tok0 & 2047; const int phys = ptab[bs * 16 + (t0 >> 7)];
    const float* src = cache + ((size_t)phys * 128 + (t0 & 127)) * 512 + lane * 4;
#pragma unroll
    for (int j = 0; j < 16; ++j) v[j] = *(const f32x4*)(src + (size_t)j * 512);
}
__device__ __forceinline__ void cache_store(unsigned char* ws, int r, int lane, const f32x4 (&v)[16]) {
    const int tok0 = r * 16, bs = tok0 >> 11, t0 = tok0 & 2047;
    const int kind = lane >> 5, g = (lane >> 4) & 1, d = (lane & 15) * 4;
    bf16_t* dst = (bf16_t*)(ws + WS_CMPA + (size_t)kind * CMPA_KIND_BYTES) + ((size_t)(bs * 2 + g) * 2048 + t0) * 64 + d;
#pragma unroll
    for (int j = 0; j < 16; ++j) { u32x2 w; w.x = pk2(v[j][0], v[j][1]); w.y = pk2(v[j][2], v[j][3]); *(u32x2*)(dst + j * 64) = w; }
}
__device__ __forceinline__ void cache_span(const float* cache, const int* ptab, unsigned char* ws, int lo, int hi, int step, int lane) {
    f32x4 va[16], vb[16];
    if (lo < hi) cache_load(cache, ptab, lo, lane, va);
#pragma unroll 1
    for (int it = lo; it < hi; it += 2 * step) {
        if (it + step < hi) cache_load(cache, ptab, it + step, lane, vb);
        cache_store(ws, it, lane, va);
        if (it + 2 * step < hi) cache_load(cache, ptab, it + 2 * step, lane, va);
        if (it + step < hi) cache_store(ws, it + step, lane, vb); }
}

struct EpiMain {
    static constexpr bool PERM = true, HAS_MID = false, HAS_BETWEEN = true;
    float* out; bf16_t *Qb, *CMPAp0, *CMPAp1, *KVI, *SA, *U, *CBG, *GA, *GB; const float* rope;
    const float* cache; const int* ptab; unsigned char* wsb; int c, G; const float* conv_w; bf16_t* AOYb;
    __device__ __forceinline__ void between(int ui, int wid, int lane) const {
        if (G != 256 || ui != c % 5) return;
        const int lo = c < 215 ? c * 58 : 215 * 58 + (c - 215) * 96, n = c < 215 ? 58 : 96; const int hi = lo + n < N_CACHE_ITEMS ? lo + n : N_CACHE_ITEMS;
        cache_span(cache, ptab, wsb, lo + wid, hi, 8, lane);
        asm volatile("s_waitcnt vmcnt(0)" ::: "memory");
    }
    __device__ __forceinline__ void operator()(const Acc& acc, const pg8::Unit& u, int wr, int wc, int fr, int fq) const {
        const int pn = u.pn;
        const int lane16 = fq;
        f32x4 ncs0 = {0.f, 0.f, 0.f, 0.f}, ncs1 = ncs0, nsn0 = ncs0, nsn1 = ncs0, uprev = ncs0;
#pragma unroll
        for (int ai = 0; ai < 2; ++ai)
#pragma unroll
            for (int m = 0; m < 4; ++m) {
                asm volatile("" ::: "memory");
                const int row = u.pm * 256 + ai * 128 + wr * 64 + m * 16 + fr;
                const bool rok = row < MALL;
                const bool prompt = row < MP;
                const int pos = prompt ? (row & (TS - 1)) : 2048;
                if (pn < 5) {
                    const bool isq = pn < 2;
                    const bool ropelane = ((wc & 1) == 0) && (lane16 < 2);
                    if (ai == 0 && m == 0) { if (ropelane) { const float* rp = rope + (size_t)pos * 16; ncs0 = *(const f32x4*)(rp); ncs1 = *(const f32x4*)(rp + 4); nsn0 = *(const f32x4*)(rp + 8); nsn1 = *(const f32x4*)(rp + 12); } }
                    const f32x4 cs0 = ncs0, cs1 = ncs1, sn0 = nsn0, sn1 = nsn1;
                    if (!(ai == 1 && m == 3)) { const int nrow = u.pm * 256 + (m == 3 ? 128 : ai * 128) + wr * 64 + ((m + 1) & 3) * 16 + fr; const int npos = nrow < MP ? (nrow & (TS - 1)) : 2048;
                        if (ropelane) { const float* rp = rope + (size_t)npos * 16; ncs0 = *(const f32x4*)(rp); ncs1 = *(const f32x4*)(rp + 4); nsn0 = *(const f32x4*)(rp + 8); nsn1 = *(const f32x4*)(rp + 12); } }
#pragma unroll
                    for (int bj = 0; bj < 2; ++bj) {
                        f32x4 v0 = acc[ai][bj][m][0], v1 = acc[ai][bj][m][1];
                        const bool dorope = isq || (bj == 0);
                        if (dorope) {
                            f32x4 p0, p1;
#pragma unroll
                            for (int j = 0; j < 4; ++j) { p0[j] = __shfl_xor(v0[j], 16); p1[j] = __shfl_xor(v1[j], 16); }
                            if (ropelane) {
                                if (lane16 == 0) { v0 = v0 * cs0 - p0 * sn0; v1 = v1 * cs1 - p1 * sn1; }
                                else { v0 = p0 * sn0 + v0 * cs0; v1 = p1 * sn1 + v1 * cs1; }
                            }
                        }
                        if (!rok) continue;
                        if (isq) {
                            u32x4 w; w.x = pk2(v0[0] * QSCALE, v0[1] * QSCALE); w.y = pk2(v0[2] * QSCALE, v0[3] * QSCALE); w.z = pk2(v1[0] * QSCALE, v1[1] * QSCALE); w.w = pk2(v1[2] * QSCALE, v1[3] * QSCALE);
                            *(u32x4*)(Qb + (size_t)row * 512 + pn * 256 + bj * 128 + wc * 32 + fq * 8) = w;
                        } else {
                            const int kind = 2 * (pn - 2) + bj, g = wc >> 1, dim0 = 32 * (wc & 1) + 8 * fq;
                            if (prompt) {
                                const int b = row >> 13, t = row & (TS - 1), bg = b * 2 + g;
                                if (kind < 4) { float* o = out + O_KVP + ((size_t)row * 4 + kind) * 128 + g * 64 + dim0; *(f32x4*)o = v0; *(f32x4*)(o + 4) = v1; }
                                else if (t >= TS - 512) { float* o = out + O_WINP + ((size_t)(b * 512 + t - (TS - 512)) * 2 + (kind - 4)) * 128 + g * 64 + dim0; *(f32x4*)o = v0; *(f32x4*)(o + 4) = v1; }
                                u32x4 w; w.x = pk2(v0[0], v0[1]); w.y = pk2(v0[2], v0[3]); w.z = pk2(v1[0], v1[1]); w.w = pk2(v1[2], v1[3]);
                                if (kind < 2) { bf16_t* base = kind ? CMPAp1 : CMPAp0; *(u32x4*)(base + ((size_t)bg * TS + t) * 64 + dim0) = w; }
                                else {
                                    unsigned char* img = (unsigned char*)KVI + ((size_t)((kind - 2) * 4 + bg) * 128 + (t >> 6)) * 8192; const int key = t & 63;
                                    if ((kind & 1) == 0) *(u32x4*)(img + (dim0 >> 3) * 1024 + key * 16) = w;
                                    else { const int k16 = key & 15, pp = 8 * ((k16 >> 2) & 1) + 4 * (k16 >> 3) + (k16 & 3); unsigned char* vq = img + (key >> 4) * 2048 + dim0 * 32 + pp * 2;
                                        *(bf16_t*)(vq) = (bf16_t)w.x; *(bf16_t*)(vq + 32) = (bf16_t)(w.x >> 16); *(bf16_t*)(vq + 64) = (bf16_t)w.y; *(bf16_t*)(vq + 96) = (bf16_t)(w.y >> 16);
                                        *(bf16_t*)(vq + 128) = (bf16_t)w.z; *(bf16_t*)(vq + 160) = (bf16_t)(w.z >> 16); *(bf16_t*)(vq + 192) = (bf16_t)w.w; *(bf16_t*)(vq + 224) = (bf16_t)(w.w >> 16); }
                                }
                            } else {
                                const int bs = row - MP;
                                float* o = kind < 4 ? out + O_KVS + ((size_t)bs * 4 + kind) * 128 + g * 64 + dim0 : out + O_WINS + ((size_t)(bs * 512 + 511) * 2 + (kind - 4)) * 128 + g * 64 + dim0;
                                *(f32x4*)o = v0; *(f32x4*)(o + 4) = v1;
                            }
                        }
                    }
                } else if (pn < 7) {
                    if (!rok) continue;
#pragma unroll
                    for (int bj = 0; bj < 2; ++bj) { const f32x4 v0 = acc[ai][bj][m][0], v1 = acc[ai][bj][m][1];
                        u32x4 w; w.x = pk2(silu(v0[0]), silu(v0[1])); w.y = pk2(silu(v0[2]), silu(v0[3])); w.z = pk2(silu(v1[0]), silu(v1[1])); w.w = pk2(silu(v1[2]), silu(v1[3]));
                        *(u32x4*)(SA + (size_t)row * 512 + (pn - 5) * 256 + bj * 128 + wc * 32 + fq * 8) = w; }
                } else if (pn < 15) {
                    if (!rok) continue;
                    const f32x4 cb = acc[ai][0][m][0], cg = acc[ai][0][m][1], cc = acc[ai][1][m][0], cx = acc[ai][1][m][1];
                    const int c0 = 64 * (pn - 7) + 16 * wc + 4 * fq;
                    const f32x4 uu = cc * cx; f32x4 cbg;
#pragma unroll
                    for (int j = 0; j < 4; ++j) cbg[j] = cb[j] * silu(cg[j]);
                    f32x4 s1, s2;
                    { const int l1 = (fq << 4) | ((fr - 1) & 15), l2 = (fq << 4) | ((fr - 2) & 15);
#pragma unroll
                      for (int j = 0; j < 4; ++j) { s1[j] = __shfl(fr == 15 ? uprev[j] : uu[j], l1); s2[j] = __shfl(fr >= 14 ? uprev[j] : uu[j], l2); } }
                    uprev = uu;
                    const bool edge_lo = (m == 0) && (fr < 2), edge_hi = (m == 3) && (fr >= 14);
                    if (prompt && !edge_lo) { const f32x4 w0 = *(const f32x4*)(conv_w + c0), w1 = *(const f32x4*)(conv_w + 512 + c0), w2 = *(const f32x4*)(conv_w + 1024 + c0);
                        float o[4];
#pragma unroll
                        for (int j = 0; j < 4; ++j) o[j] = cbg[j] * (w0[j] * s2[j] + w1[j] * s1[j] + w2[j] * uu[j]);
                        u32x2 wo; wo.x = pk2(o[0], o[1]); wo.y = pk2(o[2], o[3]); *(u32x2*)(AOYb + (size_t)row * 1024 + 512 + c0) = wo; }
                    if (!prompt || edge_lo || edge_hi) { u32x2 wu; wu.x = pk2(uu[0], uu[1]); wu.y = pk2(uu[2], uu[3]); *(u32x2*)(U + (size_t)row * 512 + c0) = wu; }
                    if (!prompt || edge_lo) { u32x2 wc2; wc2.x = pk2(cbg[0], cbg[1]); wc2.y = pk2(cbg[2], cbg[3]); *(u32x2*)(CBG + (size_t)row * 512 + c0) = wc2; }
                    if (prompt) { const int t = row & (TS - 1); if (t >= TS - 2) *(f32x4*)(out + O_CSP + ((size_t)(row >> 13) * 2 + (t - (TS - 2))) * 512 + c0) = uu; }
                    else *(f32x4*)(out + O_CSS + ((size_t)(row - MP) * 2 + 1) * 512 + c0) = uu;
                } else {
                    if (!rok) continue;
                    const int col = (pn - 15) * 128 + wc * 32 + fq * 8;
                    const f32x4 a0 = acc[ai][0][m][0], a1 = acc[ai][0][m][1], b0 = acc[ai][1][m][0], b1 = acc[ai][1][m][1];
                    float rr[8], gg[8];
#pragma unroll
                    for (int j = 0; j < 4; ++j) { const float ea0 = 1.f + __expf(-a0[j]), eb0 = 1.f + __expf(-b0[j]), ea1 = 1.f + __expf(-a1[j]), eb1 = 1.f + __expf(-b1[j]);
                        const float r0 = fast_rcp(ea0 * eb0), r1 = fast_rcp(ea1 * eb1);
                        rr[j] = eb0 * eb0 * r0; gg[j] = ea0 * r0; rr[4 + j] = eb1 * eb1 * r1; gg[4 + j] = ea1 * r1; }
                    u32x4 wr_, wg_; wr_.x = pk2(rr[0], rr[1]); wr_.y = pk2(rr[2], rr[3]); wr_.z = pk2(rr[4], rr[5]); wr_.w = pk2(rr[6], rr[7]);
                    wg_.x = pk2(gg[0], gg[1]); wg_.y = pk2(gg[2], gg[3]); wg_.z = pk2(gg[4], gg[5]); wg_.w = pk2(gg[6], gg[7]);
                    *(u32x4*)(GA + (size_t)row * 1024 + col) = wr_; *(u32x4*)(GB + (size_t)row * 1024 + col) = wg_;
                }
            }
    }
};
struct SchedMain {
    int G, c;
    __device__ __forceinline__ bool next(int i, pg8::Unit& u) const {
        int pm, pn; if (!pg8::static_tile(i, G, c, 65, 23, pm, pn)) return false;
        u.pm = pm; u.pn = pn; u.aux = 0; u.aoff = (size_t)pm * 256 * 1024 * 2; u.boff = (size_t)pn * 256 * 1024 * 2; return true; }
};

struct EpiCmp1 {
    static constexpr bool PERM = true, HAS_MID = false, HAS_BETWEEN = false;
    bf16_t* HID; const float* peb;
    __device__ __forceinline__ void operator()(const Acc& acc, const pg8::Unit& u, int wr, int wc, int fr, int fq) const {
        const int kind = u.aux; bf16_t* H = HID + (size_t)kind * (HID_KIND_BYTES / 2);
        f32x4 bv[2][2];
#pragma unroll
        for (int bj = 0; bj < 2; ++bj)
#pragma unroll
            for (int n = 0; n < 2; ++n) bv[bj][n] = *(const f32x4*)(peb + kind * 256 + bj * 128 + wc * 32 + fq * 8 + n * 4);
#pragma unroll
        for (int ai = 0; ai < 2; ++ai)
#pragma unroll
            for (int m = 0; m < 4; ++m) { const int row = u.pm * 256 + ai * 128 + wr * 64 + m * 16 + fr;
#pragma unroll
                for (int bj = 0; bj < 2; ++bj) { const f32x4 v0 = acc[ai][bj][m][0] + bv[bj][0], v1 = acc[ai][bj][m][1] + bv[bj][1];
                    u32x4 w; w.x = pk2(silu(v0[0]), silu(v0[1])); w.y = pk2(silu(v0[2]), silu(v0[3])); w.z = pk2(silu(v1[0]), silu(v1[1])); w.w = pk2(silu(v1[2]), silu(v1[3]));
                    *(u32x4*)(H + (size_t)row * 256 + bj * 128 + wc * 32 + fq * 8) = w; } }
    }
};
struct SchedCmp {
    int G, c, pm0, npm;
    __device__ __forceinline__ bool next(int i, pg8::Unit& u) const {
        const int L = i * G + c; if (c < 0 || L >= 2 * npm) return false;
        const int kind = L / npm, pm = pm0 + L % npm;
        u.pm = pm; u.pn = 0; u.aux = kind; u.aoff = (size_t)kind * CMPA_KIND_BYTES + (size_t)pm * 256 * 1024 * 2; u.boff = (size_t)kind * 256 * 2048 * 2; return true; }
};


struct EpiCmp2 {
    static constexpr bool PERM = true, HAS_MID = false, HAS_BETWEEN = false;
    unsigned char* KC;
    __device__ __forceinline__ void operator()(const Acc& acc, const pg8::Unit& u, int wr, int wc, int fr, int fq) const {
        if (wc >= 2) return;
        const int kind = u.aux, d0 = 32 * wc + 8 * fq; unsigned char* img = KC + (size_t)kind * KC_KIND_BYTES;
#pragma unroll
        for (int ai = 0; ai < 2; ++ai)
#pragma unroll
            for (int m = 0; m < 4; ++m) { const int row = u.pm * 256 + ai * 128 + wr * 64 + m * 16 + fr, tile = row >> 6, key = row & 63;
                const f32x4 v0 = acc[ai][0][m][0], v1 = acc[ai][0][m][1];
                u32x4 w; w.x = pk2(v0[0], v0[1]); w.y = pk2(v0[2], v0[3]); w.z = pk2(v1[0], v1[1]); w.w = pk2(v1[2], v1[3]);
                if (kind == 0) *(u32x4*)(img + (size_t)tile * 8192 + (d0 >> 3) * 1024 + key * 16) = w;
                else { const int k16 = key & 15, pp = 8 * ((k16 >> 2) & 1) + 4 * (k16 >> 3) + (k16 & 3); unsigned char* vq = img + (size_t)tile * 8192 + (key >> 4) * 2048 + d0 * 32 + pp * 2;
                    *(bf16_t*)(vq) = (bf16_t)w.x; *(bf16_t*)(vq + 32) = (bf16_t)(w.x >> 16); *(bf16_t*)(vq + 64) = (bf16_t)w.y; *(bf16_t*)(vq + 96) = (bf16_t)(w.y >> 16);
                    *(bf16_t*)(vq + 128) = (bf16_t)w.z; *(bf16_t*)(vq + 160) = (bf16_t)(w.z >> 16); *(bf16_t*)(vq + 192) = (bf16_t)w.w; *(bf16_t*)(vq + 224) = (bf16_t)(w.w >> 16); } }
    }
};
struct SchedCmp2 {
    int G, c, pm0, npm;
    __device__ __forceinline__ bool next(int i, pg8::Unit& u) const {
        const int L = i * G + c; if (c < 0 || L >= 2 * npm) return false;
        const int kind = L / npm, pm = pm0 + L % npm;
        u.pm = pm; u.pn = 0; u.aux = kind; u.aoff = (size_t)kind * HID_KIND_BYTES + (size_t)pm * 256 * 256 * 2; u.boff = (size_t)kind * 256 * 256 * 2; return true; }
};
struct EpiE1 {
    static constexpr bool PERM = true, HAS_MID = true, HAS_BETWEEN = false;
    const bf16_t *GR, *GB; bf16_t* OPRE;
    __device__ __forceinline__ void mid(Acc& acc, const pg8::Unit& u, int wr, int wc, int fr, int fq) const {
#pragma unroll
        for (int ai = 0; ai < 2; ++ai) {
            u32x4 gw[4][2];
#pragma unroll
            for (int m = 0; m < 4; ++m)
#pragma unroll
                for (int bj = 0; bj < 2; ++bj) { int row = u.pm * 256 + ai * 128 + wr * 64 + m * 16 + fr; row = row < MALL ? row : MALL - 1;
                    gw[m][bj] = *(const u32x4*)(GR + (size_t)row * 1024 + u.pn * 256 + bj * 128 + wc * 32 + fq * 8); }
#pragma unroll
            for (int m = 0; m < 4; ++m)
#pragma unroll
                for (int bj = 0; bj < 2; ++bj) { const u32x4 g = gw[m][bj];
                    acc[ai][bj][m][0][0] *= bflo(g.x); acc[ai][bj][m][0][1] *= bfhi(g.x); acc[ai][bj][m][0][2] *= bflo(g.y); acc[ai][bj][m][0][3] *= bfhi(g.y);
                    acc[ai][bj][m][1][0] *= bflo(g.z); acc[ai][bj][m][1][1] *= bfhi(g.z); acc[ai][bj][m][1][2] *= bflo(g.w); acc[ai][bj][m][1][3] *= bfhi(g.w); }
        }
    }
    __device__ __forceinline__ void operator()(const Acc& acc, const pg8::Unit& u, int wr, int wc, int fr, int fq) const {
#pragma unroll
        for (int ai = 0; ai < 2; ++ai) {
            u32x4 gw[4][2];
#pragma unroll
            for (int m = 0; m < 4; ++m)
#pragma unroll
                for (int bj = 0; bj < 2; ++bj) { int row = u.pm * 256 + ai * 128 + wr * 64 + m * 16 + fr; row = row < MALL ? row : MALL - 1;
                    gw[m][bj] = *(const u32x4*)(GB + (size_t)row * 1024 + u.pn * 256 + bj * 128 + wc * 32 + fq * 8); }
#pragma unroll
            for (int m = 0; m < 4; ++m) { const int row = u.pm * 256 + ai * 128 + wr * 64 + m * 16 + fr; if (row >= MALL) continue;
#pragma unroll
                for (int bj = 0; bj < 2; ++bj) { const u32x4 g = gw[m][bj]; const f32x4 v0 = acc[ai][bj][m][0], v1 = acc[ai][bj][m][1];
                    u32x4 w; w.x = pk2(v0[0] * bflo(g.x), v0[1] * bfhi(g.x)); w.y = pk2(v0[2] * bflo(g.y), v0[3] * bfhi(g.y)); w.z = pk2(v1[0] * bflo(g.z), v1[1] * bfhi(g.z)); w.w = pk2(v1[2] * bflo(g.w), v1[3] * bfhi(g.w));
                    *(u32x4*)(OPRE + (size_t)row * 1024 + u.pn * 256 + bj * 128 + wc * 32 + fq * 8) = w; } }
        }
    }
};
struct EpiE2 {
    static constexpr bool PERM = true, HAS_MID = false, HAS_BETWEEN = false;
    bf16_t* O; float* SSQP;
    __device__ __forceinline__ void operator()(const Acc& acc, const pg8::Unit& u, int wr, int wc, int fr, int fq) const {
#pragma unroll
        for (int ai = 0; ai < 2; ++ai)
#pragma unroll
            for (int m = 0; m < 4; ++m) { const int row = u.pm * 256 + ai * 128 + wr * 64 + m * 16 + fr; float s = 0.f;
#pragma unroll
                for (int bj = 0; bj < 2; ++bj) { const f32x4 v0 = acc[ai][bj][m][0], v1 = acc[ai][bj][m][1];
                    s += ((v0[0] * v0[0] + v0[1] * v0[1]) + (v0[2] * v0[2] + v0[3] * v0[3])) + ((v1[0] * v1[0] + v1[1] * v1[1]) + (v1[2] * v1[2] + v1[3] * v1[3]));
                    u32x4 w; w.x = pk2(v0[0], v0[1]); w.y = pk2(v0[2], v0[3]); w.z = pk2(v1[0], v1[1]); w.w = pk2(v1[2], v1[3]);
                    *(u32x4*)(O + (size_t)row * 1024 + u.pn * 256 + bj * 128 + wc * 32 + fq * 8) = w; }
                s += __shfl_xor(s, 16); s += __shfl_xor(s, 32);
                if (fq == 0) SSQP[(size_t)row * 16 + u.pn * 4 + wc] = s; }
    }
};
struct SchedE2 {
    int G, c;
    __device__ __forceinline__ bool next(int i, pg8::Unit& u) const {
        int pm, pn; if (!pg8::static_tile(i, G, c, 64, 4, pm, pn)) return false;
        u.pm = pm; u.pn = pn; u.aux = 0; u.aoff = (size_t)pm * 256 * 1024 * 2; u.boff = (size_t)pn * 256 * 1024 * 2; return true; }
};
struct SchedOne {
    int pm, pn;
    __device__ __forceinline__ bool next(int i, pg8::Unit& u) const {
        if (i != 0) return false;
        u.pm = pm; u.pn = pn; u.aux = 0; u.aoff = (size_t)pm * 256 * 1024 * 2; u.boff = (size_t)pn * 256 * 1024 * 2; return true; }
};
struct Frame { LAS unsigned char* lds; int tid, lane, wave, vcu, G; };

__device__ __forceinline__ float wave_sum(float v) {
#pragma unroll
    for (int o = 1; o < 64; o <<= 1) v += __shfl_xor(v, o);
    return v;
}
__device__ __forceinline__ int win_src(int v) {
    const int pn = v >> 8, w = v & 255;
    if (pn < 5) return v;
    if (pn < 7) return C_A + (v - 5 * 256);
    if (pn < 15) { const int ti = pn - 7, bj = w >> 7, wc = (w >> 5) & 3, fq = (w >> 3) & 3, e = w & 7, tsel = e >> 2, e3 = e & 3;
        const int ch = 64 * ti + 16 * wc + 4 * fq + e3, type = bj * 2 + tsel;
        return (type == 0 ? C_CB : type == 1 ? C_CG : type == 2 ? C_CC : C_CX) + ch; }
    return C_GA + ((w >> 7) ? 1024 : 0) + (pn - 15) * 128 + (w & 127);
}
template <class SrcMap>
__device__ __forceinline__ void transpose_item(const float* W, int N, bf16_t* WT, int ldt, int kcol0, LAS float* scr, int k0, int n0, int lane, const SrcMap& src) {
    const int sc = src(n0 + (lane & 31));
#pragma unroll 8
    for (int i = 0; i < 32; ++i) { const int kk = 2 * i + (lane >> 5); scr[kk * 33 + (lane & 31)] = W[(size_t)(k0 + kk) * N + sc]; }
    asm volatile("s_waitcnt lgkmcnt(0)" ::: "memory");
    const int c = lane & 7;
#pragma unroll
    for (int j = 0; j < 4; ++j) { const int n = (lane >> 3) + 8 * j; const LAS float* s = scr + (8 * c) * 33 + n;
        u32x4 o; o.x = pk2(s[0 * 33], s[1 * 33]); o.y = pk2(s[2 * 33], s[3 * 33]); o.z = pk2(s[4 * 33], s[5 * 33]); o.w = pk2(s[6 * 33], s[7 * 33]);
        *(u32x4*)(WT + (size_t)(n0 + n) * ldt + kcol0 + k0 + 8 * c) = o; }
    asm volatile("s_waitcnt lgkmcnt(0)" ::: "memory");
}
struct IdMap { __device__ __forceinline__ int operator()(int n) const { return n; } };
struct GateMap { __device__ __forceinline__ int operator()(int n) const { return C_G + n; } };
struct WinMap { __device__ __forceinline__ int operator()(int n) const { return win_src(n); } };

__device__ __forceinline__ void phase0(const Params& p, const Frame& F) {
    LAS float* scr = (LAS float*)(F.lds + F.wave * 16384);
    unsigned char* ws = p.ws; const int lane = F.lane;
    const int gw = F.vcu * NWAVES + F.wave, NGW = F.G * NWAVES;
    constexpr int I_PEB = 256, I_ROPE = 1024, I_WIN = 16 * 184, I_WBA = 8 * 32, I_WBB = 8 * 32, I_WOUT = 16 * 32, I_WC1 = 2 * 32 * 8, I_WC2 = 2 * 4 * 2, I_WC2Z = 2 * 24, I_WGT = 16,
                  I_CSC = 256;
    constexpr int TOTAL = I_PEB + I_ROPE + I_WIN + I_WBA + I_WBB + I_WOUT + I_WC1 + I_WC2 + I_WC2Z + I_WGT + I_CSC;
    float* mod = (float*)(ws + WS_MOD);
    for (int item = F.vcu; item < 48 * 5; item += F.G) {
        const int nb = item % 48, rt = item / 48, j32 = lane & 31, h = lane >> 5, kbase = F.wave * 128;
        int arow = 32 * rt + j32; arow = arow < 130 ? arow : 129;
        const float* cr = (arow < 2 ? p.cp + (size_t)arow * 1024 : p.cs + (size_t)(arow - 2) * 1024) + kbase + 4 * h;
        const float* wb = p.w_ada + (size_t)(kbase + 4 * h) * 3072 + nb * 64 + 2 * j32;
        f32x16 acc0 = {}, acc1 = {};
#pragma unroll 4
        for (int g8 = 0; g8 < 16; ++g8) {
            const f32x4 cx = *(const f32x4*)(cr + 8 * g8);
            f32x2 bw[4];
#pragma unroll
            for (int s4 = 0; s4 < 4; ++s4) bw[s4] = *(const f32x2*)(wb + (size_t)(8 * g8 + s4) * 3072);
#pragma unroll
            for (int s4 = 0; s4 < 4; ++s4) { const float x = cx[s4]; const float a = x / (1.f + __expf(-x));
                acc0 = __builtin_amdgcn_mfma_f32_32x32x2f32(a, bw[s4][0], acc0, 0, 0, 0); acc1 = __builtin_amdgcn_mfma_f32_32x32x2f32(a, bw[s4][1], acc1, 0, 0, 0); }
        }
        LAS float* red = (LAS float*)F.lds;
        __syncthreads();
#pragma unroll
        for (int r = 0; r < 16; ++r) { red[(F.wave * 32 + r) * 64 + lane] = acc0[r]; red[(F.wave * 32 + 16 + r) * 64 + lane] = acc1[r]; }
        __syncthreads();
        for (int e = F.tid; e < 32 * 64; e += NTHR) { const int v = e >> 6, l = e & 63, ecol = v >> 4, r = v & 15;
            const int row = 32 * rt + (r & 3) + 8 * (r >> 2) + 4 * (l >> 5), col = nb * 64 + 2 * (l & 31) + ecol;
            float sum = p.b_ada[col];
#pragma unroll
            for (int w = 0; w < 8; ++w) sum += red[(w * 32 + v) * 64 + l];
            if (row < 130) mod[(size_t)row * 3072 + col] = sum; }
        __syncthreads();
    }
    for (int it = gw; it < TOTAL; it += NGW) {
        int r = it;
        if (r < I_PEB) {
            const int kind = r >> 7, nb = (r >> 5) & 3, kc = r & 31, n = nb * 64 + lane; float s = 0.f;
            const float* pe = p.pe + kind * 2048 + kc * 64; const float* w = p.w1 + ((size_t)kind * 2048 + kc * 64) * 256 + n;
#pragma unroll
            for (int k = 0; k < 64; ++k) s += pe[k] * w[(size_t)k * 256];
            ((float*)(ws + WS_PEBP))[(kind * 32 + kc) * 256 + n] = s;
            continue;
        }
        r -= I_PEB;
        if (r < I_ROPE) {
            const int idx = r * 64 + lane, pos = idx >> 3, i = idx & 7;
            const float inv = (float)pow(500000.0, -(double)i / 8.0); const float ang = (float)pos * inv;
            float* rp = (float*)(ws + WS_ROPE) + (size_t)pos * 16;
            rp[i] = (float)cos((double)ang); rp[8 + i] = (float)sin((double)ang);
            continue;
        }
        r -= I_ROPE;
        if (r < I_WIN) { transpose_item(p.w_in, INW, (bf16_t*)(ws + WS_WINT), 1024, 0, scr, 64 * (r / 184), 32 * (r % 184), lane, WinMap()); continue; }
        r -= I_WIN;
        if (r < I_WBA) { transpose_item(p.wba, 1024, (bf16_t*)(ws + WS_WBR), 1024, 0, scr, 64 * (r / 32), 32 * (r % 32), lane, IdMap()); continue; }
        r -= I_WBA;
        if (r < I_WBB) { transpose_item(p.wbb, 1024, (bf16_t*)(ws + WS_WBR), 1024, 512, scr, 64 * (r / 32), 32 * (r % 32), lane, IdMap()); continue; }
        r -= I_WBB;
        if (r < I_WOUT) { transpose_item(p.wout, 1024, (bf16_t*)(ws + WS_WOUT), 1024, 0, scr, 64 * (r / 32), 32 * (r % 32), lane, IdMap()); continue; }
        r -= I_WOUT;
        if (r < I_WC1) { const int kind = r / 256, q = r % 256; transpose_item(p.w1 + (size_t)kind * 2048 * 256, 256, (bf16_t*)(ws + WS_WC1) + (size_t)kind * 256 * 2048, 2048, 0, scr, 64 * (q / 8), 32 * (q % 8), lane, IdMap()); continue; }
        r -= I_WC1;
        if (r < I_WC2) { const int kind = r / 8, q = r % 8; transpose_item(p.w2 + (size_t)kind * 256 * 64, 64, (bf16_t*)(ws + WS_WC2) + (size_t)kind * 256 * 256, 256, 0, scr, 64 * (q / 2), 32 * (q % 2), lane, IdMap()); continue; }
        r -= I_WC2;
        if (r < I_WC2Z) { const int kind = r / 24, q = r % 24;
            u32x4* z = (u32x4*)((bf16_t*)(ws + WS_WC2) + (size_t)kind * 256 * 256 + (size_t)(64 + 8 * q) * 256);
#pragma unroll
            for (int j = 0; j < 4; ++j) z[j * 64 + lane] = (u32x4){0u, 0u, 0u, 0u};
            continue; }
        r -= I_WC2Z;
        if (r < I_WGT) { transpose_item(p.w_in, INW, (bf16_t*)(ws + WS_WGT), 1024, 0, scr, 64 * r, 0, lane, GateMap()); continue; }
        r -= I_WGT;
        { const int idx = r * 256 + lane * 4, bs = idx >> 9, c = idx & 511;
          *(f32x4*)(p.out + O_CSS + ((size_t)bs * 2) * 512 + c) = *(const f32x4*)(p.sconv + ((size_t)bs * 2 + 1) * 512 + c); }
    }
}

constexpr int N_WINC = (128 * 511 + 15) / 16;
__device__ __forceinline__ void wincopy_item(const Params& p, int r, int lane) {
    f32x4 v[16];
#pragma unroll
    for (int j = 0; j < 16; ++j) { const int ridx = r * 16 + j; if (ridx < 128 * 511) { const int bs = ridx / 511, jj = ridx % 511; v[j] = *(const f32x4*)(p.swin + ((size_t)bs * 512 + jj + 1) * 256 + lane * 4); } }
#pragma unroll
    for (int j = 0; j < 16; ++j) { const int ridx = r * 16 + j; if (ridx < 128 * 511) { const int bs = ridx / 511, jj = ridx % 511; *(f32x4*)(p.out + O_WINS + ((size_t)bs * 512 + jj) * 256 + lane * 4) = v[j]; } }
}
__device__ __forceinline__ float dot2bf(unsigned w, unsigned x, float acc) { typedef __bf16 bf16x2_t __attribute__((ext_vector_type(2)));
    return __builtin_amdgcn_fdot2_f32_bf16(__builtin_bit_cast(bf16x2_t, w), __builtin_bit_cast(bf16x2_t, x), acc, false); }
__device__ __forceinline__ void phase1(const Params& p, const Frame& F) {
    unsigned char* ws = p.ws; const int lane = F.lane;
    LAS unsigned* wg = (LAS unsigned*)F.lds;
    { const u32x4* src = (const u32x4*)(ws + WS_WGT);
#pragma unroll
      for (int i = 0; i < 6; ++i) ((LAS u32x4*)wg)[i * NTHR + F.tid] = src[i * NTHR + F.tid]; }
    __syncthreads();
    const int gw = F.vcu * NWAVES + F.wave, NGW = F.G * NWAVES;
    const float* mod = (const float*)(ws + WS_MOD); bf16_t* H = (bf16_t*)(ws + WS_H); float* NG = (float*)(ws + WS_NG);
    if (gw < 8) { const int kind = gw >> 2, n = (gw & 3) * 64 + lane; float s = 0.f; const float* pp = (const float*)(ws + WS_PEBP) + kind * 32 * 256 + n;
#pragma unroll
        for (int kc = 0; kc < 32; ++kc) s += pp[kc * 256];
        ((float*)(ws + WS_PEB))[kind * 256 + n] = s; }
    f32x4 vn[2][4];
#define P1_LOADX(dst, r_) do { const int r__ = (r_); if (r__ < MALL) { const float* x = r__ < MP ? p.xp + (size_t)r__ * DM : p.xs + (size_t)(r__ - MP) * DM; \
        _Pragma("unroll") for (int j = 0; j < 4; ++j) dst[j] = *(const f32x4*)(x + (j >> 1) * 512 + lane * 8 + (j & 1) * 4); } } while (0)
#pragma unroll
    for (int j = 0; j < 4; ++j) { vn[0][j] = (f32x4){0.f, 0.f, 0.f, 0.f}; vn[1][j] = vn[0][j]; }
    P1_LOADX(vn[0], gw); P1_LOADX(vn[1], gw + NGW);
    for (int row = gw; row < MALL; row += 2 * NGW) {
        const bool ok1 = row + NGW < MALL; const int rw[2] = {row, ok1 ? row + NGW : row};
        f32x4 v[2][4]; float s[2];
#pragma unroll
        for (int u = 0; u < 2; ++u) { s[u] = 0.f;
#pragma unroll
            for (int j = 0; j < 4; ++j) { v[u][j] = vn[u][j]; s[u] += (v[u][j][0] * v[u][j][0] + v[u][j][1] * v[u][j][1]) + (v[u][j][2] * v[u][j][2] + v[u][j][3] * v[u][j][3]); } }
        P1_LOADX(vn[0], row + 2 * NGW); P1_LOADX(vn[1], row + 3 * NGW);
        s[0] = wave_sum(s[0]); s[1] = wave_sum(s[1]);
        u32x4 hp[2][2];
#pragma unroll
        for (int u = 0; u < 2; ++u) { const float rs = rsqrtf(s[u] * (1.f / DM) + 1e-6f); const int r_ = rw[u];
            const float* md = mod + (size_t)(r_ < MP ? (r_ >> 13) : 2 + (r_ - MP)) * 3072;
#pragma unroll
            for (int j = 0; j < 4; ++j) { const int k = (j >> 1) * 512 + lane * 8 + (j & 1) * 4; const f32x4 gp = *(const f32x4*)(p.g_pre + k), sh = *(const f32x4*)(md + k), sc = *(const f32x4*)(md + 1024 + k);
                const f32x4 h = v[u][j] * rs * gp * (1.f + sc) + sh;
                if (j & 1) { hp[u][j >> 1].z = pk2(h[0], h[1]); hp[u][j >> 1].w = pk2(h[2], h[3]); } else { hp[u][j >> 1].x = pk2(h[0], h[1]); hp[u][j >> 1].y = pk2(h[2], h[3]); } }
            if (u == 0 || ok1) { *(u32x4*)(H + (size_t)r_ * DM + lane * 8) = hp[u][0]; *(u32x4*)(H + (size_t)r_ * DM + 512 + lane * 8) = hp[u][1]; } }
        float d[2][24];
#pragma unroll
        for (int c = 0; c < 24; ++c) { if ((c & 3) == 0) asm volatile("" ::: "memory");
            const u32x4 w0 = *(const LAS u32x4*)(wg + c * 512 + lane * 4), w1 = *(const LAS u32x4*)(wg + c * 512 + 256 + lane * 4);
#pragma unroll
            for (int u = 0; u < 2; ++u) { float a = dot2bf(w0.x, hp[u][0].x, 0.f), b = dot2bf(w1.x, hp[u][1].x, 0.f);
                a = dot2bf(w0.y, hp[u][0].y, a); b = dot2bf(w1.y, hp[u][1].y, b); a = dot2bf(w0.z, hp[u][0].z, a); b = dot2bf(w1.z, hp[u][1].z, b); a = dot2bf(w0.w, hp[u][0].w, a); b = dot2bf(w1.w, hp[u][1].w, b);
                d[u][c] = a + b; } }
        const bool b5 = lane & 32, b4 = lane & 16, b3 = lane & 8;
        float e12[2][12], e6[2][6], e3[2][3];
#pragma unroll
        for (int i = 0; i < 12; ++i)
#pragma unroll
            for (int u = 0; u < 2; ++u) { const float snd = b5 ? d[u][i] : d[u][12 + i]; const float rcv = __shfl_xor(snd, 32); e12[u][i] = (b5 ? d[u][12 + i] : d[u][i]) + rcv; }
#pragma unroll
        for (int i = 0; i < 6; ++i)
#pragma unroll
            for (int u = 0; u < 2; ++u) { const float snd = b4 ? e12[u][i] : e12[u][6 + i]; const float rcv = __shfl_xor(snd, 16); e6[u][i] = (b4 ? e12[u][6 + i] : e12[u][i]) + rcv; }
#pragma unroll
        for (int i = 0; i < 3; ++i)
#pragma unroll
            for (int u = 0; u < 2; ++u) { const float snd = b3 ? e6[u][i] : e6[u][3 + i]; const float rcv = __shfl_xor(snd, 8); e3[u][i] = (b3 ? e6[u][3 + i] : e6[u][i]) + rcv; }
#pragma unroll
        for (int i = 0; i < 3; ++i)
#pragma unroll
            for (int u = 0; u < 2; ++u) { float x = e3[u][i]; x += __shfl_xor(x, 4); x += __shfl_xor(x, 2); x += __shfl_xor(x, 1); e3[u][i] = x; }
        { const int l7 = lane & 7;
#pragma unroll
          for (int u = 0; u < 2; ++u) if (l7 < 3 && (u == 0 || ok1)) { const float gsum = l7 == 0 ? e3[u][0] : (l7 == 1 ? e3[u][1] : e3[u][2]);
            NG[(size_t)rw[u] * 32 + (b5 ? 12 : 0) + (b4 ? 6 : 0) + (b3 ? 3 : 0) + l7] = sigm(gsum); } }
    }
#undef P1_LOADX
}

__device__ __forceinline__ void cmp2_item(unsigned char* ws, int kind, int row0, int lane) {
    const bf16_t* H = (const bf16_t*)(ws + WS_HID + (size_t)kind * HID_KIND_BYTES); const bf16_t* W = (const bf16_t*)(ws + WS_WC2) + (size_t)kind * 64 * 256;
    const int r32 = lane & 31, hi = lane >> 5;
    f32x16 acc0 = {}, acc1 = {};
#pragma unroll 4
    for (int s = 0; s < 16; ++s) {
        const bf16x8 a = *(const bf16x8*)(H + (size_t)(row0 + r32) * 256 + s * 16 + hi * 8);
        const bf16x8 b0 = *(const bf16x8*)(W + (size_t)r32 * 256 + s * 16 + hi * 8), b1 = *(const bf16x8*)(W + (size_t)(32 + r32) * 256 + s * 16 + hi * 8);
        acc0 = __builtin_amdgcn_mfma_f32_32x32x16_bf16(a, b0, acc0, 0, 0, 0); acc1 = __builtin_amdgcn_mfma_f32_32x32x16_bf16(a, b1, acc1, 0, 0, 0);
    }
    unsigned char* img = ws + WS_KC + (size_t)kind * KC_KIND_BYTES;
#pragma unroll
    for (int r = 0; r < 16; ++r) { const int row = row0 + (r & 3) + 8 * (r >> 2) + 4 * hi, tile = row >> 6, key = row & 63;
#pragma unroll
        for (int h2 = 0; h2 < 2; ++h2) { const int d = r32 + 32 * h2; const float v = h2 ? acc1[r] : acc0[r];
            size_t off;
            if (kind == 0) off = (size_t)tile * 8192 + (d >> 3) * 1024 + key * 16 + (d & 7) * 2;
            else { const int k16 = key & 15; off = (size_t)tile * 8192 + (key >> 4) * 2048 + d * 32 + (8 * ((k16 >> 2) & 1) + 4 * (k16 >> 3) + (k16 & 3)) * 2; }
            *(bf16_t*)(img + off) = (bf16_t)f2bf(v); } }
}
__device__ __forceinline__ void ybin_row(const Params& p, int row, int lane) {
    unsigned char* ws = p.ws; const bf16_t* U = (const bf16_t*)(ws + WS_U); const bf16_t* CBG = (const bf16_t*)(ws + WS_CBG); bf16_t* AOY = (bf16_t*)(ws + WS_AOY);
    const int c = lane * 8;
    float u0[8], u1[8], u2[8];
    { const u32x4 w = *(const u32x4*)(U + (size_t)row * 512 + c); u2[0] = bflo(w.x); u2[1] = bfhi(w.x); u2[2] = bflo(w.y); u2[3] = bfhi(w.y); u2[4] = bflo(w.z); u2[5] = bfhi(w.z); u2[6] = bflo(w.w); u2[7] = bfhi(w.w); }
    if (row < MP) { const int t = row & (TS - 1);
        if (t >= 1) { const u32x4 w = *(const u32x4*)(U + (size_t)(row - 1) * 512 + c); u1[0] = bflo(w.x); u1[1] = bfhi(w.x); u1[2] = bflo(w.y); u1[3] = bfhi(w.y); u1[4] = bflo(w.z); u1[5] = bfhi(w.z); u1[6] = bflo(w.w); u1[7] = bfhi(w.w); }
        else {
#pragma unroll
            for (int j = 0; j < 8; ++j) u1[j] = 0.f; }
        if (t >= 2) { const u32x4 w = *(const u32x4*)(U + (size_t)(row - 2) * 512 + c); u0[0] = bflo(w.x); u0[1] = bfhi(w.x); u0[2] = bflo(w.y); u0[3] = bfhi(w.y); u0[4] = bflo(w.z); u0[5] = bfhi(w.z); u0[6] = bflo(w.w); u0[7] = bfhi(w.w); }
        else {
#pragma unroll
            for (int j = 0; j < 8; ++j) u0[j] = 0.f; }
    } else { const int bs = row - MP; const float* s0 = p.sconv + ((size_t)bs * 2) * 512 + c; const float* s1 = s0 + 512;
#pragma unroll
        for (int j = 0; j < 8; ++j) { u0[j] = s0[j]; u1[j] = s1[j]; } }
    const u32x4 wcb = *(const u32x4*)(CBG + (size_t)row * 512 + c);
    float cb[8] = {bflo(wcb.x), bfhi(wcb.x), bflo(wcb.y), bfhi(wcb.y), bflo(wcb.z), bfhi(wcb.z), bflo(wcb.w), bfhi(wcb.w)};
    float o[8];
#pragma unroll
    for (int j = 0; j < 8; ++j) o[j] = cb[j] * (p.conv_w[c + j] * u0[j] + p.conv_w[512 + c + j] * u1[j] + p.conv_w[1024 + c + j] * u2[j]);
    u32x4 w; w.x = pk2(o[0], o[1]); w.y = pk2(o[2], o[3]); w.z = pk2(o[4], o[5]); w.w = pk2(o[6], o[7]);
    *(u32x4*)(AOY + (size_t)row * 1024 + 512 + c) = w;
}
__device__ __forceinline__ void final_row(const Params& p, float* outbase, int row, int lane) {
    unsigned char* ws = p.ws; const bf16_t* O = (const bf16_t*)(ws + WS_O) + (size_t)row * 1024; const float* sq = (const float*)(ws + WS_SSQP) + (size_t)row * 16;
    float s = 0.f;
#pragma unroll
    for (int j = 0; j < 16; ++j) s += sq[j];
    const float rs = rsqrtf(s * (1.f / DM) + 1e-6f);
    const float* x = row < MP ? p.xp + (size_t)row * DM : p.xs + (size_t)(row - MP) * DM;
    float* y = row < MP ? outbase + O_YP + (size_t)row * DM : outbase + O_YS + (size_t)(row - MP) * DM;
    const float* gate = (const float*)(ws + WS_MOD) + (size_t)(row < MP ? (row >> 13) : 2 + (row - MP)) * 3072 + 2048;
#pragma unroll
    for (int j = 0; j < 4; ++j) { const int k = j * 256 + lane * 4; const u32x2 ow = *(const u32x2*)(O + k); const f32x4 xv = *(const f32x4*)(x + k), ov = {bflo(ow.x), bfhi(ow.x), bflo(ow.y), bfhi(ow.y)}, gv = *(const f32x4*)(gate + k), gp = *(const f32x4*)(p.g_post + k);
        *(f32x4*)(y + k) = xv + gv * ov * rs * gp; }
}
namespace att {
constexpr int L_K = 0, L_V = 16384, L_GS = 32768, L_LS = 65536, L_SELM = 98304, L_WSF = 99328, L_UN = 101376, L_Q = 101632, L_END = 134400;
typedef short s16x4 __attribute__((ext_vector_type(4)));
typedef LAS const unsigned char* lptr;
__device__ __forceinline__ int crow(int r, int hi) { return (r & 3) + 8 * (r >> 2) + 4 * hi; }
__device__ __forceinline__ s16x4 vtr(lptr p) { return __builtin_bit_cast(s16x4, __builtin_amdgcn_ds_read_tr16_b64_v4i16((LAS s16x4*)p)); }
__device__ __forceinline__ float half_swap_max(float m) { auto rr = __builtin_amdgcn_permlane32_swap(__float_as_uint(m), __float_as_uint(m), false, false); return fmaxf(__uint_as_float(rr[0]), __uint_as_float(rr[1])); }
__device__ __forceinline__ float half_swap_sum(float m) { auto rr = __builtin_amdgcn_permlane32_swap(__float_as_uint(m), __float_as_uint(m), false, false); return __uint_as_float(rr[0]) + __uint_as_float(rr[1]); }
__device__ __forceinline__ unsigned cvtpk(float lo, float hi) { typedef __bf16 bf16x2_t __attribute__((ext_vector_type(2))); f32x2 v = {lo, hi}; bf16x2_t b = __builtin_convertvector(v, bf16x2_t); return __builtin_bit_cast(unsigned, b); }
__device__ __forceinline__ float quad_sum(float v) { v += __shfl_xor(v, 1); v += __shfl_xor(v, 2); return v; }

struct Tile16 { u32x4 k, v; };
__device__ __forceinline__ void qkt(f32x16& p0, f32x16& p1, lptr kslot, const LAS bf16x8* qr, int r32, int hi) {
    lptr kb = kslot + hi * 1024 + r32 * 16;
    p0 = f32x16{}; p1 = f32x16{};
#pragma unroll
    for (int d0 = 0; d0 < 4; ++d0) {
        const bf16x8 b0 = *(const LAS bf16x8*)(kb + d0 * 2048), b1 = *(const LAS bf16x8*)(kb + d0 * 2048 + 512);
        const bf16x8 qf = qr[d0 * 64]; p0 = __builtin_amdgcn_mfma_f32_32x32x16_bf16(b0, qf, p0, 0, 0, 0); p1 = __builtin_amdgcn_mfma_f32_32x32x16_bf16(b1, qf, p1, 0, 0, 0);
    }
}
__device__ __forceinline__ void pv(f32x16* o, lptr vslot, const f32x16& p0, const f32x16& p1, int lane, int hi) {
    u32x4 pw[4];
    pw[0] = (u32x4){cvtpk(p0[0], p0[1]), cvtpk(p0[2], p0[3]), cvtpk(p0[4], p0[5]), cvtpk(p0[6], p0[7])};
    pw[1] = (u32x4){cvtpk(p0[8], p0[9]), cvtpk(p0[10], p0[11]), cvtpk(p0[12], p0[13]), cvtpk(p0[14], p0[15])};
    pw[2] = (u32x4){cvtpk(p1[0], p1[1]), cvtpk(p1[2], p1[3]), cvtpk(p1[4], p1[5]), cvtpk(p1[6], p1[7])};
    pw[3] = (u32x4){cvtpk(p1[8], p1[9]), cvtpk(p1[10], p1[11]), cvtpk(p1[12], p1[13]), cvtpk(p1[14], p1[15])};
    lptr vp = vslot + ((lane >> 4) & 1) * 32 + (lane & 3) * 8 + (4 * hi + ((lane & 15) >> 2)) * 64;
#pragma unroll
    for (int d0 = 0; d0 < 2; ++d0)
#pragma unroll
        for (int ks = 0; ks < 4; ++ks) {
            const s16x4 lo = vtr(vp + d0 * 4096 + ks * 1024), hh = vtr(vp + d0 * 4096 + ks * 1024 + 512);
            const bf16x8 vf = (bf16x8){lo[0], lo[1], lo[2], lo[3], hh[0], hh[1], hh[2], hh[3]};
            o[d0] = __builtin_amdgcn_mfma_f32_32x32x16_bf16(__builtin_bit_cast(bf16x8, pw[ks]), vf, o[d0], 0, 0, 0);
        }
}
__device__ __forceinline__ void mask_range(f32x16& p0, f32x16& p1, int lo, int hi_, int hi) {
    const int lo2 = lo - 4 * hi, hi2 = hi_ - 4 * hi;
#pragma unroll
    for (int r = 0; r < 16; ++r) { const int c = (r & 3) + 8 * (r >> 2);
        p0[r] = (c >= lo2 && c <= hi2) ? p0[r] : -INFINITY; p1[r] = (c + 32 >= lo2 && c + 32 <= hi2) ? p1[r] : -INFINITY; }
}
__device__ __forceinline__ void mask_rows(f32x16& p0, f32x16& p1, float bias) {
#pragma unroll
    for (int r = 0; r < 16; ++r) { p0[r] += bias; p1[r] += bias; }
}
__device__ __forceinline__ void online_step(f32x16& p0, f32x16& p1, float& m, float& l, f32x16* o, LAS float* wsf, int r32, int hi, bool en = true) {
    float rm = p0[0];
#pragma unroll
    for (int r = 1; r < 16; ++r) rm = fmaxf(rm, p0[r]);
#pragma unroll
    for (int r = 0; r < 16; ++r) rm = fmaxf(rm, p1[r]);
    rm = half_swap_max(rm);
    rm = en ? rm : -INFINITY;
    const bool need = __any(rm - m > 8.f);
    const float mn = need ? fmaxf(m, rm) : m;
    const float alpha = need ? __builtin_amdgcn_exp2f(m - mn) : 1.f;
    const float msub = en ? mn : INFINITY;
    float s = 0.f;
#pragma unroll
    for (int r = 0; r < 16; ++r) { p0[r] = __builtin_amdgcn_exp2f(p0[r] - msub); p1[r] = __builtin_amdgcn_exp2f(p1[r] - msub); s += p0[r] + p1[r]; }
    l = l * alpha + s; m = mn;
    if (need) {
        if (hi == 0) wsf[r32] = alpha;
        asm volatile("s_waitcnt lgkmcnt(0)" ::: "memory");
#pragma unroll
        for (int r = 0; r < 16; ++r) { const float a = wsf[crow(r, hi)]; o[0][r] *= a; o[1][r] *= a; }
    }
}
template <int MODE  >
__device__ __forceinline__ void accum_lds(LAS float* ot0, LAS float* ot1, const f32x16* o, float coef, LAS float* wsf, int lane, int r32, int hi) {
    if (hi == 0) wsf[32 + r32] = coef;
    asm volatile("s_waitcnt lgkmcnt(0)" ::: "memory");
#pragma unroll
    for (int r = 0; r < 16; ++r) { const float a = wsf[32 + crow(r, hi)];
        if (MODE == 0) { ot0[r * 64 + lane] = a * o[0][r]; ot1[r * 64 + lane] = a * o[1][r]; }
        else { ot0[r * 64 + lane] += a * o[0][r]; ot1[r * 64 + lane] += a * o[1][r]; } }
}
__device__ __forceinline__ unsigned pick4(unsigned a0, unsigned a1, unsigned a2, unsigned a3, int i) { unsigned r = a0; r = (i == 1) ? a1 : r; r = (i == 2) ? a2 : r; r = (i == 3) ? a3 : r; return r; }
__device__ __forceinline__ int next_bit(unsigned u0, unsigned u1, unsigned u2, unsigned u3, int j, int jmax) {
    while (j <= jmax) { const unsigned w = pick4(u0, u1, u2, u3, j >> 5) >> (j & 31); if (w) { j += __builtin_ctz(w); return j <= jmax ? j : jmax + 1; } j = (j | 31) + 1; }
    return jmax + 1;
}

__device__ __forceinline__ void loadK(bf16x8 (&kf)[8], const unsigned char* tile, unsigned koff) {
#pragma unroll
    for (int d0 = 0; d0 < 4; ++d0) { kf[2 * d0] = *(const bf16x8*)(tile + koff + d0 * 2048); kf[2 * d0 + 1] = *(const bf16x8*)(tile + koff + d0 * 2048 + 512); }
}
__device__ __forceinline__ void loadV(bf16x8 (&vf)[8], const unsigned char* tile, unsigned voff) {
#pragma unroll
    for (int d0 = 0; d0 < 2; ++d0)
#pragma unroll
        for (int ks = 0; ks < 4; ++ks) vf[d0 * 4 + ks] = *(const bf16x8*)(tile + voff + ks * 2048 + d0 * 1024);
}
__device__ __forceinline__ void qkt_reg(f32x16& p0, f32x16& p1, const bf16x8 (&kf)[8], const LAS bf16x8* qr) {
    p0 = f32x16{}; p1 = f32x16{};
    bf16x8 qf[4];
#pragma unroll
    for (int d0 = 0; d0 < 4; ++d0) qf[d0] = qr[d0 * 64];
    __builtin_amdgcn_sched_barrier(0);
#pragma unroll
    for (int d0 = 0; d0 < 4; ++d0) {
        p0 = __builtin_amdgcn_mfma_f32_32x32x16_bf16(kf[2 * d0], qf[d0], p0, 0, 0, 0); p1 = __builtin_amdgcn_mfma_f32_32x32x16_bf16(kf[2 * d0 + 1], qf[d0], p1, 0, 0, 0); }
}
__device__ __forceinline__ void pv_reg(f32x16* o, const bf16x8 (&vf)[8], const f32x16& p0, const f32x16& p1) {
    u32x4 pw[4];
    pw[0] = (u32x4){cvtpk(p0[0], p0[1]), cvtpk(p0[2], p0[3]), cvtpk(p0[4], p0[5]), cvtpk(p0[6], p0[7])};
    pw[1] = (u32x4){cvtpk(p0[8], p0[9]), cvtpk(p0[10], p0[11]), cvtpk(p0[12], p0[13]), cvtpk(p0[14], p0[15])};
    pw[2] = (u32x4){cvtpk(p1[0], p1[1]), cvtpk(p1[2], p1[3]), cvtpk(p1[4], p1[5]), cvtpk(p1[6], p1[7])};
    pw[3] = (u32x4){cvtpk(p1[8], p1[9]), cvtpk(p1[10], p1[11]), cvtpk(p1[12], p1[13]), cvtpk(p1[14], p1[15])};
#pragma unroll
    for (int d0 = 0; d0 < 2; ++d0)
#pragma unroll
        for (int ks = 0; ks < 4; ++ks) o[d0] = __builtin_amdgcn_mfma_f32_32x32x16_bf16(__builtin_bit_cast(bf16x8, pw[ks]), vf[d0 * 4 + ks], o[d0], 0, 0, 0);
}

__device__ __forceinline__ void prompt_unit(const Params& p, const Frame& F, int b, int g, int cur, int tg) {
    unsigned char* ws = p.ws; LAS unsigned char* lds = F.lds;
    const int lane = F.lane, wid = F.wave, r32 = lane & 31, hi = lane >> 5;
    const int bg = b * 2 + g, t0 = cur * 64, tokl = 8 * tg + (r32 >> 2), head = r32 & 3, t = t0 + tokl;
    const size_t grow = (size_t)b * TS + t;
    LAS float* wsf = (LAS float*)(lds + L_WSF) + wid * 64;
    LAS float* GS = (LAS float*)(lds + L_GS); LAS float* LS = (LAS float*)(lds + L_LS);
    LAS bf16x8* qr = (LAS bf16x8*)(lds + L_Q + wid * 4096) + hi * 32 + r32;
    { const bf16_t* qp = (const bf16_t*)(ws + WS_QB) + grow * 512 + (g * 4 + head) * 64 + hi * 8;
#pragma unroll
      for (int d0 = 0; d0 < 4; ++d0) qr[d0 * 64] = *(const bf16x8*)(qp + d0 * 16); }
    const float* ngp = (const float*)(ws + WS_NG) + grow * 32 + g * 12 + head * 3;
    const float g_cmp = ngp[0], g_sel = ngp[1], g_win = ngp[2];
    f32x16 o[2]; f32x16 p0, p1;
    LAS float* ot0 = GS + wid * 1024; LAS float* ot1 = LS + wid * 1024;
    const unsigned char* kc_img = ws + WS_KC + (size_t)(512 + bg * 8) * 8192;
    const unsigned char* vc_img = ws + WS_KC + KC_KIND_BYTES + (size_t)(512 + bg * 8) * 8192;
    const unsigned char* ks_img = ws + WS_KVI + (size_t)(0 * 4 + bg) * 128 * 8192;
    const unsigned char* vs_img = ws + WS_KVI + (size_t)(1 * 4 + bg) * 128 * 8192;
    const unsigned char* kw_img = ws + WS_KVI + (size_t)(2 * 4 + bg) * 128 * 8192;
    const unsigned char* vw_img = ws + WS_KVI + (size_t)(3 * 4 + bg) * 128 * 8192;
    unsigned koff = (unsigned)(hi * 1024 + r32 * 16), voff = (unsigned)(r32 * 32 + hi * 16);
    asm volatile("" : "+v"(koff), "+v"(voff));
    bf16x8 kf[8], vf[8];
    const int cmaxl = (t >= 31) ? ((t - 31) >> 4) : -1;
    const int nct = (4 * cur + 3 + 63) >> 6;
    float m = -1e30f, l = 0.f;
    loadK(kf, kc_img, koff);
#pragma unroll 1
    for (int ct = 0; ct < nct; ++ct) {
        qkt_reg(p0, p1, kf, qr);
        loadK(kf, kc_img + (size_t)(ct + 1 < nct ? ct + 1 : ct) * 8192, koff);
        mask_range(p0, p1, 0, cmaxl - 64 * ct, hi);
        float rm = p0[0];
#pragma unroll
        for (int r = 1; r < 16; ++r) rm = fmaxf(rm, p0[r]);
#pragma unroll
        for (int r = 0; r < 16; ++r) rm = fmaxf(rm, p1[r]);
        rm = half_swap_max(rm);
        const float mn = fmaxf(m, rm); float s = 0.f;
#pragma unroll
        for (int r = 0; r < 16; ++r) s += __builtin_amdgcn_exp2f(p0[r] - mn) + __builtin_amdgcn_exp2f(p1[r] - mn);
        l = l * __builtin_amdgcn_exp2f(m - mn) + s; m = mn;
    }
    l = half_swap_sum(l);
    const float linv = 1.f / fmaxf(l, 1e-30f);
    o[0] = f32x16{}; o[1] = f32x16{};
    loadK(kf, kc_img, koff);
#pragma unroll 1
    for (int ct = 0; ct < nct; ++ct) {
        loadV(vf, vc_img + (size_t)ct * 8192, voff);
        qkt_reg(p0, p1, kf, qr);
        loadK(kf, kc_img + (size_t)(ct + 1 < nct ? ct + 1 : ct) * 8192, koff);
        mask_range(p0, p1, 0, cmaxl - 64 * ct, hi);
#pragma unroll
        for (int r = 0; r < 16; ++r) { p0[r] = __builtin_amdgcn_exp2f(p0[r] - m) * linv; p1[r] = __builtin_amdgcn_exp2f(p1[r] - m) * linv; }
#pragma unroll
        for (int q = 0; q < 4; ++q) {
            const float ga = quad_sum((p0[4 * q] + p0[4 * q + 1]) + (p0[4 * q + 2] + p0[4 * q + 3])), la = quad_sum(p0[4 * q + 3]);
            const float gb = quad_sum((p1[4 * q] + p1[4 * q + 1]) + (p1[4 * q + 2] + p1[4 * q + 3])), lb = quad_sum(p1[4 * q + 3]);
            const int j = 16 * ct + 2 * q + hi;
            if (head == 0) { const int lrow = 8 * wid + (r32 >> 2); GS[lrow * 128 + j] = ga; LS[lrow * 128 + j] = la; GS[lrow * 128 + j + 8] = gb; LS[lrow * 128 + j + 8] = lb; }
        }
        pv_reg(o, vf, p0, p1);
    }
    asm volatile("s_waitcnt lgkmcnt(0)" ::: "memory");
#pragma unroll 4
    for (int i = 0; i < 16; ++i) { const int e = (8 * wid) * 128 + i * 64 + lane, j = e & 127;
        float sc; if (j == 0 || j == cur || j == cur - 1) sc = 1e6f; else if (j <= cur) sc = GS[e] + LS[e - 1]; else sc = -1.f;
        GS[e] = sc; }
    asm volatile("s_waitcnt lgkmcnt(0)" ::: "memory");
    unsigned wm0 = 0, wm1 = 0, wm2 = 0, wm3 = 0, sm0 = 0, sm1 = 0, sm2 = 0, sm3 = 0;
#pragma unroll 1
    for (int tk = 0; tk < 8; ++tk) { const int tok = 8 * wid + tk; const LAS float* sp = GS + tok * 128;
        const unsigned va = __float_as_uint(fmaxf(sp[lane], 0.f)), vb = __float_as_uint(fmaxf(sp[lane + 64], 0.f));
        unsigned T = 0;
#pragma unroll 1
        for (int bit = 30; bit >= 0; --bit) { const unsigned cand = T | (1u << bit);
            const int cnt = __builtin_popcountll(__ballot(va >= cand)) + __builtin_popcountll(__ballot(vb >= cand));
            T = cnt >= 16 ? cand : T; }
        unsigned long long ma = __ballot(va > T), mb = __ballot(vb > T);
        unsigned long long ea = __ballot(va == T), eb = __ballot(vb == T);
        int need = 16 - (__builtin_popcountll(ma) + __builtin_popcountll(mb));
#pragma unroll 1
        while (need > 0 && ea) { ma |= ea & (0ull - ea); ea &= ea - 1; --need; }
#pragma unroll 1
        while (need > 0 && eb) { mb |= eb & (0ull - eb); eb &= eb - 1; --need; }
        const unsigned a0 = (unsigned)ma, a1 = (unsigned)(ma >> 32), b0 = (unsigned)mb, b1 = (unsigned)(mb >> 32);
        if ((r32 >> 2) == tk) { sm0 = a0; sm1 = a1; sm2 = b0; sm3 = b1; }
        wm0 |= a0; wm1 |= a1; wm2 |= b0; wm3 |= b1; }
    wm0 = __builtin_amdgcn_readfirstlane(wm0); wm1 = __builtin_amdgcn_readfirstlane(wm1); wm2 = __builtin_amdgcn_readfirstlane(wm2); wm3 = __builtin_amdgcn_readfirstlane(wm3);
    asm volatile("s_waitcnt lgkmcnt(0)" ::: "memory");
    accum_lds<0>(ot0, ot1, o, g_cmp, wsf, lane, r32, hi);
    m = -1e30f; l = 0.f; o[0] = f32x16{}; o[1] = f32x16{};
    {
        int j = next_bit(wm0, wm1, wm2, wm3, 0, cur);
        if (j <= cur) loadK(kf, ks_img + (size_t)j * 8192, koff);
#pragma unroll 1
        while (j <= cur) {
            loadV(vf, vs_img + (size_t)j * 8192, voff);
            qkt_reg(p0, p1, kf, qr);
            const int jn = next_bit(wm0, wm1, wm2, wm3, j + 1, cur);
            loadK(kf, ks_img + (size_t)(jn <= cur ? jn : j) * 8192, koff);
            const bool en = (pick4(sm0, sm1, sm2, sm3, j >> 5) >> (j & 31)) & 1u;
            if (j == cur) mask_range(p0, p1, 0, tokl, hi);
            online_step(p0, p1, m, l, o, wsf, r32, hi, en);
            pv_reg(o, vf, p0, p1);
            j = jn;
        }
    }
    l = half_swap_sum(l);
    accum_lds<1>(ot0, ot1, o, g_sel / fmaxf(l, 1e-30f), wsf, lane, r32, hi);
    m = -1e30f; l = 0.f; o[0] = f32x16{}; o[1] = f32x16{};
    {
        const int j0 = cur >= 8 ? cur - 8 : 0;
        loadK(kf, kw_img + (size_t)j0 * 8192, koff);
#pragma unroll 1
        for (int j = j0; j <= cur; ++j) {
            loadV(vf, vw_img + (size_t)j * 8192, voff);
            qkt_reg(p0, p1, kf, qr);
            loadK(kf, kw_img + (size_t)(j < cur ? j + 1 : j) * 8192, koff);
            if (j == cur - 8 || j == cur) { const int lo = (j == cur - 8) ? tokl + 1 : 0, hh = (j == cur) ? tokl : 63; mask_range(p0, p1, lo, hh, hi); }
            online_step(p0, p1, m, l, o, wsf, r32, hi);
            pv_reg(o, vf, p0, p1);
        }
    }
    l = half_swap_sum(l);
    accum_lds<1>(ot0, ot1, o, g_win / fmaxf(l, 1e-30f), wsf, lane, r32, hi);
    asm volatile("s_waitcnt lgkmcnt(0)" ::: "memory");
    { const size_t rowb = (size_t)b * TS + t0 + 8 * tg + hi;
      const bf16_t* sab = (const bf16_t*)(ws + WS_SA) + rowb * 512 + g * 256 + r32; bf16_t* aob = (bf16_t*)(ws + WS_AOY) + rowb * 1024 + g * 256 + r32;
#pragma unroll
      for (int r = 0; r < 16; ++r)
#pragma unroll
        for (int d0 = 0; d0 < 2; ++d0) { const int co = (r & 3) * 64 + d0 * 32;
            aob[(2 * (r >> 2)) * 1024 + co] = (bf16_t)f2bf((d0 ? ot1 : ot0)[r * 64 + lane] * bf2f(sab[(2 * (r >> 2)) * 512 + co])); } }
}

__device__ __forceinline__ float row16_sum(float v) {
    v += __builtin_bit_cast(float, __builtin_amdgcn_update_dpp(0, __builtin_bit_cast(int, v), 0x128, 0xF, 0xF, false));
    v += __builtin_bit_cast(float, __builtin_amdgcn_update_dpp(0, __builtin_bit_cast(int, v), 0x124, 0xF, 0xF, false));
    v += __builtin_bit_cast(float, __builtin_amdgcn_update_dpp(0, __builtin_bit_cast(int, v), 0x122, 0xF, 0xF, false));
    v += __builtin_bit_cast(float, __builtin_amdgcn_update_dpp(0, __builtin_bit_cast(int, v), 0x121, 0xF, 0xF, false));
    return v; }
template <int PART  >
__device__ __forceinline__ void sample_unit(const Params& p, const Frame& F, int bs) {
    unsigned char* ws = p.ws;
    const int lane = F.lane, g = F.wave >> 2, wid = F.wave & 3, tid = F.tid & 255;
    LAS unsigned char* lds = F.lds + g * 40960;
    LAS float* q = (LAS float*)lds; LAS float* sc = (LAS float*)(lds + 1024); LAS float* impv = (LAS float*)(lds + 1024 + 4 * 1664 * 4);
    LAS int* sel = (LAS int*)(impv + 64); LAS float* osum = (LAS float*)(sel + 16);
    const size_t row = (size_t)MP + bs;
    __syncthreads();
    q[tid] = bf2f(((const bf16_t*)(ws + WS_QB))[row * 512 + g * 256 + tid]);
    __syncthreads();
    const int bg = bs * 2 + g;
    if (PART == 0) { const int c = tid & 127, hp = tid >> 7;
      float s0 = 0.f, s1 = 0.f;
      const unsigned char* img = ws + WS_KC + (size_t)(bg * 2 + (c >> 6)) * 8192; const int key = c & 63;
      u32x4 w[8];
#pragma unroll
      for (int ch = 0; ch < 8; ++ch) w[ch] = *(const u32x4*)(img + ch * 1024 + key * 16);
#pragma unroll
      for (int ch = 0; ch < 8; ++ch) { const float kf[8] = {bflo(w[ch].x), bfhi(w[ch].x), bflo(w[ch].y), bfhi(w[ch].y), bflo(w[ch].z), bfhi(w[ch].z), bflo(w[ch].w), bfhi(w[ch].w)};
#pragma unroll
          for (int e = 0; e < 8; ++e) { s0 += q[(2 * hp) * 64 + ch * 8 + e] * kf[e]; s1 += q[(2 * hp + 1) * 64 + ch * 8 + e] * kf[e]; } }
      sc[(2 * hp) * 1664 + c] = c < 127 ? s0 : -INFINITY; sc[(2 * hp + 1) * 1664 + c] = c < 127 ? s1 : -INFINITY; }
    const int kq_s = lane >> 4, d4_s = lane & 15;
    f32x4 qh[4];
#pragma unroll
    for (int h = 0; h < 4; ++h) qh[h] = *(const LAS f32x4*)(q + h * 64 + 4 * d4_s);
    if (PART == 1) {
        const float* ks = p.swin + ((size_t)bs * 512 + 1) * 256 + g * 64 + 4 * d4_s; const float* kn = p.out + O_WINS + ((size_t)bs * 512 + 511) * 256 + g * 64 + 4 * d4_s;
#pragma unroll
        for (int hb = 0; hb < 2; ++hb) { asm volatile("" ::: "memory"); f32x4 kv[16];
#pragma unroll
            for (int it = 0; it < 16; ++it) { const int i = 128 * wid + 4 * (16 * hb + it) + kq_s; kv[it] = *(const f32x4*)(i < 511 ? ks + (size_t)i * 256 : kn); }
#pragma unroll
            for (int it = 0; it < 16; ++it) { const int i = 128 * wid + 4 * (16 * hb + it) + kq_s; float sv = 0.f;
#pragma unroll
                for (int h = 0; h < 4; ++h) { const float d = row16_sum((qh[h][0] * kv[it][0] + qh[h][1] * kv[it][1]) + (qh[h][2] * kv[it][2] + qh[h][3] * kv[it][3])); sv = (d4_s == h) ? d : sv; }
                if (d4_s < 4) sc[d4_s * 1664 + 1152 + i] = sv; } }
    }
    __syncthreads();
    auto softmax_head = [&](int off, int n) {
        { LAS float* sp = sc + wid * 1664 + off; float mx = -INFINITY;
            for (int i = lane; i < n; i += 64) mx = fmaxf(mx, sp[i]);
#pragma unroll
            for (int o2 = 1; o2 < 64; o2 <<= 1) mx = fmaxf(mx, __shfl_xor(mx, o2));
            float sm = 0.f;
            for (int i = lane; i < n; i += 64) { const float e = __builtin_amdgcn_exp2f(sp[i] - mx); sp[i] = e; sm += e; }
            sm = wave_sum(sm); const float inv = 1.f / fmaxf(sm, 1e-30f);
            for (int i = lane; i < n; i += 64) sp[i] *= inv; }
        __syncthreads();
    };
    if (PART == 1) softmax_head(1152, 512);
    if (PART == 0) {
    softmax_head(0, 128);
    if (tid < 64) { float s = -1.f; const int j = tid;
        if (j < 33) { s = 0.f; for (int c = 4 * j - 1; c <= 4 * j + 3; ++c) if (c >= 0 && c < 127) s += (sc[c] + sc[1664 + c]) + (sc[2 * 1664 + c] + sc[3 * 1664 + c]);
            if (j == 0 || j == 31 || j == 32) s = 1e6f; }
        impv[j] = j < 33 ? s : -2.f; }
    __syncthreads();
    if (tid < 64) { const float sj = impv[tid]; int rk = 0; for (int i = 0; i < 33; ++i) { const float v = impv[i]; rk += (v > sj || (v == sj && i < tid)) ? 1 : 0; }
        if (tid < 33 && rk < 16) sel[rk] = tid; }
    __syncthreads();
#pragma unroll 1
    for (int rr = 0; rr < 4; ++rr) { const int r = 4 * wid + rr, j = sel[r];
        const float* kb = j < 32 ? p.cache + (((size_t)p.ptab[bs * 16 + (j >> 1)] * 128 + (j & 1) * 64) * 4 + 2) * 128 + g * 64 + 4 * d4_s : p.out + O_KVS + ((size_t)bs * 4 + 2) * 128 + g * 64 + 4 * d4_s;
        f32x4 kv[16];
#pragma unroll
        for (int it = 0; it < 16; ++it) kv[it] = *(const f32x4*)(kb + (j < 32 ? (size_t)(4 * it + kq_s) * 512 : 0));
#pragma unroll
        for (int it = 0; it < 16; ++it) { const int i = 4 * it + kq_s; float sv = 0.f;
#pragma unroll
            for (int h = 0; h < 4; ++h) { const float d = row16_sum((qh[h][0] * kv[it][0] + qh[h][1] * kv[it][1]) + (qh[h][2] * kv[it][2] + qh[h][3] * kv[it][3])); sv = (d4_s == h) ? d : sv; }
            if (d4_s < 4) sc[d4_s * 1664 + 128 + r * 64 + i] = (j < 32 || i == 0) ? sv : -INFINITY; } }
    __syncthreads();
    softmax_head(128, 1024);
    }
    const float* ngp = (const float*)(ws + WS_NG) + row * 32 + g * 12;
    const int kq = lane >> 4, d4 = lane & 15;
    f32x4 tot[4]; f32x4 br[4];
#pragma unroll
    for (int h = 0; h < 4; ++h) { tot[h] = (f32x4){0.f, 0.f, 0.f, 0.f}; br[h] = tot[h]; }
    if (PART == 0) {
#pragma unroll
    for (int it = 0; it < 8; ++it) { const int c = 32 * wid + 4 * it + kq; const unsigned char* img = ws + WS_KC + KC_KIND_BYTES + (size_t)(bg * 2 + (c >> 6)) * 8192; const int key = c & 63, d = 4 * d4;
        const int k16 = key & 15, pp = 8 * ((k16 >> 2) & 1) + 4 * (k16 >> 3) + (k16 & 3); const unsigned char* vp_ = img + (key >> 4) * 2048 + d * 32 + pp * 2;
        const f32x4 v = {bf2f(*(const bf16_t*)vp_), bf2f(*(const bf16_t*)(vp_ + 32)), bf2f(*(const bf16_t*)(vp_ + 64)), bf2f(*(const bf16_t*)(vp_ + 96))};
#pragma unroll
        for (int h = 0; h < 4; ++h) br[h] += sc[h * 1664 + c] * v; }
#pragma unroll
    for (int h = 0; h < 4; ++h) { tot[h] += ngp[h * 3] * br[h]; br[h] = (f32x4){0.f, 0.f, 0.f, 0.f}; }
    { const float* vbs[4]; int jj[4];
#pragma unroll
      for (int rr = 0; rr < 4; ++rr) { const int r = 4 * wid + rr; jj[rr] = sel[r]; const int jc = jj[rr] < 32 ? jj[rr] : 0;
          vbs[rr] = p.cache + (((size_t)p.ptab[bs * 16 + (jc >> 1)] * 128 + (jc & 1) * 64) * 4 + 3) * 128 + g * 64 + 4 * d4; }
#pragma unroll
      for (int rr = 0; rr < 4; ++rr) { const int r = 4 * wid + rr;
          asm volatile("" ::: "memory");
          if (jj[rr] < 32) {
              f32x4 v[16];
#pragma unroll
              for (int it = 0; it < 16; ++it) v[it] = *(const f32x4*)(vbs[rr] + (size_t)(4 * it + kq) * 512);
#pragma unroll
              for (int it = 0; it < 16; ++it) { const int i = 4 * it + kq;
#pragma unroll
                  for (int h = 0; h < 4; ++h) br[h] += sc[h * 1664 + 128 + r * 64 + i] * v[it]; } }
          else if (kq == 0) { const f32x4 v = *(const f32x4*)(p.out + O_KVS + ((size_t)bs * 4 + 3) * 128 + g * 64 + 4 * d4);
#pragma unroll
              for (int h = 0; h < 4; ++h) br[h] += sc[h * 1664 + 128 + r * 64] * v; } } }
#pragma unroll
    for (int h = 0; h < 4; ++h) { tot[h] += ngp[h * 3 + 1] * br[h]; br[h] = (f32x4){0.f, 0.f, 0.f, 0.f}; }
    }
    if (PART == 1) { const float* vbs = p.swin + ((size_t)bs * 512 + 1) * 256 + 128 + g * 64 + 4 * d4; const float* vbn = p.out + O_WINS + ((size_t)bs * 512 + 511) * 256 + 128 + g * 64 + 4 * d4;
#pragma unroll
      for (int hb = 0; hb < 2; ++hb) { asm volatile("" ::: "memory"); f32x4 v[16];
#pragma unroll
          for (int it = 0; it < 16; ++it) { const int i = 128 * wid + 4 * (16 * hb + it) + kq; v[it] = *(const f32x4*)(i < 511 ? vbs + (size_t)i * 256 : vbn); }
#pragma unroll
          for (int it = 0; it < 16; ++it) { const int i = 4 * (16 * hb + it) + kq;
#pragma unroll
              for (int h = 0; h < 4; ++h) br[h] += sc[h * 1664 + 1152 + 128 * wid + i] * v[it]; } } }
#pragma unroll
    for (int h = 0; h < 4; ++h) { tot[h] += ngp[h * 3 + 2] * br[h];
#pragma unroll
        for (int e = 0; e < 4; ++e) { float x = tot[h][e]; x += __shfl_xor(x, 16); x += __shfl_xor(x, 32); tot[h][e] = x; } }
    if (kq == 0) {
#pragma unroll
        for (int h = 0; h < 4; ++h) *(LAS f32x4*)(osum + (wid * 4 + h) * 64 + 4 * d4) = tot[h]; }
    __syncthreads();
    { const int h = tid >> 6, d = tid & 63; float s = 0.f;
#pragma unroll
        for (int w = 0; w < 4; ++w) s += osum[(w * 4 + h) * 64 + d];
        const int col = (g * 4 + h) * 64 + d;
        ((float*)(ws + WS_SPART))[((size_t)PART * 128 + bs) * 512 + col] = s; }
}
}
#define XB_TMO      128
#define XB_XCNT(j)  (256  + 64 * (j))
#define XB_XSUB(j)  (1280 + 64 * (j))
#define XB_XGEN(j)  (2304 + 64 * (j))
#define XB_TOP      3328
#define XB_TOPGEN   3392
#define XCD_BAR_WORDS 3456
#define XB_SPIN_CAP (1u << 22)
__device__ __forceinline__ unsigned xb_ld(unsigned* p)              { return __hip_atomic_load(p, __ATOMIC_RELAXED, __HIP_MEMORY_SCOPE_AGENT); }
__device__ __forceinline__ unsigned xb_add(unsigned* p, unsigned v) { return __hip_atomic_fetch_add(p, v, __ATOMIC_RELAXED, __HIP_MEMORY_SCOPE_AGENT); }
__device__ __forceinline__ unsigned xb_xcc_id() { return (unsigned)__builtin_amdgcn_s_getreg((3 << 11) | 20) & 0xFu; }
#define XB_SPIN(cond, bar) do { unsigned _sp = 0; while (cond) { __builtin_amdgcn_s_sleep(1); \
    if ((++_sp & 255u) == 0u) { if (xb_ld(&(bar)[XB_TMO])) break; if (_sp > XB_SPIN_CAP) { atomicAdd(&(bar)[XB_TMO], 1u); break; } } } } while (0)
struct XcdBarrier { unsigned* bar; unsigned x; volatile LAS unsigned* st; };
__device__ __forceinline__ XcdBarrier xcd_barrier_post(unsigned* bar, volatile LAS unsigned* st) {
    XcdBarrier b; b.bar = bar; b.x = xb_xcc_id(); b.st = st;
    if (threadIdx.x == 0) (void)xb_add(&bar[XB_XCNT(b.x)], 1u);
    return b;
}
__device__ __forceinline__ void xcd_barrier_complete(unsigned* bar, unsigned x, unsigned& nloc, unsigned& nx) {
    const unsigned G = gridDim.x * gridDim.y * gridDim.z;
    unsigned sum, cnt, mine, sp = 0u;
    for (;;) {
        sum = 0u; cnt = 0u; mine = 0u;
#pragma unroll
        for (unsigned j = 0; j < 16; ++j) { const unsigned c = xb_ld(&bar[XB_XCNT(j)]); sum += c; cnt += (c > 0u) ? 1u : 0u; mine = (j == x) ? c : mine; }
        if (sum == G) break;
        __builtin_amdgcn_s_sleep(1);
        if ((++sp & 255u) == 0u) { if (xb_ld(&bar[XB_TMO])) break; if (sp > XB_SPIN_CAP) { atomicAdd(&bar[XB_TMO], 1u); break; } }
    }
    nloc = mine > 0u ? mine : 1u; nx = cnt > 0u ? cnt : 1u;
}
__device__ __forceinline__ void xcd_barrier(const XcdBarrier& b) {
    asm volatile("s_waitcnt vmcnt(0)" ::: "memory");
    __syncthreads();
    if (threadIdx.x == 0) {
        unsigned* bar = b.bar;
        __builtin_amdgcn_s_waitcnt(0);
        unsigned nloc = b.st[0], nx = b.st[1];
        if (nloc == 0u) { xcd_barrier_complete(bar, b.x, nloc, nx); b.st[0] = nloc; b.st[1] = nx; }
        const unsigned old = xb_add(&bar[XB_XSUB(b.x)], 1u);
        const unsigned gen = old / nloc;
        if (old + 1u == (gen + 1u) * nloc) {
            __builtin_amdgcn_fence(__ATOMIC_RELEASE, "agent");
            asm volatile("s_waitcnt vmcnt(0)" ::: "memory");
            const unsigned og = xb_add(&bar[XB_TOP], 1u);
            const unsigned tg = og / nx;
            if (og + 1u == (tg + 1u) * nx) xb_add(&bar[XB_TOPGEN], 1u);
            else XB_SPIN(xb_ld(&bar[XB_TOPGEN]) == tg, bar);
            __builtin_amdgcn_fence(__ATOMIC_ACQUIRE, "agent");
            xb_add(&bar[XB_XGEN(b.x)], 1u);
            asm volatile("s_waitcnt vmcnt(0)" ::: "memory");
        } else {
            XB_SPIN(xb_ld(&bar[XB_XGEN(b.x)]) == gen, bar);
            __builtin_amdgcn_fence(__ATOMIC_ACQUIRE, "agent");
            asm volatile("s_waitcnt vmcnt(0)" ::: "memory");
        }
    }
    __syncthreads();
}
constexpr int LDS_MISC_OFF = 147200;

constexpr int LDS_BYTES = 147456;
constexpr int NPHASE = 8;

__global__ void __launch_bounds__(NTHR, 2) mk_fwd(Params p) {
    extern __shared__ __attribute__((aligned(16))) unsigned char lds_raw[];
    Frame F; F.lds = (LAS unsigned char*)lds_raw; F.tid = threadIdx.x; F.lane = F.tid & 63; F.wave = __builtin_amdgcn_readfirstlane(F.tid >> 6);
    F.G = gridDim.x; { const int bx = blockIdx.x; F.vcu = (F.G % 8 == 0) ? (bx % 8) * (F.G / 8) + bx / 8 : bx; }
    unsigned char* ws = p.ws;
    const int lo = p.ph_lo, hi = p.ph_hi;
    volatile LAS unsigned* misc = (volatile LAS unsigned*)(F.lds + LDS_MISC_OFF);
    if (F.tid < 2) misc[F.tid] = 0u;
    __syncthreads();
    XcdBarrier xbar; xbar.bar = (unsigned*)(ws + WS_CTL) + 4096; xbar.x = 0; xbar.st = misc;
    if (hi - lo > 1) xbar = xcd_barrier_post((unsigned*)(ws + WS_CTL) + 4096, misc);
#ifndef MK_PHASE_MASK
#define MK_PHASE_MASK 0xff
#endif
#define IN(k) (((MK_PHASE_MASK >> (k)) & 1) && lo <= (k) && (k) < hi)
#if defined(MK_TIMING)
    unsigned* tsw = (unsigned*)(ws + WS_CTL + (2u << 20));
#define TDONE(k) do { if (IN(k) && F.tid == 0) atomicMax(&tsw[16 + (k)], (unsigned)__builtin_amdgcn_s_memrealtime()); } while (0)
#define TSTART(k) do { if (blockIdx.x == 0 && F.tid == 0) tsw[(k)] = (unsigned)__builtin_amdgcn_s_memrealtime(); } while (0)
#else
#define TDONE(k) do { } while (0)
#define TSTART(k) do { } while (0)
#endif
#define SEAM(k) do { TDONE(k); if (IN(k) && IN((k) + 1)) { MK_GRID_SYNC(); } TSTART((k) + 1); } while (0)
#ifndef MK_GRID_SYNC
#define MK_GRID_SYNC() xcd_barrier(xbar)
#endif
#define PUBLISH(cp) do { asm volatile("s_waitcnt vmcnt(0)" ::: "memory"); __syncthreads(); \
        if (F.tid == 0) { __builtin_amdgcn_fence(__ATOMIC_RELEASE, "agent"); asm volatile("s_waitcnt vmcnt(0)" ::: "memory"); __hip_atomic_fetch_add((cp), 1u, __ATOMIC_RELAXED, __HIP_MEMORY_SCOPE_AGENT); } } while (0)
#define AWAIT(cp, n) do { if (F.tid == 0) { unsigned sp_ = 0; while (__hip_atomic_load((cp), __ATOMIC_RELAXED, __HIP_MEMORY_SCOPE_AGENT) < (unsigned)(n)) { __builtin_amdgcn_s_sleep(2); if (++sp_ > (1u << 22)) break; } \
            __builtin_amdgcn_fence(__ATOMIC_ACQUIRE, "agent"); asm volatile("s_waitcnt vmcnt(0)" ::: "memory"); } __syncthreads(); } while (0)
    unsigned* p34 = (unsigned*)(ws + WS_CTL + 57344);
    TSTART(0);
    if (IN(0)) { phase0(p, F); } SEAM(0);
    if (IN(1)) { phase1(p, F); } SEAM(1);
    if (IN(2)) {
        if (F.G != 256) { cache_span(p.cache, p.ptab, ws, (int)blockIdx.x * NWAVES + F.wave, N_CACHE_ITEMS, F.G * NWAVES, F.lane); asm volatile("s_waitcnt vmcnt(0)" ::: "memory"); __syncthreads(); }
        { pg8::Gemm g{(const bf16_t*)(ws + WS_H), (const bf16_t*)(ws + WS_WINT), 1024, 1024, 1024}; SchedMain S{F.G, (int)blockIdx.x};
          EpiMain E{p.out, (bf16_t*)(ws + WS_QB), (bf16_t*)(ws + WS_CMPA) + (size_t)32768 * 1024, (bf16_t*)(ws + WS_CMPA + CMPA_KIND_BYTES) + (size_t)32768 * 1024, (bf16_t*)(ws + WS_KVI),
                    (bf16_t*)(ws + WS_SA), (bf16_t*)(ws + WS_U), (bf16_t*)(ws + WS_CBG), (bf16_t*)(ws + WS_GA), (bf16_t*)(ws + WS_GB), (const float*)(ws + WS_ROPE), p.cache, p.ptab, ws, (int)blockIdx.x, F.G, p.conv_w, (bf16_t*)(ws + WS_AOY)};
          pg8::gemm_phase(F.lds, g, S, E); }
#if defined(MK_SPLIT2)
    }
    if (lo <= 8 && 8 < hi) {
#else
        if (hi - lo > 1) MK_GRID_SYNC();
#endif
        { pg8::Gemm g{(const bf16_t*)(ws + WS_CMPA), (const bf16_t*)(ws + WS_WC1), 1024, 2048, 2048}; SchedCmp S{F.G, (int)blockIdx.x, 0, 128};
          EpiCmp1 E{(bf16_t*)(ws + WS_HID), (const float*)(ws + WS_PEB)};
          pg8::gemm_phase(F.lds, g, S, E);
          asm volatile("s_waitcnt vmcnt(0)" ::: "memory"); __syncthreads();
          { pg8::Gemm g2{(const bf16_t*)(ws + WS_HID), (const bf16_t*)(ws + WS_WC2), 256, 256, 256}; SchedCmp2 S2{F.G, (int)blockIdx.x, 0, 128};
            EpiCmp2 E2{ws + WS_KC}; pg8::gemm_phase(F.lds, g2, S2, E2); } }
        PUBLISH(p34 + 128);
    }
    TDONE(2); TSTART(3);
    if (IN(3)) {
        const int c = (int)blockIdx.x;
        if (c < 16) {
            pg8::Gemm g{(const bf16_t*)(ws + WS_CMPA), (const bf16_t*)(ws + WS_WC1), 1024, 2048, 2048}; SchedCmp S{F.G, c, 128, 8};
            EpiCmp1 E{(bf16_t*)(ws + WS_HID), (const float*)(ws + WS_PEB)};
            pg8::gemm_phase(F.lds, g, S, E);
            asm volatile("s_waitcnt vmcnt(0)" ::: "memory"); __syncthreads();
            { pg8::Gemm g2{(const bf16_t*)(ws + WS_HID), (const bf16_t*)(ws + WS_WC2), 256, 256, 256}; SchedCmp2 S2{F.G, c, 128, 8};
              EpiCmp2 E2{ws + WS_KC}; pg8::gemm_phase(F.lds, g2, S2, E2); }
            PUBLISH(p34);
        } else {
            const int gw = (c - 16) * NWAVES + F.wave, NGW = (F.G - 16) * NWAVES;
            for (int it = gw; it < MP / 32 + (MALL - MP); it += NGW) ybin_row(p, it < MP / 32 ? (it >> 1) * 64 + (it & 1) : MP + (it - MP / 32), F.lane);
            if (c < 144) { AWAIT(p34 + 128, F.G); for (int u = c - 16; u < 128; u += 128) att::sample_unit<0>(p, F, u); PUBLISH(p34 + 64); }
            else { for (int u = c - 144; u < 128; u += F.G - 144) att::sample_unit<1>(p, F, u);
                PUBLISH(p34 + 64);
                for (int it = (c - 144) * NWAVES + F.wave; it < N_WINC; it += (F.G - 144) * NWAVES) wincopy_item(p, it, F.lane); }
        }
    }
    TDONE(3); TSTART(4);
    if (IN(4)) {
        AWAIT(p34, 16);
        if ((F.vcu % (F.G >> 2)) == 0 && F.G >= 4 && F.vcu / (F.G >> 2) < 4) {
            AWAIT(p34 + 64, F.G - 16);
            const int pn = F.vcu / (F.G >> 2); unsigned* gcnt = (unsigned*)(ws + WS_CTL + 49152);
            for (int gi = F.tid; gi < 128 * 512; gi += NTHR) { const float* sp = (const float*)(ws + WS_SPART); const size_t row = (size_t)MP + (gi >> 9); const int col = gi & 511;
                ((bf16_t*)(ws + WS_AOY))[row * 1024 + col] = (bf16_t)f2bf((sp[gi] + sp[128 * 512 + gi]) * bf2f(((const bf16_t*)(ws + WS_SA))[row * 512 + col])); }
            asm volatile("s_waitcnt vmcnt(0)" ::: "memory"); __syncthreads();
#define GROUP4_SYNC(k) do { asm volatile("s_waitcnt vmcnt(0)" ::: "memory"); __syncthreads(); \
            if (F.tid == 0) { __builtin_amdgcn_fence(__ATOMIC_RELEASE, "agent"); asm volatile("s_waitcnt vmcnt(0)" ::: "memory"); \
                __hip_atomic_fetch_add(gcnt + 64 * (k), 1u, __ATOMIC_RELAXED, __HIP_MEMORY_SCOPE_AGENT); unsigned sp_ = 0; \
                while (__hip_atomic_load(gcnt + 64 * (k), __ATOMIC_RELAXED, __HIP_MEMORY_SCOPE_AGENT) < 4u) { __builtin_amdgcn_s_sleep(2); if (++sp_ > (1u << 22)) break; } \
                __builtin_amdgcn_fence(__ATOMIC_ACQUIRE, "agent"); asm volatile("s_waitcnt vmcnt(0)" ::: "memory"); } \
            __syncthreads(); } while (0)
            { pg8::Gemm g{(const bf16_t*)(ws + WS_AOY), (const bf16_t*)(ws + WS_WBR), 1024, 1024, 1024}; SchedOne S{64, pn};
              EpiE1 E{(const bf16_t*)(ws + WS_GA), (const bf16_t*)(ws + WS_GB), (bf16_t*)(ws + WS_OPRE)}; pg8::gemm_phase(F.lds, g, S, E); }
            GROUP4_SYNC(0);
            { pg8::Gemm g{(const bf16_t*)(ws + WS_OPRE), (const bf16_t*)(ws + WS_WOUT), 1024, 1024, 1024}; SchedOne S{64, pn};
              EpiE2 E{(bf16_t*)(ws + WS_O), (float*)(ws + WS_SSQP)}; pg8::gemm_phase(F.lds, g, S, E); }
            GROUP4_SYNC(1);
            for (int r = F.wave; r < 32; r += NWAVES) final_row(p, p.out, MP + 32 * pn + r, F.lane);
#undef GROUP4_SYNC
        }
        { const int bgi = (F.vcu * 4) / F.G; unsigned* ctr = (unsigned*)(ws + WS_CTL + 32768) + 64 * bgi;
#pragma unroll 1
          for (;;) { unsigned k = 0; if (F.lane == 0) k = __hip_atomic_fetch_add(ctr, 1u, __ATOMIC_RELAXED, __HIP_MEMORY_SCOPE_AGENT);
              k = (unsigned)__builtin_amdgcn_readfirstlane((int)k); if (k >= 1024u) break;
              att::prompt_unit(p, F, bgi >> 1, bgi & 1, 127 - (int)(k >> 3), (int)(k & 7)); } }
    }
    SEAM(4);
    if (IN(5)) { pg8::Gemm g{(const bf16_t*)(ws + WS_AOY), (const bf16_t*)(ws + WS_WBR), 1024, 1024, 1024}; SchedE2 S{F.G, (int)blockIdx.x};
        EpiE1 E{(const bf16_t*)(ws + WS_GA), (const bf16_t*)(ws + WS_GB), (bf16_t*)(ws + WS_OPRE)};
        pg8::gemm_phase(F.lds, g, S, E); }
    SEAM(5);
    if (IN(6)) { pg8::Gemm g{(const bf16_t*)(ws + WS_OPRE), (const bf16_t*)(ws + WS_WOUT), 1024, 1024, 1024}; SchedE2 S{F.G, (int)blockIdx.x};
        EpiE2 E{(bf16_t*)(ws + WS_O), (float*)(ws + WS_SSQP)};
        pg8::gemm_phase(F.lds, g, S, E); }
    SEAM(6);
    if (IN(7)) { const int gw = F.vcu * NWAVES + F.wave, NGW = F.G * NWAVES;
        for (int row = gw; row < MP; row += NGW) final_row(p, p.out, row, F.lane); }
    TDONE(7);
#undef IN
#undef SEAM
}
}

static mk::Params make_params(void* const* d_in, float* out, unsigned char* ws) {
    mk::Params p{};
    p.xp = (const float*)d_in[0]; p.xs = (const float*)d_in[1]; p.cache = (const float*)d_in[2]; p.swin = (const float*)d_in[3]; p.sconv = (const float*)d_in[4]; p.ptab = (const int*)d_in[5];
    p.cp = (const float*)d_in[6]; p.cs = (const float*)d_in[7]; p.w_ada = (const float*)d_in[8]; p.b_ada = (const float*)d_in[9]; p.g_pre = (const float*)d_in[10]; p.g_post = (const float*)d_in[11];
    p.w_in = (const float*)d_in[12]; p.pe = (const float*)d_in[13]; p.w1 = (const float*)d_in[14]; p.w2 = (const float*)d_in[15]; p.conv_w = (const float*)d_in[16];
    p.wba = (const float*)d_in[17]; p.wbb = (const float*)d_in[18]; p.wout = (const float*)d_in[19];
    p.out = out; p.ws = ws; p.ph_lo = 0; p.ph_hi = mk::NPHASE;
    return p;
}
static int mk_grid() {
    static int grid = 0;
    if (grid == 0) {
        int dev = 0, cus = 0, per_cu = 0;
        (void)hipGetDevice(&dev); (void)hipDeviceGetAttribute(&cus, hipDeviceAttributeMultiprocessorCount, dev);
        (void)hipFuncSetAttribute((const void*)mk::mk_fwd, hipFuncAttributeMaxDynamicSharedMemorySize, mk::LDS_BYTES);
        (void)hipOccupancyMaxActiveBlocksPerMultiprocessor(&per_cu, (const void*)mk::mk_fwd, mk::NTHR, mk::LDS_BYTES);
        if (per_cu < 1) { fprintf(stderr, "mk: occupancy query says %d blocks per CU\n", per_cu); per_cu = 1; }
        grid = cus;
        (void)hipGetLastError();
    }
    return grid;
}
static void mk_launch(mk::Params p, int lo, int hi, hipStream_t stream) {
    p.ph_lo = lo; p.ph_hi = hi; const int grid = mk_grid();
    if (hi - lo > 1) { void* args[] = {&p}; hipError_t e = hipLaunchCooperativeKernel((const void*)mk::mk_fwd, dim3(grid), dim3(mk::NTHR), args, mk::LDS_BYTES, stream);
        if (e != hipSuccess) fprintf(stderr, "cooperative launch failed: %s (grid %d)\n", hipGetErrorString(e), grid); }
    else hipLaunchKernelGGL(mk::mk_fwd, dim3(grid), dim3(mk::NTHR), mk::LDS_BYTES, stream, p);
}
extern "C" void kernel_launch(void* const* d_in, const int* in_sizes, int n_in, void* d_out, int out_size, void* d_ws, size_t ws_size, hipStream_t stream) {
    (void)in_sizes; (void)n_in; (void)out_size; (void)ws_size;
    (void)hipMemsetAsync((unsigned char*)d_ws + mk::WS_CTL, 0, 65536, stream);
    mk::Params p = make_params(d_in, (float*)d_out, (unsigned char*)d_ws);
#if defined(MK_MULTI_LAUNCH)
    for (int ph = 0; ph < mk::NPHASE; ++ph) mk_launch(p, ph, ph + 1, stream);
#else
    mk_launch(p, 0, mk::NPHASE, stream);
#endif
}
```

```cpp
#include <hip/hip_runtime.h>
#include <hip/hip_cooperative_groups.h>
#include <cstdio>
#include <cstdint>
#include <cmath>
namespace cg = cooperative_groups;
#define LAS __attribute__((address_space(3)))
typedef unsigned short bf16_t;
typedef short bf16x8 __attribute__((ext_vector_type(8)));
typedef float f32x4 __attribute__((ext_vector_type(4)));
typedef float f32x2 __attribute__((ext_vector_type(2)));
typedef float f32x16 __attribute__((ext_vector_type(16)));
typedef unsigned u32x4 __attribute__((ext_vector_type(4)));
typedef unsigned u32x2 __attribute__((ext_vector_type(2)));

namespace mk {
constexpr int DM = 1024, TS = 8192, MP = 16384, SB = 128, MALL = 16512, MPAD = 16640, INW = 5912, NV = 5888;
constexpr int C_G = 1280, C_A = 1304, C_CB = 1816, C_CC = 2328, C_CX = 2840, C_CG = 3352, C_GA = 3864;
constexpr size_t O_YP = 0, O_YS = 16777216, O_KVP = 16908288, O_WINP = 25296896, O_CSP = 25559040, O_KVS = 25561088, O_WINS = 25626624, O_CSS = 42403840, O_END = 42534912;
constexpr float QSCALE = 0.125f * 1.4426950408889634f;
constexpr int NWAVES = 8, NTHR = 512;

constexpr size_t MiB = 1u << 20;
constexpr size_t WS_CTL = 0;
constexpr size_t CTL_BYTES = 4 * MiB;
constexpr size_t WS_MOD = 4 * MiB;
constexpr size_t WS_ROPE = 6 * MiB;
constexpr size_t WS_PEBP = 7 * MiB;
constexpr size_t WS_PEB = 7 * MiB + 65536;
constexpr size_t WS_WGT = 7 * MiB + 262144;
constexpr size_t WS_NG = 8 * MiB;
constexpr size_t WS_SPART = 13 * MiB;
constexpr size_t WS_SSQP = 11 * MiB;
constexpr size_t WS_WINT = 16 * MiB;
constexpr size_t WS_WBR = 28 * MiB;
constexpr size_t WS_WOUT = 30 * MiB;
constexpr size_t WS_WC1 = 32 * MiB;
constexpr size_t WS_WC2 = 34 * MiB;
constexpr size_t WS_H = 36 * MiB;
constexpr size_t WS_QB = 72 * MiB;
constexpr size_t WS_SA = 90 * MiB;
constexpr size_t WS_U = 108 * MiB;
constexpr size_t WS_CBG = 126 * MiB;
constexpr size_t WS_GA = 144 * MiB;
constexpr size_t WS_GB = 178 * MiB;
constexpr size_t WS_KVI = 212 * MiB;
constexpr size_t WS_KC = 230 * MiB;
constexpr size_t KC_KIND_BYTES = (size_t)34816 * 64 * 2;
constexpr size_t WS_HID = 240 * MiB;
constexpr size_t HID_KIND_BYTES = (size_t)34816 * 256 * 2;
constexpr size_t WS_CMPA = 276 * MiB;
constexpr size_t CMPA_KIND_BYTES = (size_t)(34816 + 2) * 1024 * 2;
constexpr size_t WS_AOY = 420 * MiB;
constexpr size_t WS_T1 = 456 * MiB;
constexpr size_t WS_OPRE = 524 * MiB;
constexpr size_t WS_O = 560 * MiB;
constexpr size_t WS_END = 628 * MiB;
constexpr size_t WS_OUT2 = 640 * MiB;
constexpr size_t WS_ORC = 1024 * MiB;

struct Params {
    const float *xp, *xs, *cache, *swin, *sconv; const int* ptab; const float *cp, *cs, *w_ada, *b_ada, *g_pre, *g_post, *w_in, *pe, *w1, *w2, *conv_w, *wba, *wbb, *wout;
    float* out; unsigned char* ws; int ph_lo, ph_hi;
};

__device__ __forceinline__ float fast_rcp(float x) { return __builtin_amdgcn_rcpf(x); }
__device__ __forceinline__ float sigm(float x) { return fast_rcp(1.f + __expf(-x)); }
__device__ __forceinline__ float silu(float x) { return x * fast_rcp(1.f + __expf(-x)); }
__device__ __forceinline__ unsigned f2bf(float f) { unsigned u = __builtin_bit_cast(unsigned, f); return (u + 0x7fffu + ((u >> 16) & 1u)) >> 16; }
__device__ __forceinline__ unsigned pk2(float lo, float hi) { typedef __bf16 bf16x2_t __attribute__((ext_vector_type(2))); f32x2 v = {lo, hi}; bf16x2_t b = __builtin_convertvector(v, bf16x2_t); return __builtin_bit_cast(unsigned, b); }
__device__ __forceinline__ float bf2f(unsigned short b) { return __builtin_bit_cast(float, (unsigned)b << 16); }
__device__ __forceinline__ float bflo(unsigned w) { return __builtin_bit_cast(float, w << 16); }
__device__ __forceinline__ float bfhi(unsigned w) { return __builtin_bit_cast(float, w & 0xffff0000u); }

namespace pg8 {
constexpr int BM = 256, BK = 64, HALF = 128, HTB = HALF * BK * 2, STAGE_BYTES = 8 * HTB, NXCD = 8, WGM = 8;
__host__ __device__ __forceinline__ int lds_byte(int r, int c) { const int st = (r >> 4) * 2 + (c >> 5), rr = r & 15, cc = c & 31, ob = rr * 64 + cc * 2; return st * 1024 + (ob ^ (((ob >> 9) & 1) << 5)); }
__host__ __device__ __forceinline__ void stage_rc(int b, int& R, int& C) { const int st = b / 1024, sb = b % 1024, swz = sb ^ (((sb >> 9) & 1) << 5); R = (st >> 1) * 16 + swz / 64; C = (st & 1) * 32 + (swz % 64) / 2; }
__host__ __device__ __forceinline__ int perm32(int rho) { const int n = rho >> 4, i = rho & 15; return 8 * (i >> 2) + 4 * n + (i & 3); }

struct Unit { int pm, pn, aux; size_t aoff, boff; };
struct Gemm { const bf16_t* A; const bf16_t* Bt; int lda, ldb, K; };

__device__ __forceinline__ bool static_tile_L(long L, int nM, int nN, int& pm, int& pn);
__device__ __forceinline__ bool static_tile(int i, int G, int c, int nM, int nN, int& pm, int& pn) { return static_tile_L((long)i * G + c, nM, nN, pm, pn); }
__device__ __forceinline__ bool static_tile_L(long L, int nM, int nN, int& pm, int& pn) {
    const int nwg = nM * nN; if (L >= nwg) return false;
    int wgid = (int)L; { const int q = nwg / NXCD, r = nwg % NXCD, xcd = wgid % NXCD, off = wgid / NXCD; wgid = (xcd < r ? xcd * (q + 1) : r * (q + 1) + (xcd - r) * q) + off; }
    const int nig = WGM * nN, gid = wgid / nig, fm = gid * WGM, gsz = (nM - fm) < WGM ? (nM - fm) : WGM;
    pm = fm + ((wgid % nig) % gsz); pn = (wgid % nig) / gsz; return true;
}

template <class Epi, class Sched>
__device__ __forceinline__ void gemm_phase(LAS unsigned char* lds, const Gemm g, const Sched& S, const Epi& E) {
    const int tid = threadIdx.x, wid = __builtin_amdgcn_readfirstlane(tid >> 6), lane = tid & 63, wr = wid >> 2, wc = wid & 3, fr = lane & 15, fq = lane >> 4;
    const int nt = g.K / BK;
    unsigned voffA[2], voffB[2];
#pragma unroll
    for (int i = 0; i < 2; ++i) { int R, C; stage_rc(tid * 16 + i * 8192, R, C); const int Rb = Epi::PERM ? ((R & ~31) + perm32(R & 31)) : R;
        voffA[i] = (unsigned)(R * g.lda + C) * 2u; voffB[i] = (unsigned)(Rb * g.ldb + C) * 2u; }
    const size_t kstep = (size_t)(BK * 2);
    const size_t hstepA = (size_t)HALF * g.lda * 2, hstepB = (size_t)HALF * g.ldb * 2;
    const unsigned ldsw = (unsigned)wid * 1024u;
    const int aoff = lds_byte(wr * 64 + fr, fq * 8), boff = lds_byte(wc * 32 + fr, fq * 8);
#define PG8_SA(b, h) (((b) * 2 + (h)) * HTB)
#define PG8_SB(b, h) ((4 + (b) * 2 + (h)) * HTB)
#define PG8_STAGE(bufoff, gbase, voff) do { _Pragma("unroll") for (int _i = 0; _i < 2; ++_i) \
        __builtin_amdgcn_global_load_lds((const unsigned*)((const char*)(gbase) + (voff)[_i]), (LAS unsigned*)(lds + (bufoff) + ldsw + _i * 8192), 16, 0, 0); } while (0)
#define PG8_LDA(dst, b, h) do { _Pragma("unroll") for (int m = 0; m < 4; ++m) _Pragma("unroll") for (int k = 0; k < 2; ++k) dst[m][k] = *(const LAS bf16x8*)(lds + PG8_SA(b, h) + aoff + m * 2048 + k * 1024); } while (0)
#define PG8_LDB(dst, b, h) do { _Pragma("unroll") for (int n = 0; n < 2; ++n) _Pragma("unroll") for (int k = 0; k < 2; ++k) dst[n][k] = *(const LAS bf16x8*)(lds + PG8_SB(b, h) + boff + n * 2048 + k * 1024); } while (0)
#define PG8_MMA(ai, bj, At, Bt) do { __builtin_amdgcn_s_setprio(1); _Pragma("unroll") for (int m = 0; m < 4; ++m) _Pragma("unroll") for (int n = 0; n < 2; ++n) _Pragma("unroll") for (int k = 0; k < 2; ++k) \
        acc[ai][bj][m][n] = __builtin_amdgcn_mfma_f32_16x16x32_bf16(Bt[n][k], At[m][k], acc[ai][bj][m][n], 0, 0, 0); __builtin_amdgcn_s_setprio(0); } while (0)
#define PG8_WAIT_V(n) asm volatile("s_waitcnt vmcnt(" #n ")" ::: "memory")
#define PG8_WAIT_L(n) asm volatile("s_waitcnt lgkmcnt(" #n ")" ::: "memory")
#define PG8_BAR __builtin_amdgcn_s_barrier()
#define PG8_SCHED __builtin_amdgcn_sched_barrier(0)
    Unit cur, nxt; int ui = 0;
    if (!S.next(0, cur)) return;
    f32x4 acc[2][2][4][2];
#pragma unroll
    for (int a = 0; a < 2; ++a)
#pragma unroll
        for (int b = 0; b < 2; ++b)
#pragma unroll
            for (int m = 0; m < 4; ++m)
#pragma unroll
                for (int n = 0; n < 2; ++n) acc[a][b][m][n] = (f32x4){0.f, 0.f, 0.f, 0.f};
    bf16x8 At[4][2], B0[2][2], B1[2][2];
    const char* cA = (const char*)g.A + cur.aoff; const char* cB = (const char*)g.Bt + cur.boff;
    PG8_STAGE(PG8_SB(0, 0), cB, voffB); PG8_STAGE(PG8_SB(0, 1), cB + hstepB, voffB); PG8_STAGE(PG8_SA(0, 0), cA, voffA); PG8_STAGE(PG8_SA(0, 1), cA + hstepA, voffA);
    if (wr == 1) PG8_BAR;
    PG8_WAIT_V(2); PG8_BAR;
    PG8_STAGE(PG8_SB(1, 0), cB + kstep, voffB); PG8_STAGE(PG8_SA(1, 0), cA + kstep, voffA); PG8_STAGE(PG8_SB(1, 1), cB + hstepB + kstep, voffB);
    PG8_WAIT_V(6); PG8_BAR;
    for (;;) {
        const bool has_next = S.next(ui + 1, nxt);
        const char* nA = has_next ? (const char*)g.A + nxt.aoff : cA; const char* nB = has_next ? (const char*)g.Bt + nxt.boff : cB;
        for (int t = 0; t < nt; t += 2) {
            if constexpr (Epi::HAS_MID) { if (t == (nt >> 1)) { int fr_ = fr, fq_ = fq; asm volatile("" : "+v"(fr_), "+v"(fq_)); E.mid(acc, cur, wr, wc, fr_, fq_); } }
            const bool last = (t == nt - 2);
            const char* a1 = cA + (size_t)(t + 1) * kstep;
            const char* a2 = last ? nA : cA + (size_t)(t + 2) * kstep; const char* b2 = last ? nB : cB + (size_t)(t + 2) * kstep;
            const char* a3 = a2 + kstep; const char* b3 = b2 + kstep;
            PG8_LDB(B0, 0, 0); PG8_LDB(B1, 0, 1); PG8_SCHED; PG8_LDA(At, 0, 0); PG8_STAGE(PG8_SA(1, 1), a1 + hstepA, voffA);
            PG8_WAIT_V(8); PG8_WAIT_L(0); PG8_BAR; PG8_MMA(0, 0, At, B0); PG8_MMA(0, 1, At, B1); PG8_BAR; PG8_SCHED;
            PG8_LDA(At, 0, 1); PG8_STAGE(PG8_SB(0, 0), b2, voffB); PG8_STAGE(PG8_SB(0, 1), b2 + hstepB, voffB); PG8_STAGE(PG8_SA(0, 0), a2, voffA);
            PG8_WAIT_V(8); PG8_WAIT_L(0); PG8_BAR; PG8_MMA(1, 0, At, B0); PG8_MMA(1, 1, At, B1); PG8_BAR; PG8_SCHED;
            PG8_LDB(B0, 1, 0); PG8_LDB(B1, 1, 1); PG8_SCHED; PG8_LDA(At, 1, 0); PG8_STAGE(PG8_SA(0, 1), a2 + hstepA, voffA);
            PG8_WAIT_V(8); PG8_WAIT_L(0); PG8_BAR; PG8_MMA(0, 0, At, B0); PG8_MMA(0, 1, At, B1); PG8_BAR; PG8_SCHED;
            PG8_LDA(At, 1, 1); PG8_STAGE(PG8_SB(1, 0), b3, voffB); PG8_STAGE(PG8_SB(1, 1), b3 + hstepB, voffB); PG8_STAGE(PG8_SA(1, 0), a3, voffA);
            PG8_WAIT_V(8); PG8_WAIT_L(0); PG8_BAR; PG8_MMA(1, 0, At, B0); PG8_MMA(1, 1, At, B1); PG8_BAR; PG8_SCHED;
        }
        if (wr == 0) PG8_BAR;
        { int fr_ = fr, fq_ = fq; asm volatile("" : "+v"(fr_), "+v"(fq_)); E(acc, cur, wr, wc, fr_, fq_); }
        if constexpr (Epi::HAS_BETWEEN) E.between(ui, wid, lane);
        if (!has_next) break;
#pragma unroll
        for (int a = 0; a < 2; ++a)
#pragma unroll
            for (int b = 0; b < 2; ++b)
#pragma unroll
                for (int m = 0; m < 4; ++m)
#pragma unroll
                    for (int n = 0; n < 2; ++n) acc[a][b][m][n] = (f32x4){0.f, 0.f, 0.f, 0.f};
        cur = nxt; cA = nA; cB = nB; ++ui;
        if (wr == 1) PG8_BAR;
    }
    PG8_WAIT_V(0);
    PG8_BAR;
#undef PG8_SA
#undef PG8_SB
#undef PG8_STAGE
#undef PG8_LDA
#undef PG8_LDB
#undef PG8_MMA
#undef PG8_WAIT_V
#undef PG8_WAIT_L
#undef PG8_BAR
#undef PG8_SCHED
}
}

typedef f32x4 Acc[2][2][4][2];

constexpr int N_CACHE_ITEMS = 16384;
__device__ __forceinline__ void cache_load(const float* cache, const int* ptab, int r, int lane, f32x4 (&v)[16]) {
    const int tok0 = r * 16, bs = tok0 >> 11, t0 = tok0 & 2047; const int phys = ptab[bs * 16 + (t0 >> 7)];
    const float* src = cache + ((size_t)phys * 128 + (t0 & 127)) * 512 + lane * 4;
#pragma unroll
    for (int j = 0; j < 16; ++j) v[j] = *(const f32x4*)(src + (size_t)j * 512);
}
__device__ __forceinline__ void cache_store(unsigned char* ws, int r, int lane, const f32x4 (&v)[16]) {
    const int tok0 = r * 16, bs = tok0 >> 11, t0 = tok0 & 2047;
    const int kind = lane >> 5, g = (lane >> 4) & 1, d = (lane & 15) * 4;
    bf16_t* dst = (bf16_t*)(ws + WS_CMPA + (size_t)kind * CMPA_KIND_BYTES) + ((size_t)(bs * 2 + g) * 2048 + t0) * 64 + d;
#pragma unroll
    for (int j = 0; j < 16; ++j) { u32x2 w; w.x = pk2(v[j][0], v[j][1]); w.y = pk2(v[j][2], v[j][3]); *(u32x2*)(dst + j * 64) = w; }
}
__device__ __forceinline__ void cache_span(const float* cache, const int* ptab, unsigned char* ws, int lo, int hi, int step, int lane) {
    f32x4 va[16], vb[16];
    if (lo < hi) cache_load(cache, ptab, lo, lane, va);
#pragma unroll 1
    for (int it = lo; it < hi; it += 2 * step) {
        if (it + step < hi) cache_load(cache, ptab, it + step, lane, vb);
        cache_store(ws, it, lane, va);
        if (it + 2 * step < hi) cache_load(cache, ptab, it + 2 * step, lane, va);
        if (it + step < hi) cache_store(ws, it + step, lane, vb); }
}

struct EpiMain {
    static constexpr bool PERM = true, HAS_MID = false, HAS_BETWEEN = true;
    float* out; bf16_t *Qb, *CMPAp0, *CMPAp1, *KVI, *SA, *U, *CBG, *GA, *GB; const float* rope;
    const float* cache; const int* ptab; unsigned char* wsb; int c, G;
    __device__ __forceinline__ void between(int ui, int wid, int lane) const {
        if (G != 256 || ui != c % 5) return;
        const int lo = c < 215 ? c * 58 : 215 * 58 + (c - 215) * 96, n = c < 215 ? 58 : 96; const int hi = lo + n < N_CACHE_ITEMS ? lo + n : N_CACHE_ITEMS;
        cache_span(cache, ptab, wsb, lo + wid, hi, 8, lane);
        asm volatile("s_waitcnt vmcnt(0)" ::: "memory");
    }
    __device__ __forceinline__ void operator()(const Acc& acc, const pg8::Unit& u, int wr, int wc, int fr, int fq) const {
        const int pn = u.pn;
        const int lane16 = fq;
        f32x4 ncs0 = {0.f, 0.f, 0.f, 0.f}, ncs1 = ncs0, nsn0 = ncs0, nsn1 = ncs0;
#pragma unroll
        for (int ai = 0; ai < 2; ++ai)
#pragma unroll
            for (int m = 0; m < 4; ++m) {
                asm volatile("" ::: "memory");
                const int row = u.pm * 256 + ai * 128 + wr * 64 + m * 16 + fr;
                const bool rok = row < MALL;
                const bool prompt = row < MP;
                const int pos = prompt ? (row & (TS - 1)) : 2048;
                if (pn < 5) {
                    const bool isq = pn < 2;
                    const bool ropelane = ((wc & 1) == 0) && (lane16 < 2);
                    if (ai == 0 && m == 0) { if (ropelane) { const float* rp = rope + (size_t)pos * 16; ncs0 = *(const f32x4*)(rp); ncs1 = *(const f32x4*)(rp + 4); nsn0 = *(const f32x4*)(rp + 8); nsn1 = *(const f32x4*)(rp + 12); } }
                    const f32x4 cs0 = ncs0, cs1 = ncs1, sn0 = nsn0, sn1 = nsn1;
                    if (!(ai == 1 && m == 3)) { const int nrow = u.pm * 256 + (m == 3 ? 128 : ai * 128) + wr * 64 + ((m + 1) & 3) * 16 + fr; const int npos = nrow < MP ? (nrow & (TS - 1)) : 2048;
                        if (ropelane) { const float* rp = rope + (size_t)npos * 16; ncs0 = *(const f32x4*)(rp); ncs1 = *(const f32x4*)(rp + 4); nsn0 = *(const f32x4*)(rp + 8); nsn1 = *(const f32x4*)(rp + 12); } }
#pragma unroll
                    for (int bj = 0; bj < 2; ++bj) {
                        f32x4 v0 = acc[ai][bj][m][0], v1 = acc[ai][bj][m][1];
                        const bool dorope = isq || (bj == 0);
                        if (dorope) {
                            f32x4 p0, p1;
#pragma unroll
                            for (int j = 0; j < 4; ++j) { p0[j] = __shfl_xor(v0[j], 16); p1[j] = __shfl_xor(v1[j], 16); }
                            if (ropelane) {
                                if (lane16 == 0) { v0 = v0 * cs0 - p0 * sn0; v1 = v1 * cs1 - p1 * sn1; }
                                else { v0 = p0 * sn0 + v0 * cs0; v1 = p1 * sn1 + v1 * cs1; }
                            }
                        }
                        if (!rok) continue;
                        if (isq) {
                            u32x4 w; w.x = pk2(v0[0] * QSCALE, v0[1] * QSCALE); w.y = pk2(v0[2] * QSCALE, v0[3] * QSCALE); w.z = pk2(v1[0] * QSCALE, v1[1] * QSCALE); w.w = pk2(v1[2] * QSCALE, v1[3] * QSCALE);
                            *(u32x4*)(Qb + (size_t)row * 512 + pn * 256 + bj * 128 + wc * 32 + fq * 8) = w;
                        } else {
                            const int kind = 2 * (pn - 2) + bj, g = wc >> 1, dim0 = 32 * (wc & 1) + 8 * fq;
                            if (prompt) {
                                const int b = row >> 13, t = row & (TS - 1), bg = b * 2 + g;
                                if (kind < 4) { float* o = out + O_KVP + ((size_t)row * 4 + kind) * 128 + g * 64 + dim0; *(f32x4*)o = v0; *(f32x4*)(o + 4) = v1; }
                                else if (t >= TS - 512) { float* o = out + O_WINP + ((size_t)(b * 512 + t - (TS - 512)) * 2 + (kind - 4)) * 128 + g * 64 + dim0; *(f32x4*)o = v0; *(f32x4*)(o + 4) = v1; }
                                u32x4 w; w.x = pk2(v0[0], v0[1]); w.y = pk2(v0[2], v0[3]); w.z = pk2(v1[0], v1[1]); w.w = pk2(v1[2], v1[3]);
                                if (kind < 2) { bf16_t* base = kind ? CMPAp1 : CMPAp0; *(u32x4*)(base + ((size_t)bg * TS + t) * 64 + dim0) = w; }
                                else {
                                    unsigned char* img = (unsigned char*)KVI + ((size_t)((kind - 2) * 4 + bg) * 128 + (t >> 6)) * 8192; const int key = t & 63;
                                    if ((kind & 1) == 0) *(u32x4*)(img + (dim0 >> 3) * 1024 + key * 16) = w;
                                    else { const int k16 = key & 15, pp = 8 * ((k16 >> 2) & 1) + 4 * (k16 >> 3) + (k16 & 3); unsigned char* vq = img + (key >> 4) * 2048 + dim0 * 32 + pp * 2;
                                        *(bf16_t*)(vq) = (bf16_t)w.x; *(bf16_t*)(vq + 32) = (bf16_t)(w.x >> 16); *(bf16_t*)(vq + 64) = (bf16_t)w.y; *(bf16_t*)(vq + 96) = (bf16_t)(w.y >> 16);
                                        *(bf16_t*)(vq + 128) = (bf16_t)w.z; *(bf16_t*)(vq + 160) = (bf16_t)(w.z >> 16); *(bf16_t*)(vq + 192) = (bf16_t)w.w; *(bf16_t*)(vq + 224) = (bf16_t)(w.w >> 16); }
                                }
                            } else {
                                const int bs = row - MP;
                                float* o = kind < 4 ? out + O_KVS + ((size_t)bs * 4 + kind) * 128 + g * 64 + dim0 : out + O_WINS + ((size_t)(bs * 512 + 511) * 2 + (kind - 4)) * 128 + g * 64 + dim0;
                                *(f32x4*)o = v0; *(f32x4*)(o + 4) = v1;
                            }
                        }
                    }
                } else if (pn < 7) {
                    if (!rok) continue;
#pragma unroll
                    for (int bj = 0; bj < 2; ++bj) { const f32x4 v0 = acc[ai][bj][m][0], v1 = acc[ai][bj][m][1];
                        u32x4 w; w.x = pk2(silu(v0[0]), silu(v0[1])); w.y = pk2(silu(v0[2]), silu(v0[3])); w.z = pk2(silu(v1[0]), silu(v1[1])); w.w = pk2(silu(v1[2]), silu(v1[3]));
                        *(u32x4*)(SA + (size_t)row * 512 + (pn - 5) * 256 + bj * 128 + wc * 32 + fq * 8) = w; }
                } else if (pn < 15) {
                    if (!rok) continue;
                    const f32x4 cb = acc[ai][0][m][0], cg = acc[ai][0][m][1], cc = acc[ai][1][m][0], cx = acc[ai][1][m][1];
                    const int c0 = 64 * (pn - 7) + 16 * wc + 4 * fq;
                    const f32x4 uu = cc * cx; f32x4 cbg;
#pragma unroll
                    for (int j = 0; j < 4; ++j) cbg[j] = cb[j] * silu(cg[j]);
                    u32x2 wu, wc2; wu.x = pk2(uu[0], uu[1]); wu.y = pk2(uu[2], uu[3]); wc2.x = pk2(cbg[0], cbg[1]); wc2.y = pk2(cbg[2], cbg[3]);
                    *(u32x2*)(U + (size_t)row * 512 + c0) = wu; *(u32x2*)(CBG + (size_t)row * 512 + c0) = wc2;
                    if (prompt) { const int t = row & (TS - 1); if (t >= TS - 2) *(f32x4*)(out + O_CSP + ((size_t)(row >> 13) * 2 + (t - (TS - 2))) * 512 + c0) = uu; }
                    else *(f32x4*)(out + O_CSS + ((size_t)(row - MP) * 2 + 1) * 512 + c0) = uu;
                } else {
                    if (!rok) continue;
                    const int col = (pn - 15) * 128 + wc * 32 + fq * 8;
                    const f32x4 a0 = acc[ai][0][m][0], a1 = acc[ai][0][m][1], b0 = acc[ai][1][m][0], b1 = acc[ai][1][m][1];
                    float rr[8], gg[8];
#pragma unroll
                    for (int j = 0; j < 4; ++j) { const float ea0 = 1.f + __expf(-a0[j]), eb0 = 1.f + __expf(-b0[j]), ea1 = 1.f + __expf(-a1[j]), eb1 = 1.f + __expf(-b1[j]);
                        const float r0 = fast_rcp(ea0 * eb0), r1 = fast_rcp(ea1 * eb1);
                        rr[j] = eb0 * eb0 * r0; gg[j] = ea0 * r0; rr[4 + j] = eb1 * eb1 * r1; gg[4 + j] = ea1 * r1; }
                    u32x4 wr_, wg_; wr_.x = pk2(rr[0], rr[1]); wr_.y = pk2(rr[2], rr[3]); wr_.z = pk2(rr[4], rr[5]); wr_.w = pk2(rr[6], rr[7]);
                    wg_.x = pk2(gg[0], gg[1]); wg_.y = pk2(gg[2], gg[3]); wg_.z = pk2(gg[4], gg[5]); wg_.w = pk2(gg[6], gg[7]);
                    *(u32x4*)(GA + (size_t)row * 1024 + col) = wr_; *(u32x4*)(GB + (size_t)row * 1024 + col) = wg_;
                }
            }
    }
};
struct SchedMain {
    int G, c;
    __device__ __forceinline__ bool next(int i, pg8::Unit& u) const {
        int pm, pn; if (!pg8::static_tile(i, G, c, 65, 23, pm, pn)) return false;
        u.pm = pm; u.pn = pn; u.aux = 0; u.aoff = (size_t)pm * 256 * 1024 * 2; u.boff = (size_t)pn * 256 * 1024 * 2; return true; }
};

struct EpiCmp1 {
    static constexpr bool PERM = true, HAS_MID = false, HAS_BETWEEN = false;
    bf16_t* HID; const float* peb;
    __device__ __forceinline__ void operator()(const Acc& acc, const pg8::Unit& u, int wr, int wc, int fr, int fq) const {
        const int kind = u.aux; bf16_t* H = HID + (size_t)kind * (HID_KIND_BYTES / 2);
        f32x4 bv[2][2];
#pragma unroll
        for (int bj = 0; bj < 2; ++bj)
#pragma unroll
            for (int n = 0; n < 2; ++n) bv[bj][n] = *(const f32x4*)(peb + kind * 256 + bj * 128 + wc * 32 + fq * 8 + n * 4);
#pragma unroll
        for (int ai = 0; ai < 2; ++ai)
#pragma unroll
            for (int m = 0; m < 4; ++m) { const int row = u.pm * 256 + ai * 128 + wr * 64 + m * 16 + fr;
#pragma unroll
                for (int bj = 0; bj < 2; ++bj) { const f32x4 v0 = acc[ai][bj][m][0] + bv[bj][0], v1 = acc[ai][bj][m][1] + bv[bj][1];
                    u32x4 w; w.x = pk2(silu(v0[0]), silu(v0[1])); w.y = pk2(silu(v0[2]), silu(v0[3])); w.z = pk2(silu(v1[0]), silu(v1[1])); w.w = pk2(silu(v1[2]), silu(v1[3]));
                    *(u32x4*)(H + (size_t)row * 256 + bj * 128 + wc * 32 + fq * 8) = w; } }
    }
};
struct SchedCmp {
    int G, c, pm0, npm;
    __device__ __forceinline__ bool next(int i, pg8::Unit& u) const {
        const int L = i * G + c; if (c < 0 || L >= 2 * npm) return false;
        const int kind = L / npm, pm = pm0 + L % npm;
        u.pm = pm; u.pn = 0; u.aux = kind; u.aoff = (size_t)kind * CMPA_KIND_BYTES + (size_t)pm * 256 * 1024 * 2; u.boff = (size_t)kind * 256 * 2048 * 2; return true; }
};


struct EpiCmp2 {
    static constexpr bool PERM = true, HAS_MID = false, HAS_BETWEEN = false;
    unsigned char* KC;
    __device__ __forceinline__ void operator()(const Acc& acc, const pg8::Unit& u, int wr, int wc, int fr, int fq) const {
        if (wc >= 2) return;
        const int kind = u.aux, d0 = 32 * wc + 8 * fq; unsigned char* img = KC + (size_t)kind * KC_KIND_BYTES;
#pragma unroll
        for (int ai = 0; ai < 2; ++ai)
#pragma unroll
            for (int m = 0; m < 4; ++m) { const int row = u.pm * 256 + ai * 128 + wr * 64 + m * 16 + fr, tile = row >> 6, key = row & 63;
                const f32x4 v0 = acc[ai][0][m][0], v1 = acc[ai][0][m][1];
                u32x4 w; w.x = pk2(v0[0], v0[1]); w.y = pk2(v0[2], v0[3]); w.z = pk2(v1[0], v1[1]); w.w = pk2(v1[2], v1[3]);
                if (kind == 0) *(u32x4*)(img + (size_t)tile * 8192 + (d0 >> 3) * 1024 + key * 16) = w;
                else { const int k16 = key & 15, pp = 8 * ((k16 >> 2) & 1) + 4 * (k16 >> 3) + (k16 & 3); unsigned char* vq = img + (size_t)tile * 8192 + (key >> 4) * 2048 + d0 * 32 + pp * 2;
                    *(bf16_t*)(vq) = (bf16_t)w.x; *(bf16_t*)(vq + 32) = (bf16_t)(w.x >> 16); *(bf16_t*)(vq + 64) = (bf16_t)w.y; *(bf16_t*)(vq + 96) = (bf16_t)(w.y >> 16);
                    *(bf16_t*)(vq + 128) = (bf16_t)w.z; *(bf16_t*)(vq + 160) = (bf16_t)(w.z >> 16); *(bf16_t*)(vq + 192) = (bf16_t)w.w; *(bf16_t*)(vq + 224) = (bf16_t)(w.w >> 16); } }
    }
};
struct SchedCmp2 {
    int G, c, pm0, npm;
    __device__ __forceinline__ bool next(int i, pg8::Unit& u) const {
        const int L = i * G + c; if (c < 0 || L >= 2 * npm) return false;
        const int kind = L / npm, pm = pm0 + L % npm;
        u.pm = pm; u.pn = 0; u.aux = kind; u.aoff = (size_t)kind * HID_KIND_BYTES + (size_t)pm * 256 * 256 * 2; u.boff = (size_t)kind * 256 * 256 * 2; return true; }
};
struct EpiE1 {
    static constexpr bool PERM = true, HAS_MID = true, HAS_BETWEEN = false;
    const bf16_t *GR, *GB; bf16_t* OPRE;
    __device__ __forceinline__ void mid(Acc& acc, const pg8::Unit& u, int wr, int wc, int fr, int fq) const {
#pragma unroll
        for (int ai = 0; ai < 2; ++ai) {
            u32x4 gw[4][2];
#pragma unroll
            for (int m = 0; m < 4; ++m)
#pragma unroll
                for (int bj = 0; bj < 2; ++bj) { int row = u.pm * 256 + ai * 128 + wr * 64 + m * 16 + fr; row = row < MALL ? row : MALL - 1;
                    gw[m][bj] = *(const u32x4*)(GR + (size_t)row * 1024 + u.pn * 256 + bj * 128 + wc * 32 + fq * 8); }
#pragma unroll
            for (int m = 0; m < 4; ++m)
#pragma unroll
                for (int bj = 0; bj < 2; ++bj) { const u32x4 g = gw[m][bj];
                    acc[ai][bj][m][0][0] *= bflo(g.x); acc[ai][bj][m][0][1] *= bfhi(g.x); acc[ai][bj][m][0][2] *= bflo(g.y); acc[ai][bj][m][0][3] *= bfhi(g.y);
                    acc[ai][bj][m][1][0] *= bflo(g.z); acc[ai][bj][m][1][1] *= bfhi(g.z); acc[ai][bj][m][1][2] *= bflo(g.w); acc[ai][bj][m][1][3] *= bfhi(g.w); }
        }
    }
    __device__ __forceinline__ void operator()(const Acc& acc, const pg8::Unit& u, int wr, int wc, int fr, int fq) const {
#pragma unroll
        for (int ai = 0; ai < 2; ++ai) {
            u32x4 gw[4][2];
#pragma unroll
            for (int m = 0; m < 4; ++m)
#pragma unroll
                for (int bj = 0; bj < 2; ++bj) { int row = u.pm * 256 + ai * 128 + wr * 64 + m * 16 + fr; row = row < MALL ? row : MALL - 1;
                    gw[m][bj] = *(const u32x4*)(GB + (size_t)row * 1024 + u.pn * 256 + bj * 128 + wc * 32 + fq * 8); }
#pragma unroll
            for (int m = 0; m < 4; ++m) { const int row = u.pm * 256 + ai * 128 + wr * 64 + m * 16 + fr; if (row >= MALL) continue;
#pragma unroll
                for (int bj = 0; bj < 2; ++bj) { const u32x4 g = gw[m][bj]; const f32x4 v0 = acc[ai][bj][m][0], v1 = acc[ai][bj][m][1];
                    u32x4 w; w.x = pk2(v0[0] * bflo(g.x), v0[1] * bfhi(g.x)); w.y = pk2(v0[2] * bflo(g.y), v0[3] * bfhi(g.y)); w.z = pk2(v1[0] * bflo(g.z), v1[1] * bfhi(g.z)); w.w = pk2(v1[2] * bflo(g.w), v1[3] * bfhi(g.w));
                    *(u32x4*)(OPRE + (size_t)row * 1024 + u.pn * 256 + bj * 128 + wc * 32 + fq * 8) = w; } }
        }
    }
};
struct EpiE2 {
    static constexpr bool PERM = true, HAS_MID = false, HAS_BETWEEN = false;
    bf16_t* O; float* SSQP;
    __device__ __forceinline__ void operator()(const Acc& acc, const pg8::Unit& u, int wr, int wc, int fr, int fq) const {
#pragma unroll
        for (int ai = 0; ai < 2; ++ai)
#pragma unroll
            for (int m = 0; m < 4; ++m) { const int row = u.pm * 256 + ai * 128 + wr * 64 + m * 16 + fr; float s = 0.f;
#pragma unroll
                for (int bj = 0; bj < 2; ++bj) { const f32x4 v0 = acc[ai][bj][m][0], v1 = acc[ai][bj][m][1];
                    s += ((v0[0] * v0[0] + v0[1] * v0[1]) + (v0[2] * v0[2] + v0[3] * v0[3])) + ((v1[0] * v1[0] + v1[1] * v1[1]) + (v1[2] * v1[2] + v1[3] * v1[3]));
                    u32x4 w; w.x = pk2(v0[0], v0[1]); w.y = pk2(v0[2], v0[3]); w.z = pk2(v1[0], v1[1]); w.w = pk2(v1[2], v1[3]);
                    *(u32x4*)(O + (size_t)row * 1024 + u.pn * 256 + bj * 128 + wc * 32 + fq * 8) = w; }
                s += __shfl_xor(s, 16); s += __shfl_xor(s, 32);
                if (fq == 0) SSQP[(size_t)row * 16 + u.pn * 4 + wc] = s; }
    }
};
struct SchedE2 {
    int G, c;
    __device__ __forceinline__ bool next(int i, pg8::Unit& u) const {
        int pm, pn; if (!pg8::static_tile(i, G, c, 64, 4, pm, pn)) return false;
        u.pm = pm; u.pn = pn; u.aux = 0; u.aoff = (size_t)pm * 256 * 1024 * 2; u.boff = (size_t)pn * 256 * 1024 * 2; return true; }
};
struct SchedOne {
    int pm, pn;
    __device__ __forceinline__ bool next(int i, pg8::Unit& u) const {
        if (i != 0) return false;
        u.pm = pm; u.pn = pn; u.aux = 0; u.aoff = (size_t)pm * 256 * 1024 * 2; u.boff = (size_t)pn * 256 * 1024 * 2; return true; }
};
struct Frame { LAS unsigned char* lds; int tid, lane, wave, vcu, G; };

__device__ __forceinline__ float wave_sum(float v) {
#pragma unroll
    for (int o = 1; o < 64; o <<= 1) v += __shfl_xor(v, o);
    return v;
}
__device__ __forceinline__ int win_src(int v) {
    const int pn = v >> 8, w = v & 255;
    if (pn < 5) return v;
    if (pn < 7) return C_A + (v - 5 * 256);
    if (pn < 15) { const int ti = pn - 7, bj = w >> 7, wc = (w >> 5) & 3, fq = (w >> 3) & 3, e = w & 7, tsel = e >> 2, e3 = e & 3;
        const int ch = 64 * ti + 16 * wc + 4 * fq + e3, type = bj * 2 + tsel;
        return (type == 0 ? C_CB : type == 1 ? C_CG : type == 2 ? C_CC : C_CX) + ch; }
    return C_GA + ((w >> 7) ? 1024 : 0) + (pn - 15) * 128 + (w & 127);
}
template <class SrcMap>
__device__ __forceinline__ void transpose_item(const float* W, int N, bf16_t* WT, int ldt, int kcol0, LAS float* scr, int k0, int n0, int lane, const SrcMap& src) {
    const int sc = src(n0 + (lane & 31));
#pragma unroll 8
    for (int i = 0; i < 32; ++i) { const int kk = 2 * i + (lane >> 5); scr[kk * 33 + (lane & 31)] = W[(size_t)(k0 + kk) * N + sc]; }
    asm volatile("s_waitcnt lgkmcnt(0)" ::: "memory");
    const int c = lane & 7;
#pragma unroll
    for (int j = 0; j < 4; ++j) { const int n = (lane >> 3) + 8 * j; const LAS float* s = scr + (8 * c) * 33 + n;
        u32x4 o; o.x = pk2(s[0 * 33], s[1 * 33]); o.y = pk2(s[2 * 33], s[3 * 33]); o.z = pk2(s[4 * 33], s[5 * 33]); o.w = pk2(s[6 * 33], s[7 * 33]);
        *(u32x4*)(WT + (size_t)(n0 + n) * ldt + kcol0 + k0 + 8 * c) = o; }
    asm volatile("s_waitcnt lgkmcnt(0)" ::: "memory");
}
struct IdMap { __device__ __forceinline__ int operator()(int n) const { return n; } };
struct GateMap { __device__ __forceinline__ int operator()(int n) const { return C_G + n; } };
struct WinMap { __device__ __forceinline__ int operator()(int n) const { return win_src(n); } };

__device__ __forceinline__ void phase0(const Params& p, const Frame& F) {
    LAS float* scr = (LAS float*)(F.lds + F.wave * 16384);
    unsigned char* ws = p.ws; const int lane = F.lane;
    const int gw = F.vcu * NWAVES + F.wave, NGW = F.G * NWAVES;
    constexpr int I_PEB = 256, I_ROPE = 1024, I_WIN = 16 * 184, I_WBA = 8 * 32, I_WBB = 8 * 32, I_WOUT = 16 * 32, I_WC1 = 2 * 32 * 8, I_WC2 = 2 * 4 * 2, I_WC2Z = 2 * 24, I_WGT = 16,
                  I_CSC = 256;
    constexpr int TOTAL = I_PEB + I_ROPE + I_WIN + I_WBA + I_WBB + I_WOUT + I_WC1 + I_WC2 + I_WC2Z + I_WGT + I_CSC;
    float* mod = (float*)(ws + WS_MOD);
    for (int item = F.vcu; item < 48 * 5; item += F.G) {
        const int nb = item % 48, rt = item / 48, j32 = lane & 31, h = lane >> 5, kbase = F.wave * 128;
        int arow = 32 * rt + j32; arow = arow < 130 ? arow : 129;
        const float* cr = (arow < 2 ? p.cp + (size_t)arow * 1024 : p.cs + (size_t)(arow - 2) * 1024) + kbase + 4 * h;
        const float* wb = p.w_ada + (size_t)(kbase + 4 * h) * 3072 + nb * 64 + 2 * j32;
        f32x16 acc0 = {}, acc1 = {};
#pragma unroll 4
        for (int g8 = 0; g8 < 16; ++g8) {
            const f32x4 cx = *(const f32x4*)(cr + 8 * g8);
            f32x2 bw[4];
#pragma unroll
            for (int s4 = 0; s4 < 4; ++s4) bw[s4] = *(const f32x2*)(wb + (size_t)(8 * g8 + s4) * 3072);
#pragma unroll
            for (int s4 = 0; s4 < 4; ++s4) { const float x = cx[s4]; const float a = x / (1.f + __expf(-x));
                acc0 = __builtin_amdgcn_mfma_f32_32x32x2f32(a, bw[s4][0], acc0, 0, 0, 0); acc1 = __builtin_amdgcn_mfma_f32_32x32x2f32(a, bw[s4][1], acc1, 0, 0, 0); }
        }
        LAS float* red = (LAS float*)F.lds;
        __syncthreads();
#pragma unroll
        for (int r = 0; r < 16; ++r) { red[(F.wave * 32 + r) * 64 + lane] = acc0[r]; red[(F.wave * 32 + 16 + r) * 64 + lane] = acc1[r]; }
        __syncthreads();
        for (int e = F.tid; e < 32 * 64; e += NTHR) { const int v = e >> 6, l = e & 63, ecol = v >> 4, r = v & 15;
            const int row = 32 * rt + (r & 3) + 8 * (r >> 2) + 4 * (l >> 5), col = nb * 64 + 2 * (l & 31) + ecol;
            float sum = p.b_ada[col];
#pragma unroll
            for (int w = 0; w < 8; ++w) sum += red[(w * 32 + v) * 64 + l];
            if (row < 130) mod[(size_t)row * 3072 + col] = sum; }
        __syncthreads();
    }
    for (int it = gw; it < TOTAL; it += NGW) {
        int r = it;
        if (r < I_PEB) {
            const int kind = r >> 7, nb = (r >> 5) & 3, kc = r & 31, n = nb * 64 + lane; float s = 0.f;
            const float* pe = p.pe + kind * 2048 + kc * 64; const float* w = p.w1 + ((size_t)kind * 2048 + kc * 64) * 256 + n;
#pragma unroll
            for (int k = 0; k < 64; ++k) s += pe[k] * w[(size_t)k * 256];
            ((float*)(ws + WS_PEBP))[(kind * 32 + kc) * 256 + n] = s;
            continue;
        }
        r -= I_PEB;
        if (r < I_ROPE) {
            const int idx = r * 64 + lane, pos = idx >> 3, i = idx & 7;
            const float inv = (float)pow(500000.0, -(double)i / 8.0); const float ang = (float)pos * inv;
            float* rp = (float*)(ws + WS_ROPE) + (size_t)pos * 16;
            rp[i] = (float)cos((double)ang); rp[8 + i] = (float)sin((double)ang);
            continue;
        }
        r -= I_ROPE;
        if (r < I_WIN) { transpose_item(p.w_in, INW, (bf16_t*)(ws + WS_WINT), 1024, 0, scr, 64 * (r / 184), 32 * (r % 184), lane, WinMap()); continue; }
        r -= I_WIN;
        if (r < I_WBA) { transpose_item(p.wba, 1024, (bf16_t*)(ws + WS_WBR), 1024, 0, scr, 64 * (r / 32), 32 * (r % 32), lane, IdMap()); continue; }
        r -= I_WBA;
        if (r < I_WBB) { transpose_item(p.wbb, 1024, (bf16_t*)(ws + WS_WBR), 1024, 512, scr, 64 * (r / 32), 32 * (r % 32), lane, IdMap()); continue; }
        r -= I_WBB;
        if (r < I_WOUT) { transpose_item(p.wout, 1024, (bf16_t*)(ws + WS_WOUT), 1024, 0, scr, 64 * (r / 32), 32 * (r % 32), lane, IdMap()); continue; }
        r -= I_WOUT;
        if (r < I_WC1) { const int kind = r / 256, q = r % 256; transpose_item(p.w1 + (size_t)kind * 2048 * 256, 256, (bf16_t*)(ws + WS_WC1) + (size_t)kind * 256 * 2048, 2048, 0, scr, 64 * (q / 8), 32 * (q % 8), lane, IdMap()); continue; }
        r -= I_WC1;
        if (r < I_WC2) { const int kind = r / 8, q = r % 8; transpose_item(p.w2 + (size_t)kind * 256 * 64, 64, (bf16_t*)(ws + WS_WC2) + (size_t)kind * 256 * 256, 256, 0, scr, 64 * (q / 2), 32 * (q % 2), lane, IdMap()); continue; }
        r -= I_WC2;
        if (r < I_WC2Z) { const int kind = r / 24, q = r % 24;
            u32x4* z = (u32x4*)((bf16_t*)(ws + WS_WC2) + (size_t)kind * 256 * 256 + (size_t)(64 + 8 * q) * 256);
#pragma unroll
            for (int j = 0; j < 4; ++j) z[j * 64 + lane] = (u32x4){0u, 0u, 0u, 0u};
            continue; }
        r -= I_WC2Z;
        if (r < I_WGT) { transpose_item(p.w_in, INW, (bf16_t*)(ws + WS_WGT), 1024, 0, scr, 64 * r, 0, lane, GateMap()); continue; }
        r -= I_WGT;
        { const int idx = r * 256 + lane * 4, bs = idx >> 9, c = idx & 511;
          *(f32x4*)(p.out + O_CSS + ((size_t)bs * 2) * 512 + c) = *(const f32x4*)(p.sconv + ((size_t)bs * 2 + 1) * 512 + c); }
    }
}

constexpr int N_WINC = (128 * 511 + 15) / 16;
__device__ __forceinline__ void wincopy_item(const Params& p, int r, int lane) {
    f32x4 v[16];
#pragma unroll
    for (int j = 0; j < 16; ++j) { const int ridx = r * 16 + j; if (ridx < 128 * 511) { const int bs = ridx / 511, jj = ridx % 511; v[j] = *(const f32x4*)(p.swin + ((size_t)bs * 512 + jj + 1) * 256 + lane * 4); } }
#pragma unroll
    for (int j = 0; j < 16; ++j) { const int ridx = r * 16 + j; if (ridx < 128 * 511) { const int bs = ridx / 511, jj = ridx % 511; *(f32x4*)(p.out + O_WINS + ((size_t)bs * 512 + jj) * 256 + lane * 4) = v[j]; } }
}
__device__ __forceinline__ float dot2bf(unsigned w, unsigned x, float acc) { typedef __bf16 bf16x2_t __attribute__((ext_vector_type(2)));
    return __builtin_amdgcn_fdot2_f32_bf16(__builtin_bit_cast(bf16x2_t, w), __builtin_bit_cast(bf16x2_t, x), acc, false); }
__device__ __forceinline__ void phase1(const Params& p, const Frame& F) {
    unsigned char* ws = p.ws; const int lane = F.lane;
    LAS unsigned* wg = (LAS unsigned*)F.lds;
    { const u32x4* src = (const u32x4*)(ws + WS_WGT);
#pragma unroll
      for (int i = 0; i < 6; ++i) ((LAS u32x4*)wg)[i * NTHR + F.tid] = src[i * NTHR + F.tid]; }
    __syncthreads();
    const int gw = F.vcu * NWAVES + F.wave, NGW = F.G * NWAVES;
    const float* mod = (const float*)(ws + WS_MOD); bf16_t* H = (bf16_t*)(ws + WS_H); float* NG = (float*)(ws + WS_NG);
    if (gw < 8) { const int kind = gw >> 2, n = (gw & 3) * 64 + lane; float s = 0.f; const float* pp = (const float*)(ws + WS_PEBP) + kind * 32 * 256 + n;
#pragma unroll
        for (int kc = 0; kc < 32; ++kc) s += pp[kc * 256];
        ((float*)(ws + WS_PEB))[kind * 256 + n] = s; }
    f32x4 vn[2][4];
#define P1_LOADX(dst, r_) do { const int r__ = (r_); if (r__ < MALL) { const float* x = r__ < MP ? p.xp + (size_t)r__ * DM : p.xs + (size_t)(r__ - MP) * DM; \
        _Pragma("unroll") for (int j = 0; j < 4; ++j) dst[j] = *(const f32x4*)(x + (j >> 1) * 512 + lane * 8 + (j & 1) * 4); } } while (0)
#pragma unroll
    for (int j = 0; j < 4; ++j) { vn[0][j] = (f32x4){0.f, 0.f, 0.f, 0.f}; vn[1][j] = vn[0][j]; }
    P1_LOADX(vn[0], gw); P1_LOADX(vn[1], gw + NGW);
    for (int row = gw; row < MALL; row += 2 * NGW) {
        const bool ok1 = row + NGW < MALL; const int rw[2] = {row, ok1 ? row + NGW : row};
        f32x4 v[2][4]; float s[2];
#pragma unroll
        for (int u = 0; u < 2; ++u) { s[u] = 0.f;
#pragma unroll
            for (int j = 0; j < 4; ++j) { v[u][j] = vn[u][j]; s[u] += (v[u][j][0] * v[u][j][0] + v[u][j][1] * v[u][j][1]) + (v[u][j][2] * v[u][j][2] + v[u][j][3] * v[u][j][3]); } }
        P1_LOADX(vn[0], row + 2 * NGW); P1_LOADX(vn[1], row + 3 * NGW);
        s[0] = wave_sum(s[0]); s[1] = wave_sum(s[1]);
        u32x4 hp[2][2];
#pragma unroll
        for (int u = 0; u < 2; ++u) { const float rs = rsqrtf(s[u] * (1.f / DM) + 1e-6f); const int r_ = rw[u];
            const float* md = mod + (size_t)(r_ < MP ? (r_ >> 13) : 2 + (r_ - MP)) * 3072;
#pragma unroll
            for (int j = 0; j < 4; ++j) { const int k = (j >> 1) * 512 + lane * 8 + (j & 1) * 4; const f32x4 gp = *(const f32x4*)(p.g_pre + k), sh = *(const f32x4*)(md + k), sc = *(const f32x4*)(md + 1024 + k);
                const f32x4 h = v[u][j] * rs * gp * (1.f + sc) + sh;
                if (j & 1) { hp[u][j >> 1].z = pk2(h[0], h[1]); hp[u][j >> 1].w = pk2(h[2], h[3]); } else { hp[u][j >> 1].x = pk2(h[0], h[1]); hp[u][j >> 1].y = pk2(h[2], h[3]); } }
            if (u == 0 || ok1) { *(u32x4*)(H + (size_t)r_ * DM + lane * 8) = hp[u][0]; *(u32x4*)(H + (size_t)r_ * DM + 512 + lane * 8) = hp[u][1]; } }
        float d[2][24];
#pragma unroll
        for (int c = 0; c < 24; ++c) { if ((c & 3) == 0) asm volatile("" ::: "memory");
            const u32x4 w0 = *(const LAS u32x4*)(wg + c * 512 + lane * 4), w1 = *(const LAS u32x4*)(wg + c * 512 + 256 + lane * 4);
#pragma unroll
            for (int u = 0; u < 2; ++u) { float a = dot2bf(w0.x, hp[u][0].x, 0.f), b = dot2bf(w1.x, hp[u][1].x, 0.f);
                a = dot2bf(w0.y, hp[u][0].y, a); b = dot2bf(w1.y, hp[u][1].y, b); a = dot2bf(w0.z, hp[u][0].z, a); b = dot2bf(w1.z, hp[u][1].z, b); a = dot2bf(w0.w, hp[u][0].w, a); b = dot2bf(w1.w, hp[u][1].w, b);
                d[u][c] = a + b; } }
        const bool b5 = lane & 32, b4 = lane & 16, b3 = lane & 8;
        float e12[2][12], e6[2][6], e3[2][3];
#pragma unroll
        for (int i = 0; i < 12; ++i)
#pragma unroll
            for (int u = 0; u < 2; ++u) { const float snd = b5 ? d[u][i] : d[u][12 + i]; const float rcv = __shfl_xor(snd, 32); e12[u][i] = (b5 ? d[u][12 + i] : d[u][i]) + rcv; }
#pragma unroll
        for (int i = 0; i < 6; ++i)
#pragma unroll
            for (int u = 0; u < 2; ++u) { const float snd = b4 ? e12[u][i] : e12[u][6 + i]; const float rcv = __shfl_xor(snd, 16); e6[u][i] = (b4 ? e12[u][6 + i] : e12[u][i]) + rcv; }
#pragma unroll
        for (int i = 0; i < 3; ++i)
#pragma unroll
            for (int u = 0; u < 2; ++u) { const float snd = b3 ? e6[u][i] : e6[u][3 + i]; const float rcv = __shfl_xor(snd, 8); e3[u][i] = (b3 ? e6[u][3 + i] : e6[u][i]) + rcv; }
#pragma unroll
        for (int i = 0; i < 3; ++i)
#pragma unroll
            for (int u = 0; u < 2; ++u) { float x = e3[u][i]; x += __shfl_xor(x, 4); x += __shfl_xor(x, 2); x += __shfl_xor(x, 1); e3[u][i] = x; }
        { const int l7 = lane & 7;
#pragma unroll
          for (int u = 0; u < 2; ++u) if (l7 < 3 && (u == 0 || ok1)) { const float gsum = l7 == 0 ? e3[u][0] : (l7 == 1 ? e3[u][1] : e3[u][2]);
            NG[(size_t)rw[u] * 32 + (b5 ? 12 : 0) + (b4 ? 6 : 0) + (b3 ? 3 : 0) + l7] = sigm(gsum); } }
    }
#undef P1_LOADX
}

__device__ __forceinline__ void cmp2_item(unsigned char* ws, int kind, int row0, int lane) {
    const bf16_t* H = (const bf16_t*)(ws + WS_HID + (size_t)kind * HID_KIND_BYTES); const bf16_t* W = (const bf16_t*)(ws + WS_WC2) + (size_t)kind * 64 * 256;
    const int r32 = lane & 31, hi = lane >> 5;
    f32x16 acc0 = {}, acc1 = {};
#pragma unroll 4
    for (int s = 0; s < 16; ++s) {
        const bf16x8 a = *(const bf16x8*)(H + (size_t)(row0 + r32) * 256 + s * 16 + hi * 8);
        const bf16x8 b0 = *(const bf16x8*)(W + (size_t)r32 * 256 + s * 16 + hi * 8), b1 = *(const bf16x8*)(W + (size_t)(32 + r32) * 256 + s * 16 + hi * 8);
        acc0 = __builtin_amdgcn_mfma_f32_32x32x16_bf16(a, b0, acc0, 0, 0, 0); acc1 = __builtin_amdgcn_mfma_f32_32x32x16_bf16(a, b1, acc1, 0, 0, 0);
    }
    unsigned char* img = ws + WS_KC + (size_t)kind * KC_KIND_BYTES;
#pragma unroll
    for (int r = 0; r < 16; ++r) { const int row = row0 + (r & 3) + 8 * (r >> 2) + 4 * hi, tile = row >> 6, key = row & 63;
#pragma unroll
        for (int h2 = 0; h2 < 2; ++h2) { const int d = r32 + 32 * h2; const float v = h2 ? acc1[r] : acc0[r];
            size_t off;
            if (kind == 0) off = (size_t)tile * 8192 + (d >> 3) * 1024 + key * 16 + (d & 7) * 2;
            else { const int k16 = key & 15; off = (size_t)tile * 8192 + (key >> 4) * 2048 + d * 32 + (8 * ((k16 >> 2) & 1) + 4 * (k16 >> 3) + (k16 & 3)) * 2; }
            *(bf16_t*)(img + off) = (bf16_t)f2bf(v); } }
}
__device__ __forceinline__ void ybin_row(const Params& p, int row, int lane) {
    unsigned char* ws = p.ws; const bf16_t* U = (const bf16_t*)(ws + WS_U); const bf16_t* CBG = (const bf16_t*)(ws + WS_CBG); bf16_t* AOY = (bf16_t*)(ws + WS_AOY);
    const int c = lane * 8;
    float u0[8], u1[8], u2[8];
    { const u32x4 w = *(const u32x4*)(U + (size_t)row * 512 + c); u2[0] = bflo(w.x); u2[1] = bfhi(w.x); u2[2] = bflo(w.y); u2[3] = bfhi(w.y); u2[4] = bflo(w.z); u2[5] = bfhi(w.z); u2[6] = bflo(w.w); u2[7] = bfhi(w.w); }
    if (row < MP) { const int t = row & (TS - 1);
        if (t >= 1) { const u32x4 w = *(const u32x4*)(U + (size_t)(row - 1) * 512 + c); u1[0] = bflo(w.x); u1[1] = bfhi(w.x); u1[2] = bflo(w.y); u1[3] = bfhi(w.y); u1[4] = bflo(w.z); u1[5] = bfhi(w.z); u1[6] = bflo(w.w); u1[7] = bfhi(w.w); }
        else {
#pragma unroll
            for (int j = 0; j < 8; ++j) u1[j] = 0.f; }
        if (t >= 2) { const u32x4 w = *(const u32x4*)(U + (size_t)(row - 2) * 512 + c); u0[0] = bflo(w.x); u0[1] = bfhi(w.x); u0[2] = bflo(w.y); u0[3] = bfhi(w.y); u0[4] = bflo(w.z); u0[5] = bfhi(w.z); u0[6] = bflo(w.w); u0[7] = bfhi(w.w); }
        else {
#pragma unroll
            for (int j = 0; j < 8; ++j) u0[j] = 0.f; }
    } else { const int bs = row - MP; const float* s0 = p.sconv + ((size_t)bs * 2) * 512 + c; const float* s1 = s0 + 512;
#pragma unroll
        for (int j = 0; j < 8; ++j) { u0[j] = s0[j]; u1[j] = s1[j]; } }
    const u32x4 wcb = *(const u32x4*)(CBG + (size_t)row * 512 + c);
    float cb[8] = {bflo(wcb.x), bfhi(wcb.x), bflo(wcb.y), bfhi(wcb.y), bflo(wcb.z), bfhi(wcb.z), bflo(wcb.w), bfhi(wcb.w)};
    float o[8];
#pragma unroll
    for (int j = 0; j < 8; ++j) o[j] = cb[j] * (p.conv_w[c + j] * u0[j] + p.conv_w[512 + c + j] * u1[j] + p.conv_w[1024 + c + j] * u2[j]);
    u32x4 w; w.x = pk2(o[0], o[1]); w.y = pk2(o[2], o[3]); w.z = pk2(o[4], o[5]); w.w = pk2(o[6], o[7]);
    *(u32x4*)(AOY + (size_t)row * 1024 + 512 + c) = w;
}
__device__ __forceinline__ void final_row(const Params& p, float* outbase, int row, int lane) {
    unsigned char* ws = p.ws; const bf16_t* O = (const bf16_t*)(ws + WS_O) + (size_t)row * 1024; const float* sq = (const float*)(ws + WS_SSQP) + (size_t)row * 16;
    float s = 0.f;
#pragma unroll
    for (int j = 0; j < 16; ++j) s += sq[j];
    const float rs = rsqrtf(s * (1.f / DM) + 1e-6f);
    const float* x = row < MP ? p.xp + (size_t)row * DM : p.xs + (size_t)(row - MP) * DM;
    float* y = row < MP ? outbase + O_YP + (size_t)row * DM : outbase + O_YS + (size_t)(row - MP) * DM;
    const float* gate = (const float*)(ws + WS_MOD) + (size_t)(row < MP ? (row >> 13) : 2 + (row - MP)) * 3072 + 2048;
#pragma unroll
    for (int j = 0; j < 4; ++j) { const int k = j * 256 + lane * 4; const u32x2 ow = *(const u32x2*)(O + k); const f32x4 xv = *(const f32x4*)(x + k), ov = {bflo(ow.x), bfhi(ow.x), bflo(ow.y), bfhi(ow.y)}, gv = *(const f32x4*)(gate + k), gp = *(const f32x4*)(p.g_post + k);
        *(f32x4*)(y + k) = xv + gv * ov * rs * gp; }
}
namespace att {
constexpr int L_K = 0, L_V = 16384, L_GS = 32768, L_LS = 65536, L_SELM = 98304, L_WSF = 99328, L_UN = 101376, L_Q = 101632, L_END = 134400;
typedef short s16x4 __attribute__((ext_vector_type(4)));
typedef LAS const unsigned char* lptr;
__device__ __forceinline__ int crow(int r, int hi) { return (r & 3) + 8 * (r >> 2) + 4 * hi; }
__device__ __forceinline__ s16x4 vtr(lptr p) { return __builtin_bit_cast(s16x4, __builtin_amdgcn_ds_read_tr16_b64_v4i16((LAS s16x4*)p)); }
__device__ __forceinline__ float half_swap_max(float m) { auto rr = __builtin_amdgcn_permlane32_swap(__float_as_uint(m), __float_as_uint(m), false, false); return fmaxf(__uint_as_float(rr[0]), __uint_as_float(rr[1])); }
__device__ __forceinline__ float half_swap_sum(float m) { auto rr = __builtin_amdgcn_permlane32_swap(__float_as_uint(m), __float_as_uint(m), false, false); return __uint_as_float(rr[0]) + __uint_as_float(rr[1]); }
__device__ __forceinline__ unsigned cvtpk(float lo, float hi) { typedef __bf16 bf16x2_t __attribute__((ext_vector_type(2))); f32x2 v = {lo, hi}; bf16x2_t b = __builtin_convertvector(v, bf16x2_t); return __builtin_bit_cast(unsigned, b); }
__device__ __forceinline__ float quad_sum(float v) { v += __shfl_xor(v, 1); v += __shfl_xor(v, 2); return v; }

struct Tile16 { u32x4 k, v; };
__device__ __forceinline__ void qkt(f32x16& p0, f32x16& p1, lptr kslot, const LAS bf16x8* qr, int r32, int hi) {
    lptr kb = kslot + hi * 1024 + r32 * 16;
    p0 = f32x16{}; p1 = f32x16{};
#pragma unroll
    for (int d0 = 0; d0 < 4; ++d0) {
        const bf16x8 b0 = *(const LAS bf16x8*)(kb + d0 * 2048), b1 = *(const LAS bf16x8*)(kb + d0 * 2048 + 512);
        const bf16x8 qf = qr[d0 * 64]; p0 = __builtin_amdgcn_mfma_f32_32x32x16_bf16(b0, qf, p0, 0, 0, 0); p1 = __builtin_amdgcn_mfma_f32_32x32x16_bf16(b1, qf, p1, 0, 0, 0);
    }
}
__device__ __forceinline__ void pv(f32x16* o, lptr vslot, const f32x16& p0, const f32x16& p1, int lane, int hi) {
    u32x4 pw[4];
    pw[0] = (u32x4){cvtpk(p0[0], p0[1]), cvtpk(p0[2], p0[3]), cvtpk(p0[4], p0[5]), cvtpk(p0[6], p0[7])};
    pw[1] = (u32x4){cvtpk(p0[8], p0[9]), cvtpk(p0[10], p0[11]), cvtpk(p0[12], p0[13]), cvtpk(p0[14], p0[15])};
    pw[2] = (u32x4){cvtpk(p1[0], p1[1]), cvtpk(p1[2], p1[3]), cvtpk(p1[4], p1[5]), cvtpk(p1[6], p1[7])};
    pw[3] = (u32x4){cvtpk(p1[8], p1[9]), cvtpk(p1[10], p1[11]), cvtpk(p1[12], p1[13]), cvtpk(p1[14], p1[15])};
    lptr vp = vslot + ((lane >> 4) & 1) * 32 + (lane & 3) * 8 + (4 * hi + ((lane & 15) >> 2)) * 64;
#pragma unroll
    for (int d0 = 0; d0 < 2; ++d0)
#pragma unroll
        for (int ks = 0; ks < 4; ++ks) {
            const s16x4 lo = vtr(vp + d0 * 4096 + ks * 1024), hh = vtr(vp + d0 * 4096 + ks * 1024 + 512);
            const bf16x8 vf = (bf16x8){lo[0], lo[1], lo[2], lo[3], hh[0], hh[1], hh[2], hh[3]};
            o[d0] = __builtin_amdgcn_mfma_f32_32x32x16_bf16(__builtin_bit_cast(bf16x8, pw[ks]), vf, o[d0], 0, 0, 0);
        }
}
__device__ __forceinline__ void mask_range(f32x16& p0, f32x16& p1, int lo, int hi_, int hi) {
    const int lo2 = lo - 4 * hi, hi2 = hi_ - 4 * hi;
#pragma unroll
    for (int r = 0; r < 16; ++r) { const int c = (r & 3) + 8 * (r >> 2);
        p0[r] = (c >= lo2 && c <= hi2) ? p0[r] : -INFINITY; p1[r] = (c + 32 >= lo2 && c + 32 <= hi2) ? p1[r] : -INFINITY; }
}
__device__ __forceinline__ void mask_rows(f32x16& p0, f32x16& p1, float bias) {
#pragma unroll
    for (int r = 0; r < 16; ++r) { p0[r] += bias; p1[r] += bias; }
}
__device__ __forceinline__ void online_step(f32x16& p0, f32x16& p1, float& m, float& l, f32x16* o, LAS float* wsf, int r32, int hi, bool en = true) {
    float rm = p0[0];
#pragma unroll
    for (int r = 1; r < 16; ++r) rm = fmaxf(rm, p0[r]);
#pragma unroll
    for (int r = 0; r < 16; ++r) rm = fmaxf(rm, p1[r]);
    rm = half_swap_max(rm);
    rm = en ? rm : -INFINITY;
    const bool need = __any(rm - m > 8.f);
    const float mn = need ? fmaxf(m, rm) : m;
    const float alpha = need ? __builtin_amdgcn_exp2f(m - mn) : 1.f;
    const float msub = en ? mn : INFINITY;
    float s = 0.f;
#pragma unroll
    for (int r = 0; r < 16; ++r) { p0[r] = __builtin_amdgcn_exp2f(p0[r] - msub); p1[r] = __builtin_amdgcn_exp2f(p1[r] - msub); s += p0[r] + p1[r]; }
    l = l * alpha + s; m = mn;
    if (need) {
        if (hi == 0) wsf[r32] = alpha;
        asm volatile("s_waitcnt lgkmcnt(0)" ::: "memory");
#pragma unroll
        for (int r = 0; r < 16; ++r) { const float a = wsf[crow(r, hi)]; o[0][r] *= a; o[1][r] *= a; }
    }
}
template <int MODE  >
__device__ __forceinline__ void accum_lds(LAS float* ot0, LAS float* ot1, const f32x16* o, float coef, LAS float* wsf, int lane, int r32, int hi) {
    if (hi == 0) wsf[32 + r32] = coef;
    asm volatile("s_waitcnt lgkmcnt(0)" ::: "memory");
#pragma unroll
    for (int r = 0; r < 16; ++r) { const float a = wsf[32 + crow(r, hi)];
        if (MODE == 0) { ot0[r * 64 + lane] = a * o[0][r]; ot1[r * 64 + lane] = a * o[1][r]; }
        else { ot0[r * 64 + lane] += a * o[0][r]; ot1[r * 64 + lane] += a * o[1][r]; } }
}
__device__ __forceinline__ unsigned pick4(unsigned a0, unsigned a1, unsigned a2, unsigned a3, int i) { unsigned r = a0; r = (i == 1) ? a1 : r; r = (i == 2) ? a2 : r; r = (i == 3) ? a3 : r; return r; }
__device__ __forceinline__ int next_bit(unsigned u0, unsigned u1, unsigned u2, unsigned u3, int j, int jmax) {
    while (j <= jmax) { const unsigned w = pick4(u0, u1, u2, u3, j >> 5) >> (j & 31); if (w) { j += __builtin_ctz(w); return j <= jmax ? j : jmax + 1; } j = (j | 31) + 1; }
    return jmax + 1;
}

__device__ __forceinline__ void loadK(bf16x8 (&kf)[8], const unsigned char* tile, unsigned koff) {
#pragma unroll
    for (int d0 = 0; d0 < 4; ++d0) { kf[2 * d0] = *(const bf16x8*)(tile + koff + d0 * 2048); kf[2 * d0 + 1] = *(const bf16x8*)(tile + koff + d0 * 2048 + 512); }
}
__device__ __forceinline__ void loadV(bf16x8 (&vf)[8], const unsigned char* tile, unsigned voff) {
#pragma unroll
    for (int d0 = 0; d0 < 2; ++d0)
#pragma unroll
        for (int ks = 0; ks < 4; ++ks) vf[d0 * 4 + ks] = *(const bf16x8*)(tile + voff + ks * 2048 + d0 * 1024);
}
__device__ __forceinline__ void qkt_reg(f32x16& p0, f32x16& p1, const bf16x8 (&kf)[8], const LAS bf16x8* qr) {
    p0 = f32x16{}; p1 = f32x16{};
    bf16x8 qf[4];
#pragma unroll
    for (int d0 = 0; d0 < 4; ++d0) qf[d0] = qr[d0 * 64];
    __builtin_amdgcn_sched_barrier(0);
#pragma unroll
    for (int d0 = 0; d0 < 4; ++d0) {
        p0 = __builtin_amdgcn_mfma_f32_32x32x16_bf16(kf[2 * d0], qf[d0], p0, 0, 0, 0); p1 = __builtin_amdgcn_mfma_f32_32x32x16_bf16(kf[2 * d0 + 1], qf[d0], p1, 0, 0, 0); }
}
__device__ __forceinline__ void pv_reg(f32x16* o, const bf16x8 (&vf)[8], const f32x16& p0, const f32x16& p1) {
    u32x4 pw[4];
    pw[0] = (u32x4){cvtpk(p0[0], p0[1]), cvtpk(p0[2], p0[3]), cvtpk(p0[4], p0[5]), cvtpk(p0[6], p0[7])};
    pw[1] = (u32x4){cvtpk(p0[8], p0[9]), cvtpk(p0[10], p0[11]), cvtpk(p0[12], p0[13]), cvtpk(p0[14], p0[15])};
    pw[2] = (u32x4){cvtpk(p1[0], p1[1]), cvtpk(p1[2], p1[3]), cvtpk(p1[4], p1[5]), cvtpk(p1[6], p1[7])};
    pw[3] = (u32x4){cvtpk(p1[8], p1[9]), cvtpk(p1[10], p1[11]), cvtpk(p1[12], p1[13]), cvtpk(p1[14], p1[15])};
#pragma unroll
    for (int d0 = 0; d0 < 2; ++d0)
#pragma unroll
        for (int ks = 0; ks < 4; ++ks) o[d0] = __builtin_amdgcn_mfma_f32_32x32x16_bf16(__builtin_bit_cast(bf16x8, pw[ks]), vf[d0 * 4 + ks], o[d0], 0, 0, 0);
}

__device__ __forceinline__ void prompt_unit(const Params& p, const Frame& F, int b, int g, int cur, int tg) {
    unsigned char* ws = p.ws; LAS unsigned char* lds = F.lds;
    const int lane = F.lane, wid = F.wave, r32 = lane & 31, hi = lane >> 5;
    const int bg = b * 2 + g, t0 = cur * 64, tokl = 8 * tg + (r32 >> 2), head = r32 & 3, t = t0 + tokl;
    const size_t grow = (size_t)b * TS + t;
    LAS float* wsf = (LAS float*)(lds + L_WSF) + wid * 64;
    LAS float* GS = (LAS float*)(lds + L_GS); LAS float* LS = (LAS float*)(lds + L_LS);
    LAS bf16x8* qr = (LAS bf16x8*)(lds + L_Q + wid * 4096) + hi * 32 + r32;
    { const bf16_t* qp = (const bf16_t*)(ws + WS_QB) + grow * 512 + (g * 4 + head) * 64 + hi * 8;
#pragma unroll
      for (int d0 = 0; d0 < 4; ++d0) qr[d0 * 64] = *(const bf16x8*)(qp + d0 * 16); }
    const float* ngp = (const float*)(ws + WS_NG) + grow * 32 + g * 12 + head * 3;
    const float g_cmp = ngp[0], g_sel = ngp[1], g_win = ngp[2];
    f32x16 o[2]; f32x16 p0, p1;
    LAS float* ot0 = GS + wid * 1024; LAS float* ot1 = LS + wid * 1024;
    const unsigned char* kc_img = ws + WS_KC + (size_t)(512 + bg * 8) * 8192;
    const unsigned char* vc_img = ws + WS_KC + KC_KIND_BYTES + (size_t)(512 + bg * 8) * 8192;
    const unsigned char* ks_img = ws + WS_KVI + (size_t)(0 * 4 + bg) * 128 * 8192;
    const unsigned char* vs_img = ws + WS_KVI + (size_t)(1 * 4 + bg) * 128 * 8192;
    const unsigned char* kw_img = ws + WS_KVI + (size_t)(2 * 4 + bg) * 128 * 8192;
    const unsigned char* vw_img = ws + WS_KVI + (size_t)(3 * 4 + bg) * 128 * 8192;
    unsigned koff = (unsigned)(hi * 1024 + r32 * 16), voff = (unsigned)(r32 * 32 + hi * 16);
    asm volatile("" : "+v"(koff), "+v"(voff));
    bf16x8 kf[8], vf[8];
    const int cmaxl = (t >= 31) ? ((t - 31) >> 4) : -1;
    const int nct = (4 * cur + 3 + 63) >> 6;
    float m = -1e30f, l = 0.f;
    loadK(kf, kc_img, koff);
#pragma unroll 1
    for (int ct = 0; ct < nct; ++ct) {
        qkt_reg(p0, p1, kf, qr);
        loadK(kf, kc_img + (size_t)(ct + 1 < nct ? ct + 1 : ct) * 8192, koff);
        mask_range(p0, p1, 0, cmaxl - 64 * ct, hi);
        float rm = p0[0];
#pragma unroll
        for (int r = 1; r < 16; ++r) rm = fmaxf(rm, p0[r]);
#pragma unroll
        for (int r = 0; r < 16; ++r) rm = fmaxf(rm, p1[r]);
        rm = half_swap_max(rm);
        const float mn = fmaxf(m, rm); float s = 0.f;
#pragma unroll
        for (int r = 0; r < 16; ++r) s += __builtin_amdgcn_exp2f(p0[r] - mn) + __builtin_amdgcn_exp2f(p1[r] - mn);
        l = l * __builtin_amdgcn_exp2f(m - mn) + s; m = mn;
    }
    l = half_swap_sum(l);
    const float linv = 1.f / fmaxf(l, 1e-30f);
    o[0] = f32x16{}; o[1] = f32x16{};
    loadK(kf, kc_img, koff);
#pragma unroll 1
    for (int ct = 0; ct < nct; ++ct) {
        loadV(vf, vc_img + (size_t)ct * 8192, voff);
        qkt_reg(p0, p1, kf, qr);
        loadK(kf, kc_img + (size_t)(ct + 1 < nct ? ct + 1 : ct) * 8192, koff);
        mask_range(p0, p1, 0, cmaxl - 64 * ct, hi);
#pragma unroll
        for (int r = 0; r < 16; ++r) { p0[r] = __builtin_amdgcn_exp2f(p0[r] - m) * linv; p1[r] = __builtin_amdgcn_exp2f(p1[r] - m) * linv; }
#pragma unroll
        for (int q = 0; q < 4; ++q) {
            const float ga = quad_sum((p0[4 * q] + p0[4 * q + 1]) + (p0[4 * q + 2] + p0[4 * q + 3])), la = quad_sum(p0[4 * q + 3]);
            const float gb = quad_sum((p1[4 * q] + p1[4 * q + 1]) + (p1[4 * q + 2] + p1[4 * q + 3])), lb = quad_sum(p1[4 * q + 3]);
            const int j = 16 * ct + 2 * q + hi;
            if (head == 0) { const int lrow = 8 * wid + (r32 >> 2); GS[lrow * 128 + j] = ga; LS[lrow * 128 + j] = la; GS[lrow * 128 + j + 8] = gb; LS[lrow * 128 + j + 8] = lb; }
        }
        pv_reg(o, vf, p0, p1);
    }
    asm volatile("s_waitcnt lgkmcnt(0)" ::: "memory");
#pragma unroll 4
    for (int i = 0; i < 16; ++i) { const int e = (8 * wid) * 128 + i * 64 + lane, j = e & 127;
        float sc; if (j == 0 || j == cur || j == cur - 1) sc = 1e6f; else if (j <= cur) sc = GS[e] + LS[e - 1]; else sc = -1.f;
        GS[e] = sc; }
    asm volatile("s_waitcnt lgkmcnt(0)" ::: "memory");
    unsigned wm0 = 0, wm1 = 0, wm2 = 0, wm3 = 0, sm0 = 0, sm1 = 0, sm2 = 0, sm3 = 0;
#pragma unroll 1
    for (int tk = 0; tk < 8; ++tk) { const int tok = 8 * wid + tk; const LAS float* sp = GS + tok * 128;
        const unsigned va = __float_as_uint(fmaxf(sp[lane], 0.f)), vb = __float_as_uint(fmaxf(sp[lane + 64], 0.f));
        unsigned T = 0;
#pragma unroll 1
        for (int bit = 30; bit >= 0; --bit) { const unsigned cand = T | (1u << bit);
            const int cnt = __builtin_popcountll(__ballot(va >= cand)) + __builtin_popcountll(__ballot(vb >= cand));
            T = cnt >= 16 ? cand : T; }
        unsigned long long ma = __ballot(va > T), mb = __ballot(vb > T);
        unsigned long long ea = __ballot(va == T), eb = __ballot(vb == T);
        int need = 16 - (__builtin_popcountll(ma) + __builtin_popcountll(mb));
#pragma unroll 1
        while (need > 0 && ea) { ma |= ea & (0ull - ea); ea &= ea - 1; --need; }
#pragma unroll 1
        while (need > 0 && eb) { mb |= eb & (0ull - eb); eb &= eb - 1; --need; }
        const unsigned a0 = (unsigned)ma, a1 = (unsigned)(ma >> 32), b0 = (unsigned)mb, b1 = (unsigned)(mb >> 32);
        if ((r32 >> 2) == tk) { sm0 = a0; sm1 = a1; sm2 = b0; sm3 = b1; }
        wm0 |= a0; wm1 |= a1; wm2 |= b0; wm3 |= b1; }
    wm0 = __builtin_amdgcn_readfirstlane(wm0); wm1 = __builtin_amdgcn_readfirstlane(wm1); wm2 = __builtin_amdgcn_readfirstlane(wm2); wm3 = __builtin_amdgcn_readfirstlane(wm3);
    asm volatile("s_waitcnt lgkmcnt(0)" ::: "memory");
    accum_lds<0>(ot0, ot1, o, g_cmp, wsf, lane, r32, hi);
    m = -1e30f; l = 0.f; o[0] = f32x16{}; o[1] = f32x16{};
    {
        int j = next_bit(wm0, wm1, wm2, wm3, 0, cur);
        if (j <= cur) loadK(kf, ks_img + (size_t)j * 8192, koff);
#pragma unroll 1
        while (j <= cur) {
            loadV(vf, vs_img + (size_t)j * 8192, voff);
            qkt_reg(p0, p1, kf, qr);
            const int jn = next_bit(wm0, wm1, wm2, wm3, j + 1, cur);
            loadK(kf, ks_img + (size_t)(jn <= cur ? jn : j) * 8192, koff);
            const bool en = (pick4(sm0, sm1, sm2, sm3, j >> 5) >> (j & 31)) & 1u;
            if (j == cur) mask_range(p0, p1, 0, tokl, hi);
            online_step(p0, p1, m, l, o, wsf, r32, hi, en);
            pv_reg(o, vf, p0, p1);
            j = jn;
        }
    }
    l = half_swap_sum(l);
    accum_lds<1>(ot0, ot1, o, g_sel / fmaxf(l, 1e-30f), wsf, lane, r32, hi);
    m = -1e30f; l = 0.f; o[0] = f32x16{}; o[1] = f32x16{};
    {
        const int j0 = cur >= 8 ? cur - 8 : 0;
        loadK(kf, kw_img + (size_t)j0 * 8192, koff);
#pragma unroll 1
        for (int j = j0; j <= cur; ++j) {
            loadV(vf, vw_img + (size_t)j * 8192, voff);
            qkt_reg(p0, p1, kf, qr);
            loadK(kf, kw_img + (size_t)(j < cur ? j + 1 : j) * 8192, koff);
            if (j == cur - 8 || j == cur) { const int lo = (j == cur - 8) ? tokl + 1 : 0, hh = (j == cur) ? tokl : 63; mask_range(p0, p1, lo, hh, hi); }
            online_step(p0, p1, m, l, o, wsf, r32, hi);
            pv_reg(o, vf, p0, p1);
        }
    }
    l = half_swap_sum(l);
    accum_lds<1>(ot0, ot1, o, g_win / fmaxf(l, 1e-30f), wsf, lane, r32, hi);
    asm volatile("s_waitcnt lgkmcnt(0)" ::: "memory");
    { const size_t rowb = (size_t)b * TS + t0 + 8 * tg + hi;
      const bf16_t* sab = (const bf16_t*)(ws + WS_SA) + rowb * 512 + g * 256 + r32; bf16_t* aob = (bf16_t*)(ws + WS_AOY) + rowb * 1024 + g * 256 + r32;
#pragma unroll
      for (int r = 0; r < 16; ++r)
#pragma unroll
        for (int d0 = 0; d0 < 2; ++d0) { const int co = (r & 3) * 64 + d0 * 32;
            aob[(2 * (r >> 2)) * 1024 + co] = (bf16_t)f2bf((d0 ? ot1 : ot0)[r * 64 + lane] * bf2f(sab[(2 * (r >> 2)) * 512 + co])); } }
}

__device__ __forceinline__ float row16_sum(float v) {
    v += __builtin_bit_cast(float, __builtin_amdgcn_update_dpp(0, __builtin_bit_cast(int, v), 0x128, 0xF, 0xF, false));
    v += __builtin_bit_cast(float, __builtin_amdgcn_update_dpp(0, __builtin_bit_cast(int, v), 0x124, 0xF, 0xF, false));
    v += __builtin_bit_cast(float, __builtin_amdgcn_update_dpp(0, __builtin_bit_cast(int, v), 0x122, 0xF, 0xF, false));
    v += __builtin_bit_cast(float, __builtin_amdgcn_update_dpp(0, __builtin_bit_cast(int, v), 0x121, 0xF, 0xF, false));
    return v; }
template <int PART  >
__device__ __forceinline__ void sample_unit(const Params& p, const Frame& F, int bs) {
    unsigned char* ws = p.ws;
    const int lane = F.lane, g = F.wave >> 2, wid = F.wave & 3, tid = F.tid & 255;
    LAS unsigned char* lds = F.lds + g * 40960;
    LAS float* q = (LAS float*)lds; LAS float* sc = (LAS float*)(lds + 1024); LAS float* impv = (LAS float*)(lds + 1024 + 4 * 1664 * 4);
    LAS int* sel = (LAS int*)(impv + 64); LAS float* osum = (LAS float*)(sel + 16);
    const size_t row = (size_t)MP + bs;
    __syncthreads();
    q[tid] = bf2f(((const bf16_t*)(ws + WS_QB))[row * 512 + g * 256 + tid]);
    __syncthreads();
    const int bg = bs * 2 + g;
    if (PART == 0) { const int c = tid & 127, hp = tid >> 7;
      float s0 = 0.f, s1 = 0.f;
      const unsigned char* img = ws + WS_KC + (size_t)(bg * 2 + (c >> 6)) * 8192; const int key = c & 63;
      u32x4 w[8];
#pragma unroll
      for (int ch = 0; ch < 8; ++ch) w[ch] = *(const u32x4*)(img + ch * 1024 + key * 16);
#pragma unroll
      for (int ch = 0; ch < 8; ++ch) { const float kf[8] = {bflo(w[ch].x), bfhi(w[ch].x), bflo(w[ch].y), bfhi(w[ch].y), bflo(w[ch].z), bfhi(w[ch].z), bflo(w[ch].w), bfhi(w[ch].w)};
#pragma unroll
          for (int e = 0; e < 8; ++e) { s0 += q[(2 * hp) * 64 + ch * 8 + e] * kf[e]; s1 += q[(2 * hp + 1) * 64 + ch * 8 + e] * kf[e]; } }
      sc[(2 * hp) * 1664 + c] = c < 127 ? s0 : -INFINITY; sc[(2 * hp + 1) * 1664 + c] = c < 127 ? s1 : -INFINITY; }
    const int kq_s = lane >> 4, d4_s = lane & 15;
    f32x4 qh[4];
#pragma unroll
    for (int h = 0; h < 4; ++h) qh[h] = *(const LAS f32x4*)(q + h * 64 + 4 * d4_s);
    if (PART == 1) {
        const float* ks = p.swin + ((size_t)bs * 512 + 1) * 256 + g * 64 + 4 * d4_s; const float* kn = p.out + O_WINS + ((size_t)bs * 512 + 511) * 256 + g * 64 + 4 * d4_s;
#pragma unroll
        for (int hb = 0; hb < 2; ++hb) { asm volatile("" ::: "memory"); f32x4 kv[16];
#pragma unroll
            for (int it = 0; it < 16; ++it) { const int i = 128 * wid + 4 * (16 * hb + it) + kq_s; kv[it] = *(const f32x4*)(i < 511 ? ks + (size_t)i * 256 : kn); }
#pragma unroll
            for (int it = 0; it < 16; ++it) { const int i = 128 * wid + 4 * (16 * hb + it) + kq_s; float sv = 0.f;
#pragma unroll
                for (int h = 0; h < 4; ++h) { const float d = row16_sum((qh[h][0] * kv[it][0] + qh[h][1] * kv[it][1]) + (qh[h][2] * kv[it][2] + qh[h][3] * kv[it][3])); sv = (d4_s == h) ? d : sv; }
                if (d4_s < 4) sc[d4_s * 1664 + 1152 + i] = sv; } }
    }
    __syncthreads();
    auto softmax_head = [&](int off, int n) {
        { LAS float* sp = sc + wid * 1664 + off; float mx = -INFINITY;
            for (int i = lane; i < n; i += 64) mx = fmaxf(mx, sp[i]);
#pragma unroll
            for (int o2 = 1; o2 < 64; o2 <<= 1) mx = fmaxf(mx, __shfl_xor(mx, o2));
            float sm = 0.f;
            for (int i = lane; i < n; i += 64) { const float e = __builtin_amdgcn_exp2f(sp[i] - mx); sp[i] = e; sm += e; }
            sm = wave_sum(sm); const float inv = 1.f / fmaxf(sm, 1e-30f);
            for (int i = lane; i < n; i += 64) sp[i] *= inv; }
        __syncthreads();
    };
    if (PART == 1) softmax_head(1152, 512);
    if (PART == 0) {
    softmax_head(0, 128);
    if (tid < 64) { float s = -1.f; const int j = tid;
        if (j < 33) { s = 0.f; for (int c = 4 * j - 1; c <= 4 * j + 3; ++c) if (c >= 0 && c < 127) s += (sc[c] + sc[1664 + c]) + (sc[2 * 1664 + c] + sc[3 * 1664 + c]);
            if (j == 0 || j == 31 || j == 32) s = 1e6f; }
        impv[j] = j < 33 ? s : -2.f; }
    __syncthreads();
    if (tid < 64) { const float sj = impv[tid]; int rk = 0; for (int i = 0; i < 33; ++i) { const float v = impv[i]; rk += (v > sj || (v == sj && i < tid)) ? 1 : 0; }
        if (tid < 33 && rk < 16) sel[rk] = tid; }
    __syncthreads();
#pragma unroll 1
    for (int rr = 0; rr < 4; ++rr) { const int r = 4 * wid + rr, j = sel[r];
        const float* kb = j < 32 ? p.cache + (((size_t)p.ptab[bs * 16 + (j >> 1)] * 128 + (j & 1) * 64) * 4 + 2) * 128 + g * 64 + 4 * d4_s : p.out + O_KVS + ((size_t)bs * 4 + 2) * 128 + g * 64 + 4 * d4_s;
        f32x4 kv[16];
#pragma unroll
        for (int it = 0; it < 16; ++it) kv[it] = *(const f32x4*)(kb + (j < 32 ? (size_t)(4 * it + kq_s) * 512 : 0));
#pragma unroll
        for (int it = 0; it < 16; ++it) { const int i = 4 * it + kq_s; float sv = 0.f;
#pragma unroll
            for (int h = 0; h < 4; ++h) { const float d = row16_sum((qh[h][0] * kv[it][0] + qh[h][1] * kv[it][1]) + (qh[h][2] * kv[it][2] + qh[h][3] * kv[it][3])); sv = (d4_s == h) ? d : sv; }
            if (d4_s < 4) sc[d4_s * 1664 + 128 + r * 64 + i] = (j < 32 || i == 0) ? sv : -INFINITY; } }
    __syncthreads();
    softmax_head(128, 1024);
    }
    const float* ngp = (const float*)(ws + WS_NG) + row * 32 + g * 12;
    const int kq = lane >> 4, d4 = lane & 15;
    f32x4 tot[4]; f32x4 br[4];
#pragma unroll
    for (int h = 0; h < 4; ++h) { tot[h] = (f32x4){0.f, 0.f, 0.f, 0.f}; br[h] = tot[h]; }
    if (PART == 0) {
#pragma unroll
    for (int it = 0; it < 8; ++it) { const int c = 32 * wid + 4 * it + kq; const unsigned char* img = ws + WS_KC + KC_KIND_BYTES + (size_t)(bg * 2 + (c >> 6)) * 8192; const int key = c & 63, d = 4 * d4;
        const int k16 = key & 15, pp = 8 * ((k16 >> 2) & 1) + 4 * (k16 >> 3) + (k16 & 3); const unsigned char* vp_ = img + (key >> 4) * 2048 + d * 32 + pp * 2;
        const f32x4 v = {bf2f(*(const bf16_t*)vp_), bf2f(*(const bf16_t*)(vp_ + 32)), bf2f(*(const bf16_t*)(vp_ + 64)), bf2f(*(const bf16_t*)(vp_ + 96))};
#pragma unroll
        for (int h = 0; h < 4; ++h) br[h] += sc[h * 1664 + c] * v; }
#pragma unroll
    for (int h = 0; h < 4; ++h) { tot[h] += ngp[h * 3] * br[h]; br[h] = (f32x4){0.f, 0.f, 0.f, 0.f}; }
    { const float* vbs[4]; int jj[4];
#pragma unroll
      for (int rr = 0; rr < 4; ++rr) { const int r = 4 * wid + rr; jj[rr] = sel[r]; const int jc = jj[rr] < 32 ? jj[rr] : 0;
          vbs[rr] = p.cache + (((size_t)p.ptab[bs * 16 + (jc >> 1)] * 128 + (jc & 1) * 64) * 4 + 3) * 128 + g * 64 + 4 * d4; }
#pragma unroll
      for (int rr = 0; rr < 4; ++rr) { const int r = 4 * wid + rr;
          asm volatile("" ::: "memory");
          if (jj[rr] < 32) {
              f32x4 v[16];
#pragma unroll
              for (int it = 0; it < 16; ++it) v[it] = *(const f32x4*)(vbs[rr] + (size_t)(4 * it + kq) * 512);
#pragma unroll
              for (int it = 0; it < 16; ++it) { const int i = 4 * it + kq;
#pragma unroll
                  for (int h = 0; h < 4; ++h) br[h] += sc[h * 1664 + 128 + r * 64 + i] * v[it]; } }
          else if (kq == 0) { const f32x4 v = *(const f32x4*)(p.out + O_KVS + ((size_t)bs * 4 + 3) * 128 + g * 64 + 4 * d4);
#pragma unroll
              for (int h = 0; h < 4; ++h) br[h] += sc[h * 1664 + 128 + r * 64] * v; } } }
#pragma unroll
    for (int h = 0; h < 4; ++h) { tot[h] += ngp[h * 3 + 1] * br[h]; br[h] = (f32x4){0.f, 0.f, 0.f, 0.f}; }
    }
    if (PART == 1) { const float* vbs = p.swin + ((size_t)bs * 512 + 1) * 256 + 128 + g * 64 + 4 * d4; const float* vbn = p.out + O_WINS + ((size_t)bs * 512 + 511) * 256 + 128 + g * 64 + 4 * d4;
#pragma unroll
      for (int hb = 0; hb < 2; ++hb) { asm volatile("" ::: "memory"); f32x4 v[16];
#pragma unroll
          for (int it = 0; it < 16; ++it) { const int i = 128 * wid + 4 * (16 * hb + it) + kq; v[it] = *(const f32x4*)(i < 511 ? vbs + (size_t)i * 256 : vbn); }
#pragma unroll
          for (int it = 0; it < 16; ++it) { const int i = 4 * (16 * hb + it) + kq;
#pragma unroll
              for (int h = 0; h < 4; ++h) br[h] += sc[h * 1664 + 1152 + 128 * wid + i] * v[it]; } } }
#pragma unroll
    for (int h = 0; h < 4; ++h) { tot[h] += ngp[h * 3 + 2] * br[h];
#pragma unroll
        for (int e = 0; e < 4; ++e) { float x = tot[h][e]; x += __shfl_xor(x, 16); x += __shfl_xor(x, 32); tot[h][e] = x; } }
    if (kq == 0) {
#pragma unroll
        for (int h = 0; h < 4; ++h) *(LAS f32x4*)(osum + (wid * 4 + h) * 64 + 4 * d4) = tot[h]; }
    __syncthreads();
    { const int h = tid >> 6, d = tid & 63; float s = 0.f;
#pragma unroll
        for (int w = 0; w < 4; ++w) s += osum[(w * 4 + h) * 64 + d];
        const int col = (g * 4 + h) * 64 + d;
        ((float*)(ws + WS_SPART))[((size_t)PART * 128 + bs) * 512 + col] = s; }
}
}
#define XB_TMO      128
#define XB_XCNT(j)  (256  + 64 * (j))
#define XB_XSUB(j)  (1280 + 64 * (j))
#define XB_XGEN(j)  (2304 + 64 * (j))
#define XB_TOP      3328
#define XB_TOPGEN   3392
#define XCD_BAR_WORDS 3456
#define XB_SPIN_CAP (1u << 22)
__device__ __forceinline__ unsigned xb_ld(unsigned* p)              { return __hip_atomic_load(p, __ATOMIC_RELAXED, __HIP_MEMORY_SCOPE_AGENT); }
__device__ __forceinline__ unsigned xb_add(unsigned* p, unsigned v) { return __hip_atomic_fetch_add(p, v, __ATOMIC_RELAXED, __HIP_MEMORY_SCOPE_AGENT); }
__device__ __forceinline__ unsigned xb_xcc_id() { return (unsigned)__builtin_amdgcn_s_getreg((3 << 11) | 20) & 0xFu; }
#define XB_SPIN(cond, bar) do { unsigned _sp = 0; while (cond) { __builtin_amdgcn_s_sleep(1); \
    if ((++_sp & 255u) == 0u) { if (xb_ld(&(bar)[XB_TMO])) break; if (_sp > XB_SPIN_CAP) { atomicAdd(&(bar)[XB_TMO], 1u); break; } } } } while (0)
struct XcdBarrier { unsigned* bar; unsigned x; volatile LAS unsigned* st; };
__device__ __forceinline__ XcdBarrier xcd_barrier_post(unsigned* bar, volatile LAS unsigned* st) {
    XcdBarrier b; b.bar = bar; b.x = xb_xcc_id(); b.st = st;
    if (threadIdx.x == 0) (void)xb_add(&bar[XB_XCNT(b.x)], 1u);
    return b;
}
__device__ __forceinline__ void xcd_barrier_complete(unsigned* bar, unsigned x, unsigned& nloc, unsigned& nx) {
    const unsigned G = gridDim.x * gridDim.y * gridDim.z;
    unsigned sum, cnt, mine, sp = 0u;
    for (;;) {
        sum = 0u; cnt = 0u; mine = 0u;
#pragma unroll
        for (unsigned j = 0; j < 16; ++j) { const unsigned c = xb_ld(&bar[XB_XCNT(j)]); sum += c; cnt += (c > 0u) ? 1u : 0u; mine = (j == x) ? c : mine; }
        if (sum == G) break;
        __builtin_amdgcn_s_sleep(1);
        if ((++sp & 255u) == 0u) { if (xb_ld(&bar[XB_TMO])) break; if (sp > XB_SPIN_CAP) { atomicAdd(&bar[XB_TMO], 1u); break; } }
    }
    nloc = mine > 0u ? mine : 1u; nx = cnt > 0u ? cnt : 1u;
}
__device__ __forceinline__ void xcd_barrier(const XcdBarrier& b) {
    asm volatile("s_waitcnt vmcnt(0)" ::: "memory");
    __syncthreads();
    if (threadIdx.x == 0) {
        unsigned* bar = b.bar;
        __builtin_amdgcn_s_waitcnt(0);
        unsigned nloc = b.st[0], nx = b.st[1];
        if (nloc == 0u) { xcd_barrier_complete(bar, b.x, nloc, nx); b.st[0] = nloc; b.st[1] = nx; }
        const unsigned old = xb_add(&bar[XB_XSUB(b.x)], 1u);
        const unsigned gen = old / nloc;
        if (old + 1u == (gen + 1u) * nloc) {
            __builtin_amdgcn_fence(__ATOMIC_RELEASE, "agent");
            asm volatile("s_waitcnt vmcnt(0)" ::: "memory");
            const unsigned og = xb_add(&bar[XB_TOP], 1u);
            const unsigned tg = og / nx;
            if (og + 1u == (tg + 1u) * nx) xb_add(&bar[XB_TOPGEN], 1u);
            else XB_SPIN(xb_ld(&bar[XB_TOPGEN]) == tg, bar);
            __builtin_amdgcn_fence(__ATOMIC_ACQUIRE, "agent");
            xb_add(&bar[XB_XGEN(b.x)], 1u);
            asm volatile("s_waitcnt vmcnt(0)" ::: "memory");
        } else {
            XB_SPIN(xb_ld(&bar[XB_XGEN(b.x)]) == gen, bar);
            __builtin_amdgcn_fence(__ATOMIC_ACQUIRE, "agent");
            asm volatile("s_waitcnt vmcnt(0)" ::: "memory");
        }
    }
    __syncthreads();
}
constexpr int LDS_MISC_OFF = 147200;

constexpr int LDS_BYTES = 147456;
constexpr int NPHASE = 8;

__global__ void __launch_bounds__(NTHR, 2) mk_fwd(Params p) {
    extern __shared__ __attribute__((aligned(16))) unsigned char lds_raw[];
    Frame F; F.lds = (LAS unsigned char*)lds_raw; F.tid = threadIdx.x; F.lane = F.tid & 63; F.wave = __builtin_amdgcn_readfirstlane(F.tid >> 6);
    F.G = gridDim.x; { const int bx = blockIdx.x; F.vcu = (F.G % 8 == 0) ? (bx % 8) * (F.G / 8) + bx / 8 : bx; }
    unsigned char* ws = p.ws;
    const int lo = p.ph_lo, hi = p.ph_hi;
    volatile LAS unsigned* misc = (volatile LAS unsigned*)(F.lds + LDS_MISC_OFF);
    if (F.tid < 2) misc[F.tid] = 0u;
    __syncthreads();
    XcdBarrier xbar; xbar.bar = (unsigned*)(ws + WS_CTL) + 4096; xbar.x = 0; xbar.st = misc;
    if (hi - lo > 1) xbar = xcd_barrier_post((unsigned*)(ws + WS_CTL) + 4096, misc);
#ifndef MK_PHASE_MASK
#define MK_PHASE_MASK 0xff
#endif
#define IN(k) (((MK_PHASE_MASK >> (k)) & 1) && lo <= (k) && (k) < hi)
#if defined(MK_TIMING)
    unsigned* tsw = (unsigned*)(ws + WS_CTL + (2u << 20));
#define TDONE(k) do { if (IN(k) && F.tid == 0) atomicMax(&tsw[16 + (k)], (unsigned)__builtin_amdgcn_s_memrealtime()); } while (0)
#define TSTART(k) do { if (blockIdx.x == 0 && F.tid == 0) tsw[(k)] = (unsigned)__builtin_amdgcn_s_memrealtime(); } while (0)
#else
#define TDONE(k) do { } while (0)
#define TSTART(k) do { } while (0)
#endif
#define SEAM(k) do { TDONE(k); if (IN(k) && IN((k) + 1)) { MK_GRID_SYNC(); } TSTART((k) + 1); } while (0)
#ifndef MK_GRID_SYNC
#define MK_GRID_SYNC() xcd_barrier(xbar)
#endif
#define PUBLISH(cp) do { asm volatile("s_waitcnt vmcnt(0)" ::: "memory"); __syncthreads(); \
        if (F.tid == 0) { __builtin_amdgcn_fence(__ATOMIC_RELEASE, "agent"); asm volatile("s_waitcnt vmcnt(0)" ::: "memory"); __hip_atomic_fetch_add((cp), 1u, __ATOMIC_RELAXED, __HIP_MEMORY_SCOPE_AGENT); } } while (0)
#define AWAIT(cp, n) do { if (F.tid == 0) { unsigned sp_ = 0; while (__hip_atomic_load((cp), __ATOMIC_RELAXED, __HIP_MEMORY_SCOPE_AGENT) < (unsigned)(n)) { __builtin_amdgcn_s_sleep(2); if (++sp_ > (1u << 22)) break; } \
            __builtin_amdgcn_fence(__ATOMIC_ACQUIRE, "agent"); asm volatile("s_waitcnt vmcnt(0)" ::: "memory"); } __syncthreads(); } while (0)
    unsigned* p34 = (unsigned*)(ws + WS_CTL + 57344);
    TSTART(0);
    if (IN(0)) { phase0(p, F); } SEAM(0);
    if (IN(1)) { phase1(p, F); } SEAM(1);
    if (IN(2)) {
        if (F.G != 256) { cache_span(p.cache, p.ptab, ws, (int)blockIdx.x * NWAVES + F.wave, N_CACHE_ITEMS, F.G * NWAVES, F.lane); asm volatile("s_waitcnt vmcnt(0)" ::: "memory"); __syncthreads(); }
        { pg8::Gemm g{(const bf16_t*)(ws + WS_H), (const bf16_t*)(ws + WS_WINT), 1024, 1024, 1024}; SchedMain S{F.G, (int)blockIdx.x};
          EpiMain E{p.out, (bf16_t*)(ws + WS_QB), (bf16_t*)(ws + WS_CMPA) + (size_t)32768 * 1024, (bf16_t*)(ws + WS_CMPA + CMPA_KIND_BYTES) + (size_t)32768 * 1024, (bf16_t*)(ws + WS_KVI),
                    (bf16_t*)(ws + WS_SA), (bf16_t*)(ws + WS_U), (bf16_t*)(ws + WS_CBG), (bf16_t*)(ws + WS_GA), (bf16_t*)(ws + WS_GB), (const float*)(ws + WS_ROPE), p.cache, p.ptab, ws, (int)blockIdx.x, F.G};
          pg8::gemm_phase(F.lds, g, S, E); }
#if defined(MK_SPLIT2)
    }
    if (lo <= 8 && 8 < hi) {
#else
        if (hi - lo > 1) MK_GRID_SYNC();
#endif
        { pg8::Gemm g{(const bf16_t*)(ws + WS_CMPA), (const bf16_t*)(ws + WS_WC1), 1024, 2048, 2048}; SchedCmp S{F.G, (int)blockIdx.x, 0, 128};
          EpiCmp1 E{(bf16_t*)(ws + WS_HID), (const float*)(ws + WS_PEB)};
          pg8::gemm_phase(F.lds, g, S, E);
          asm volatile("s_waitcnt vmcnt(0)" ::: "memory"); __syncthreads();
          { pg8::Gemm g2{(const bf16_t*)(ws + WS_HID), (const bf16_t*)(ws + WS_WC2), 256, 256, 256}; SchedCmp2 S2{F.G, (int)blockIdx.x, 0, 128};
            EpiCmp2 E2{ws + WS_KC}; pg8::gemm_phase(F.lds, g2, S2, E2); } }
        PUBLISH(p34 + 128);
    }
    TDONE(2); TSTART(3);
    if (IN(3)) {
        const int c = (int)blockIdx.x;
        if (c < 16) {
            pg8::Gemm g{(const bf16_t*)(ws + WS_CMPA), (const bf16_t*)(ws + WS_WC1), 1024, 2048, 2048}; SchedCmp S{F.G, c, 128, 8};
            EpiCmp1 E{(bf16_t*)(ws + WS_HID), (const float*)(ws + WS_PEB)};
            pg8::gemm_phase(F.lds, g, S, E);
            asm volatile("s_waitcnt vmcnt(0)" ::: "memory"); __syncthreads();
            { pg8::Gemm g2{(const bf16_t*)(ws + WS_HID), (const bf16_t*)(ws + WS_WC2), 256, 256, 256}; SchedCmp2 S2{F.G, c, 128, 8};
              EpiCmp2 E2{ws + WS_KC}; pg8::gemm_phase(F.lds, g2, S2, E2); }
            PUBLISH(p34);
        } else {
            const int gw = (c - 16) * NWAVES + F.wave, NGW = (F.G - 16) * NWAVES;
            for (int it = gw; it < MALL; it += NGW) ybin_row(p, it, F.lane);
            if (c < 144) { AWAIT(p34 + 128, F.G); for (int u = c - 16; u < 128; u += 128) att::sample_unit<0>(p, F, u); PUBLISH(p34 + 64); }
            else { for (int u = c - 144; u < 128; u += F.G - 144) att::sample_unit<1>(p, F, u);
                PUBLISH(p34 + 64);
                for (int it = (c - 144) * NWAVES + F.wave; it < N_WINC; it += (F.G - 144) * NWAVES) wincopy_item(p, it, F.lane); }
        }
    }
    TDONE(3); TSTART(4);
    if (IN(4)) {
        AWAIT(p34, 16);
        if ((F.vcu % (F.G >> 2)) == 0 && F.G >= 4 && F.vcu / (F.G >> 2) < 4) {
            AWAIT(p34 + 64, F.G - 16);
            const int pn = F.vcu / (F.G >> 2); unsigned* gcnt = (unsigned*)(ws + WS_CTL + 49152);
            for (int gi = F.tid; gi < 128 * 512; gi += NTHR) { const float* sp = (const float*)(ws + WS_SPART); const size_t row = (size_t)MP + (gi >> 9); const int col = gi & 511;
                ((bf16_t*)(ws + WS_AOY))[row * 1024 + col] = (bf16_t)f2bf((sp[gi] + sp[128 * 512 + gi]) * bf2f(((const bf16_t*)(ws + WS_SA))[row * 512 + col])); }
            asm volatile("s_waitcnt vmcnt(0)" ::: "memory"); __syncthreads();
#define GROUP4_SYNC(k) do { asm volatile("s_waitcnt vmcnt(0)" ::: "memory"); __syncthreads(); \
            if (F.tid == 0) { __builtin_amdgcn_fence(__ATOMIC_RELEASE, "agent"); asm volatile("s_waitcnt vmcnt(0)" ::: "memory"); \
                __hip_atomic_fetch_add(gcnt + 64 * (k), 1u, __ATOMIC_RELAXED, __HIP_MEMORY_SCOPE_AGENT); unsigned sp_ = 0; \
                while (__hip_atomic_load(gcnt + 64 * (k), __ATOMIC_RELAXED, __HIP_MEMORY_SCOPE_AGENT) < 4u) { __builtin_amdgcn_s_sleep(2); if (++sp_ > (1u << 22)) break; } \
                __builtin_amdgcn_fence(__ATOMIC_ACQUIRE, "agent"); asm volatile("s_waitcnt vmcnt(0)" ::: "memory"); } \
            __syncthreads(); } while (0)
            { pg8::Gemm g{(const bf16_t*)(ws + WS_AOY), (const bf16_t*)(ws + WS_WBR), 1024, 1024, 1024}; SchedOne S{64, pn};
              EpiE1 E{(const bf16_t*)(ws + WS_GA), (const bf16_t*)(ws + WS_GB), (bf16_t*)(ws + WS_OPRE)}; pg8::gemm_phase(F.lds, g, S, E); }
            GROUP4_SYNC(0);
            { pg8::Gemm g{(const bf16_t*)(ws + WS_OPRE), (const bf16_t*)(ws + WS_WOUT), 1024, 1024, 1024}; SchedOne S{64, pn};
              EpiE2 E{(bf16_t*)(ws + WS_O), (float*)(ws + WS_SSQP)}; pg8::gemm_phase(F.lds, g, S, E); }
            GROUP4_SYNC(1);
            for (int r = F.wave; r < 32; r += NWAVES) final_row(p, p.out, MP + 32 * pn + r, F.lane);
#undef GROUP4_SYNC
        }
        { const int bgi = (F.vcu * 4) / F.G; unsigned* ctr = (unsigned*)(ws + WS_CTL + 32768) + 64 * bgi;
#pragma unroll 1
          for (;;) { unsigned k = 0; if (F.lane == 0) k = __hip_atomic_fetch_add(ctr, 1u, __ATOMIC_RELAXED, __HIP_MEMORY_SCOPE_AGENT);
              k = (unsigned)__builtin_amdgcn_readfirstlane((int)k); if (k >= 1024u) break;
              att::prompt_unit(p, F, bgi >> 1, bgi & 1, 127 - (int)(k >> 3), (int)(k & 7)); } }
    }
    SEAM(4);
    if (IN(5)) { pg8::Gemm g{(const bf16_t*)(ws + WS_AOY), (const bf16_t*)(ws + WS_WBR), 1024, 1024, 1024}; SchedE2 S{F.G, (int)blockIdx.x};
        EpiE1 E{(const bf16_t*)(ws + WS_GA), (const bf16_t*)(ws + WS_GB), (bf16_t*)(ws + WS_OPRE)};
        pg8::gemm_phase(F.lds, g, S, E); }
    SEAM(5);
    if (IN(6)) { pg8::Gemm g{(const bf16_t*)(ws + WS_OPRE), (const bf16_t*)(ws + WS_WOUT), 1024, 1024, 1024}; SchedE2 S{F.G, (int)blockIdx.x};
        EpiE2 E{(bf16_t*)(ws + WS_O), (float*)(ws + WS_SSQP)};
        pg8::gemm_phase(F.lds, g, S, E); }
    SEAM(6);
    if (IN(7)) { const int gw = F.vcu * NWAVES + F.wave, NGW = F.G * NWAVES;
        for (int row = gw; row < MP; row += NGW) final_row(p, p.out, row, F.lane); }
    TDONE(7);
#undef IN
#undef SEAM
}
}

static mk::Params make_params(void* const* d_in, float* out, unsigned char* ws) {
    mk::Params p{};
    p.xp = (const float*)d_in[0]; p.xs = (const float*)d_in[1]; p.cache = (const float*)d_in[2]; p.swin = (const float*)d_in[3]; p.sconv = (const float*)d_in[4]; p.ptab = (const int*)d_in[5];
    p.cp = (const float*)d_in[6]; p.cs = (const float*)d_in[7]; p.w_ada = (const float*)d_in[8]; p.b_ada = (const float*)d_in[9]; p.g_pre = (const float*)d_in[10]; p.g_post = (const float*)d_in[11];
    p.w_in = (const float*)d_in[12]; p.pe = (const float*)d_in[13]; p.w1 = (const float*)d_in[14]; p.w2 = (const float*)d_in[15]; p.conv_w = (const float*)d_in[16];
    p.wba = (const float*)d_in[17]; p.wbb = (const float*)d_in[18]; p.wout = (const float*)d_in[19];
    p.out = out; p.ws = ws; p.ph_lo = 0; p.ph_hi = mk::NPHASE;
    return p;
}
static int mk_grid() {
    static int grid = 0;
    if (grid == 0) {
        int dev = 0, cus = 0, per_cu = 0;
        (void)hipGetDevice(&dev); (void)hipDeviceGetAttribute(&cus, hipDeviceAttributeMultiprocessorCount, dev);
        (void)hipFuncSetAttribute((const void*)mk::mk_fwd, hipFuncAttributeMaxDynamicSharedMemorySize, mk::LDS_BYTES);
        (void)hipOccupancyMaxActiveBlocksPerMultiprocessor(&per_cu, (const void*)mk::mk_fwd, mk::NTHR, mk::LDS_BYTES);
        if (per_cu < 1) { fprintf(stderr, "mk: occupancy query says %d blocks per CU\n", per_cu); per_cu = 1; }
        grid = cus;
        (void)hipGetLastError();
    }
    return grid;
}
static void mk_launch(mk::Params p, int lo, int hi, hipStream_t stream) {
    p.ph_lo = lo; p.ph_hi = hi; const int grid = mk_grid();
    if (hi - lo > 1) { void* args[] = {&p}; hipError_t e = hipLaunchCooperativeKernel((const void*)mk::mk_fwd, dim3(grid), dim3(mk::NTHR), args, mk::LDS_BYTES, stream);
        if (e != hipSuccess) fprintf(stderr, "cooperative launch failed: %s (grid %d)\n", hipGetErrorString(e), grid); }
    else hipLaunchKernelGGL(mk::mk_fwd, dim3(grid), dim3(mk::NTHR), mk::LDS_BYTES, stream, p);
}
extern "C" void kernel_launch(void* const* d_in, const int* in_sizes, int n_in, void* d_out, int out_size, void* d_ws, size_t ws_size, hipStream_t stream) {
    (void)in_sizes; (void)n_in; (void)out_size; (void)ws_size;
    (void)hipMemsetAsync((unsigned char*)d_ws + mk::WS_CTL, 0, 65536, stream);
    mk::Params p = make_params(d_in, (float*)d_out, (unsigned char*)d_ws);
#if defined(MK_MULTI_LAUNCH)
    for (int ph = 0; ph < mk::NPHASE; ++ph) mk_launch(p, ph, ph + 1, stream);
#else
    mk_launch(p, 0, mk::NPHASE, stream);
#endif
}
```

```cpp
#include <hip/hip_runtime.h>
#include <hip/hip_cooperative_groups.h>
#include <cstdio>
#include <cstdint>
#include <cmath>
namespace cg = cooperative_groups;
#define LAS __attribute__((address_space(3)))
typedef unsigned short bf16_t;
typedef short bf16x8 __attribute__((ext_vector_type(8)));
typedef float f32x4 __attribute__((ext_vector_type(4)));
typedef float f32x2 __attribute__((ext_vector_type(2)));
typedef float f32x16 __attribute__((ext_vector_type(16)));
typedef unsigned u32x4 __attribute__((ext_vector_type(4)));
typedef unsigned u32x2 __attribute__((ext_vector_type(2)));

namespace mk {
constexpr int DM = 1024, TS = 8192, MP = 16384, SB = 128, MALL = 16512, MPAD = 16640, INW = 5912, NV = 5888;
constexpr int C_G = 1280, C_A = 1304, C_CB = 1816, C_CC = 2328, C_CX = 2840, C_CG = 3352, C_GA = 3864;
constexpr size_t O_YP = 0, O_YS = 16777216, O_KVP = 16908288, O_WINP = 25296896, O_CSP = 25559040, O_KVS = 25561088, O_WINS = 25626624, O_CSS = 42403840, O_END = 42534912;
constexpr float QSCALE = 0.125f * 1.4426950408889634f;
constexpr int NWAVES = 8, NTHR = 512;

constexpr size_t MiB = 1u << 20;
constexpr size_t WS_CTL = 0;
constexpr size_t CTL_BYTES = 4 * MiB;
constexpr size_t WS_MOD = 4 * MiB;
constexpr size_t WS_ROPE = 6 * MiB;
constexpr size_t WS_PEBP = 7 * MiB;
constexpr size_t WS_PEB = 7 * MiB + 65536;
constexpr size_t WS_WGT = 7 * MiB + 262144;
constexpr size_t WS_NG = 8 * MiB;
constexpr size_t WS_SPART = 13 * MiB;
constexpr size_t WS_SSQP = 11 * MiB;
constexpr size_t WS_WINT = 16 * MiB;
constexpr size_t WS_WBR = 28 * MiB;
constexpr size_t WS_WOUT = 30 * MiB;
constexpr size_t WS_WC1 = 32 * MiB;
constexpr size_t WS_WC2 = 34 * MiB;
constexpr size_t WS_H = 36 * MiB;
constexpr size_t WS_QB = 72 * MiB;
constexpr size_t WS_SA = 90 * MiB;
constexpr size_t WS_U = 108 * MiB;
constexpr size_t WS_CBG = 126 * MiB;
constexpr size_t WS_GA = 144 * MiB;
constexpr size_t WS_GB = 178 * MiB;
constexpr size_t WS_KVI = 212 * MiB;
constexpr size_t WS_KC = 230 * MiB;
constexpr size_t KC_KIND_BYTES = (size_t)34816 * 64 * 2;
constexpr size_t WS_HID = 240 * MiB;
constexpr size_t HID_KIND_BYTES = (size_t)34816 * 256 * 2;
constexpr size_t WS_CMPA = 276 * MiB;
constexpr size_t CMPA_KIND_BYTES = (size_t)(34816 + 2) * 1024 * 2;
constexpr size_t WS_AOY = 420 * MiB;
constexpr size_t WS_T1 = 456 * MiB;
constexpr size_t WS_OPRE = 524 * MiB;
constexpr size_t WS_O = 560 * MiB;
constexpr size_t WS_END = 628 * MiB;
constexpr size_t WS_OUT2 = 640 * MiB;
constexpr size_t WS_ORC = 1024 * MiB;

struct Params {
    const float *xp, *xs, *cache, *swin, *sconv; const int* ptab; const float *cp, *cs, *w_ada, *b_ada, *g_pre, *g_post, *w_in, *pe, *w1, *w2, *conv_w, *wba, *wbb, *wout;
    float* out; unsigned char* ws; int ph_lo, ph_hi;
};

__device__ __forceinline__ float fast_rcp(float x) { return __builtin_amdgcn_rcpf(x); }
__device__ __forceinline__ float sigm(float x) { return fast_rcp(1.f + __expf(-x)); }
__device__ __forceinline__ float silu(float x) { return x * fast_rcp(1.f + __expf(-x)); }
__device__ __forceinline__ unsigned f2bf(float f) { unsigned u = __builtin_bit_cast(unsigned, f); return (u + 0x7fffu + ((u >> 16) & 1u)) >> 16; }
__device__ __forceinline__ unsigned pk2(float lo, float hi) { typedef __bf16 bf16x2_t __attribute__((ext_vector_type(2))); f32x2 v = {lo, hi}; bf16x2_t b = __builtin_convertvector(v, bf16x2_t); return __builtin_bit_cast(unsigned, b); }
__device__ __forceinline__ float bf2f(unsigned short b) { return __builtin_bit_cast(float, (unsigned)b << 16); }
__device__ __forceinline__ float bflo(unsigned w) { return __builtin_bit_cast(float, w << 16); }
__device__ __forceinline__ float bfhi(unsigned w) { return __builtin_bit_cast(float, w & 0xffff0000u); }

namespace pg8 {
constexpr int BM = 256, BK = 64, HALF = 128, HTB = HALF * BK * 2, STAGE_BYTES = 8 * HTB, NXCD = 8, WGM = 8;
__host__ __device__ __forceinline__ int lds_byte(int r, int c) { const int st = (r >> 4) * 2 + (c >> 5), rr = r & 15, cc = c & 31, ob = rr * 64 + cc * 2; return st * 1024 + (ob ^ (((ob >> 9) & 1) << 5)); }
__host__ __device__ __forceinline__ void stage_rc(int b, int& R, int& C) { const int st = b / 1024, sb = b % 1024, swz = sb ^ (((sb >> 9) & 1) << 5); R = (st >> 1) * 16 + swz / 64; C = (st & 1) * 32 + (swz % 64) / 2; }
__host__ __device__ __forceinline__ int perm32(int rho) { const int n = rho >> 4, i = rho & 15; return 8 * (i >> 2) + 4 * n + (i & 3); }

struct Unit { int pm, pn, aux; size_t aoff, boff; };
struct Gemm { const bf16_t* A; const bf16_t* Bt; int lda, ldb, K; };

__device__ __forceinline__ bool static_tile_L(long L, int nM, int nN, int& pm, int& pn);
__device__ __forceinline__ bool static_tile(int i, int G, int c, int nM, int nN, int& pm, int& pn) { return static_tile_L((long)i * G + c, nM, nN, pm, pn); }
__device__ __forceinline__ bool static_tile_L(long L, int nM, int nN, int& pm, int& pn) {
    const int nwg = nM * nN; if (L >= nwg) return false;
    int wgid = (int)L; { const int q = nwg / NXCD, r = nwg % NXCD, xcd = wgid % NXCD, off = wgid / NXCD; wgid = (xcd < r ? xcd * (q + 1) : r * (q + 1) + (xcd - r) * q) + off; }
    const int nig = WGM * nN, gid = wgid / nig, fm = gid * WGM, gsz = (nM - fm) < WGM ? (nM - fm) : WGM;
    pm = fm + ((wgid % nig) % gsz); pn = (wgid % nig) / gsz; return true;
}

template <class Epi, class Sched>
__device__ __forceinline__ void gemm_phase(LAS unsigned char* lds, const Gemm g, const Sched& S, const Epi& E) {
    const int tid = threadIdx.x, wid = __builtin_amdgcn_readfirstlane(tid >> 6), lane = tid & 63, wr = wid >> 2, wc = wid & 3, fr = lane & 15, fq = lane >> 4;
    const int nt = g.K / BK;
    unsigned voffA[2], voffB[2];
#pragma unroll
    for (int i = 0; i < 2; ++i) { int R, C; stage_rc(tid * 16 + i * 8192, R, C); const int Rb = Epi::PERM ? ((R & ~31) + perm32(R & 31)) : R;
        voffA[i] = (unsigned)(R * g.lda + C) * 2u; voffB[i] = (unsigned)(Rb * g.ldb + C) * 2u; }
    const size_t kstep = (size_t)(BK * 2);
    const size_t hstepA = (size_t)HALF * g.lda * 2, hstepB = (size_t)HALF * g.ldb * 2;
    const unsigned ldsw = (unsigned)wid * 1024u;
    const int aoff = lds_byte(wr * 64 + fr, fq * 8), boff = lds_byte(wc * 32 + fr, fq * 8);
#define PG8_SA(b, h) (((b) * 2 + (h)) * HTB)
#define PG8_SB(b, h) ((4 + (b) * 2 + (h)) * HTB)
#define PG8_STAGE(bufoff, gbase, voff) do { _Pragma("unroll") for (int _i = 0; _i < 2; ++_i) \
        __builtin_amdgcn_global_load_lds((const unsigned*)((const char*)(gbase) + (voff)[_i]), (LAS unsigned*)(lds + (bufoff) + ldsw + _i * 8192), 16, 0, 0); } while (0)
#define PG8_LDA(dst, b, h) do { _Pragma("unroll") for (int m = 0; m < 4; ++m) _Pragma("unroll") for (int k = 0; k < 2; ++k) dst[m][k] = *(const LAS bf16x8*)(lds + PG8_SA(b, h) + aoff + m * 2048 + k * 1024); } while (0)
#define PG8_LDB(dst, b, h) do { _Pragma("unroll") for (int n = 0; n < 2; ++n) _Pragma("unroll") for (int k = 0; k < 2; ++k) dst[n][k] = *(const LAS bf16x8*)(lds + PG8_SB(b, h) + boff + n * 2048 + k * 1024); } while (0)
#define PG8_MMA(ai, bj, At, Bt) do { __builtin_amdgcn_s_setprio(1); _Pragma("unroll") for (int m = 0; m < 4; ++m) _Pragma("unroll") for (int n = 0; n < 2; ++n) _Pragma("unroll") for (int k = 0; k < 2; ++k) \
        acc[ai][bj][m][n] = __builtin_amdgcn_mfma_f32_16x16x32_bf16(Bt[n][k], At[m][k], acc[ai][bj][m][n], 0, 0, 0); __builtin_amdgcn_s_setprio(0); } while (0)
#define PG8_WAIT_V(n) asm volatile("s_waitcnt vmcnt(" #n ")" ::: "memory")
#define PG8_WAIT_L(n) asm volatile("s_waitcnt lgkmcnt(" #n ")" ::: "memory")
#define PG8_BAR __builtin_amdgcn_s_barrier()
#define PG8_SCHED __builtin_amdgcn_sched_barrier(0)
    Unit cur, nxt; int ui = 0;
    if (!S.next(0, cur)) return;
    f32x4 acc[2][2][4][2];
#pragma unroll
    for (int a = 0; a < 2; ++a)
#pragma unroll
        for (int b = 0; b < 2; ++b)
#pragma unroll
            for (int m = 0; m < 4; ++m)
#pragma unroll
                for (int n = 0; n < 2; ++n) acc[a][b][m][n] = (f32x4){0.f, 0.f, 0.f, 0.f};
    bf16x8 At[4][2], B0[2][2], B1[2][2];
    const char* cA = (const char*)g.A + cur.aoff; const char* cB = (const char*)g.Bt + cur.boff;
    PG8_STAGE(PG8_SB(0, 0), cB, voffB); PG8_STAGE(PG8_SB(0, 1), cB + hstepB, voffB); PG8_STAGE(PG8_SA(0, 0), cA, voffA); PG8_STAGE(PG8_SA(0, 1), cA + hstepA, voffA);
    if (wr == 1) PG8_BAR;
    PG8_WAIT_V(2); PG8_BAR;
    PG8_STAGE(PG8_SB(1, 0), cB + kstep, voffB); PG8_STAGE(PG8_SA(1, 0), cA + kstep, voffA); PG8_STAGE(PG8_SB(1, 1), cB + hstepB + kstep, voffB);
    PG8_WAIT_V(6); PG8_BAR;
    for (;;) {
        const bool has_next = S.next(ui + 1, nxt);
        const char* nA = has_next ? (const char*)g.A + nxt.aoff : cA; const char* nB = has_next ? (const char*)g.Bt + nxt.boff : cB;
        for (int t = 0; t < nt; t += 2) {
            if constexpr (Epi::HAS_MID) { if (t == (nt >> 1)) { int fr_ = fr, fq_ = fq; asm volatile("" : "+v"(fr_), "+v"(fq_)); E.mid(acc, cur, wr, wc, fr_, fq_); } }
            const bool last = (t == nt - 2);
            const char* a1 = cA + (size_t)(t + 1) * kstep;
            const char* a2 = last ? nA : cA + (size_t)(t + 2) * kstep; const char* b2 = last ? nB : cB + (size_t)(t + 2) * kstep;
            const char* a3 = a2 + kstep; const char* b3 = b2 + kstep;
            PG8_LDB(B0, 0, 0); PG8_LDB(B1, 0, 1); PG8_SCHED; PG8_LDA(At, 0, 0); PG8_STAGE(PG8_SA(1, 1), a1 + hstepA, voffA);
            PG8_WAIT_V(8); PG8_WAIT_L(0); PG8_BAR; PG8_MMA(0, 0, At, B0); PG8_MMA(0, 1, At, B1); PG8_BAR; PG8_SCHED;
            PG8_LDA(At, 0, 1); PG8_STAGE(PG8_SB(0, 0), b2, voffB); PG8_STAGE(PG8_SB(0, 1), b2 + hstepB, voffB); PG8_STAGE(PG8_SA(0, 0), a2, voffA);
            PG8_WAIT_V(8); PG8_WAIT_L(0); PG8_BAR; PG8_MMA(1, 0, At, B0); PG8_MMA(1, 1, At, B1); PG8_BAR; PG8_SCHED;
            PG8_LDB(B0, 1, 0); PG8_LDB(B1, 1, 1); PG8_SCHED; PG8_LDA(At, 1, 0); PG8_STAGE(PG8_SA(0, 1), a2 + hstepA, voffA);
            PG8_WAIT_V(8); PG8_WAIT_L(0); PG8_BAR; PG8_MMA(0, 0, At, B0); PG8_MMA(0, 1, At, B1); PG8_BAR; PG8_SCHED;
            PG8_LDA(At, 1, 1); PG8_STAGE(PG8_SB(1, 0), b3, voffB); PG8_STAGE(PG8_SB(1, 1), b3 + hstepB, voffB); PG8_STAGE(PG8_SA(1, 0), a3, voffA);
            PG8_WAIT_V(8); PG8_WAIT_L(0); PG8_BAR; PG8_MMA(1, 0, At, B0); PG8_MMA(1, 1, At, B1); PG8_BAR; PG8_SCHED;
        }
        if (wr == 0) PG8_BAR;
        { int fr_ = fr, fq_ = fq; asm volatile("" : "+v"(fr_), "+v"(fq_)); E(acc, cur, wr, wc, fr_, fq_); }
        if constexpr (Epi::HAS_BETWEEN) E.between(ui, wid, lane);
        if (!has_next) break;
#pragma unroll
        for (int a = 0; a < 2; ++a)
#pragma unroll
            for (int b = 0; b < 2; ++b)
#pragma unroll
                for (int m = 0; m < 4; ++m)
#pragma unroll
                    for (int n = 0; n < 2; ++n) acc[a][b][m][n] = (f32x4){0.f, 0.f, 0.f, 0.f};
        cur = nxt; cA = nA; cB = nB; ++ui;
        if (wr == 1) PG8_BAR;
    }
    PG8_WAIT_V(0);
    PG8_BAR;
#undef PG8_SA
#undef PG8_SB
#undef PG8_STAGE
#undef PG8_LDA
#undef PG8_LDB
#undef PG8_MMA
#undef PG8_WAIT_V
#undef PG8_WAIT_L
#undef PG8_BAR
#undef PG8_SCHED
}
}

typedef f32x4 Acc[2][2][4][2];

constexpr int N_CACHE_ITEMS = 16384;
__device__ __forceinline__ void cache_load(const float* cache, const int* ptab, int r, int lane, f32x4 (&v)[16]) {
    const int tok0 = r * 16, bs = tok0 >> 11, t0 = tok0 & 2047; const int phys = ptab[bs * 16 + (t0 >> 7)];
    const float* src = cache + ((size_t)phys * 128 + (t0 & 127)) * 512 + lane * 4;
#pragma unroll
    for (int j = 0; j < 16; ++j) v[j] = *(const f32x4*)(src + (size_t)j * 512);
}
__device__ __forceinline__ void cache_store(unsigned char* ws, int r, int lane, const f32x4 (&v)[16]) {
    const int tok0 = r * 16, bs = tok0 >> 11, t0 = tok0 & 2047;
    const int kind = lane >> 5, g = (lane >> 4) & 1, d = (lane & 15) * 4;
    bf16_t* dst = (bf16_t*)(ws + WS_CMPA + (size_t)kind * CMPA_KIND_BYTES) + ((size_t)(bs * 2 + g) * 2048 + t0) * 64 + d;
#pragma unroll
    for (int j = 0; j < 16; ++j) { u32x2 w; w.x = pk2(v[j][0], v[j][1]); w.y = pk2(v[j][2], v[j][3]); *(u32x2*)(dst + j * 64) = w; }
}
__device__ __forceinline__ void cache_span(const float* cache, const int* ptab, unsigned char* ws, int lo, int hi, int step, int lane) {
    f32x4 va[16], vb[16];
    if (lo < hi) cache_load(cache, ptab, lo, lane, va);
#pragma unroll 1
    for (int it = lo; it < hi; it += 2 * step) {
        if (it + step < hi) cache_load(cache, ptab, it + step, lane, vb);
        cache_store(ws, it, lane, va);
        if (it + 2 * step < hi) cache_load(cache, ptab, it + 2 * step, lane, va);
        if (it + step < hi) cache_store(ws, it + step, lane, vb); }
}

struct EpiMain {
    static constexpr bool PERM = true, HAS_MID = false, HAS_BETWEEN = true;
    float* out; bf16_t *Qb, *CMPAp0, *CMPAp1, *KVI, *SA, *U, *CBG, *GA, *GB; const float* rope;
    const float* cache; const int* ptab; unsigned char* wsb; int c, G;
    __device__ __forceinline__ void between(int ui, int wid, int lane) const {
        if (G != 256 || ui != c % 5) return;
        const int lo = c < 215 ? c * 58 : 215 * 58 + (c - 215) * 96, n = c < 215 ? 58 : 96; const int hi = lo + n < N_CACHE_ITEMS ? lo + n : N_CACHE_ITEMS;
        cache_span(cache, ptab, wsb, lo + wid, hi, 8, lane);
        asm volatile("s_waitcnt vmcnt(0)" ::: "memory");
    }
    __device__ __forceinline__ void operator()(const Acc& acc, const pg8::Unit& u, int wr, int wc, int fr, int fq) const {
        const int pn = u.pn;
        const int lane16 = fq;
        f32x4 ncs0 = {0.f, 0.f, 0.f, 0.f}, ncs1 = ncs0, nsn0 = ncs0, nsn1 = ncs0;
#pragma unroll
        for (int ai = 0; ai < 2; ++ai)
#pragma unroll
            for (int m = 0; m < 4; ++m) {
                asm volatile("" ::: "memory");
                const int row = u.pm * 256 + ai * 128 + wr * 64 + m * 16 + fr;
                const bool rok = row < MALL;
                const bool prompt = row < MP;
                const int pos = prompt ? (row & (TS - 1)) : 2048;
                if (pn < 5) {
                    const bool isq = pn < 2;
                    const bool ropelane = ((wc & 1) == 0) && (lane16 < 2);
                    if (ai == 0 && m == 0) { if (ropelane) { const float* rp = rope + (size_t)pos * 16; ncs0 = *(const f32x4*)(rp); ncs1 = *(const f32x4*)(rp + 4); nsn0 = *(const f32x4*)(rp + 8); nsn1 = *(const f32x4*)(rp + 12); } }
                    const f32x4 cs0 = ncs0, cs1 = ncs1, sn0 = nsn0, sn1 = nsn1;
                    if (!(ai == 1 && m == 3)) { const int nrow = u.pm * 256 + (m == 3 ? 128 : ai * 128) + wr * 64 + ((m + 1) & 3) * 16 + fr; const int npos = nrow < MP ? (nrow & (TS - 1)) : 2048;
                        if (ropelane) { const float* rp = rope + (size_t)npos * 16; ncs0 = *(const f32x4*)(rp); ncs1 = *(const f32x4*)(rp + 4); nsn0 = *(const f32x4*)(rp + 8); nsn1 = *(const f32x4*)(rp + 12); } }
#pragma unroll
                    for (int bj = 0; bj < 2; ++bj) {
                        f32x4 v0 = acc[ai][bj][m][0], v1 = acc[ai][bj][m][1];
                        const bool dorope = isq || (bj == 0);
                        if (dorope) {
                            f32x4 p0, p1;
#pragma unroll
                            for (int j = 0; j < 4; ++j) { p0[j] = __shfl_xor(v0[j], 16); p1[j] = __shfl_xor(v1[j], 16); }
                            if (ropelane) {
                                if (lane16 == 0) { v0 = v0 * cs0 - p0 * sn0; v1 = v1 * cs1 - p1 * sn1; }
                                else { v0 = p0 * sn0 + v0 * cs0; v1 = p1 * sn1 + v1 * cs1; }
                            }
                        }
                        if (!rok) continue;
                        if (isq) {
                            u32x4 w; w.x = pk2(v0[0] * QSCALE, v0[1] * QSCALE); w.y = pk2(v0[2] * QSCALE, v0[3] * QSCALE); w.z = pk2(v1[0] * QSCALE, v1[1] * QSCALE); w.w = pk2(v1[2] * QSCALE, v1[3] * QSCALE);
                            *(u32x4*)(Qb + (size_t)row * 512 + pn * 256 + bj * 128 + wc * 32 + fq * 8) = w;
                        } else {
                            const int kind = 2 * (pn - 2) + bj, g = wc >> 1, dim0 = 32 * (wc & 1) + 8 * fq;
                            if (prompt) {
                                const int b = row >> 13, t = row & (TS - 1), bg = b * 2 + g;
                                if (kind < 4) { float* o = out + O_KVP + ((size_t)row * 4 + kind) * 128 + g * 64 + dim0; *(f32x4*)o = v0; *(f32x4*)(o + 4) = v1; }
                                else if (t >= TS - 512) { float* o = out + O_WINP + ((size_t)(b * 512 + t - (TS - 512)) * 2 + (kind - 4)) * 128 + g * 64 + dim0; *(f32x4*)o = v0; *(f32x4*)(o + 4) = v1; }
                                u32x4 w; w.x = pk2(v0[0], v0[1]); w.y = pk2(v0[2], v0[3]); w.z = pk2(v1[0], v1[1]); w.w = pk2(v1[2], v1[3]);
                                if (kind < 2) { bf16_t* base = kind ? CMPAp1 : CMPAp0; *(u32x4*)(base + ((size_t)bg * TS + t) * 64 + dim0) = w; }
                                else {
                                    unsigned char* img = (unsigned char*)KVI + ((size_t)((kind - 2) * 4 + bg) * 128 + (t >> 6)) * 8192; const int key = t & 63;
                                    if ((kind & 1) == 0) *(u32x4*)(img + (dim0 >> 3) * 1024 + key * 16) = w;
                                    else { const int k16 = key & 15, pp = 8 * ((k16 >> 2) & 1) + 4 * (k16 >> 3) + (k16 & 3); unsigned char* vq = img + (key >> 4) * 2048 + dim0 * 32 + pp * 2;
                                        *(bf16_t*)(vq) = (bf16_t)w.x; *(bf16_t*)(vq + 32) = (bf16_t)(w.x >> 16); *(bf16_t*)(vq + 64) = (bf16_t)w.y; *(bf16_t*)(vq + 96) = (bf16_t)(w.y >> 16);
                                        *(bf16_t*)(vq + 128) = (bf16_t)w.z; *(bf16_t*)(vq + 160) = (bf16_t)(w.z >> 16); *(bf16_t*)(vq + 192) = (bf16_t)w.w; *(bf16_t*)(vq + 224) = (bf16_t)(w.w >> 16); }
                                }
                            } else {
                                const int bs = row - MP;
                                float* o = kind < 4 ? out + O_KVS + ((size_t)bs * 4 + kind) * 128 + g * 64 + dim0 : out + O_WINS + ((size_t)(bs * 512 + 511) * 2 + (kind - 4)) * 128 + g * 64 + dim0;
                                *(f32x4*)o = v0; *(f32x4*)(o + 4) = v1;
                            }
                        }
                    }
                } else if (pn < 7) {
                    if (!rok) continue;
#pragma unroll
                    for (int bj = 0; bj < 2; ++bj) { const f32x4 v0 = acc[ai][bj][m][0], v1 = acc[ai][bj][m][1];
                        u32x4 w; w.x = pk2(silu(v0[0]), silu(v0[1])); w.y = pk2(silu(v0[2]), silu(v0[3])); w.z = pk2(silu(v1[0]), silu(v1[1])); w.w = pk2(silu(v1[2]), silu(v1[3]));
                        *(u32x4*)(SA + (size_t)row * 512 + (pn - 5) * 256 + bj * 128 + wc * 32 + fq * 8) = w; }
                } else if (pn < 15) {
                    if (!rok) continue;
                    const f32x4 cb = acc[ai][0][m][0], cg = acc[ai][0][m][1], cc = acc[ai][1][m][0], cx = acc[ai][1][m][1];
                    const int c0 = 64 * (pn - 7) + 16 * wc + 4 * fq;
                    const f32x4 uu = cc * cx; f32x4 cbg;
#pragma unroll
                    for (int j = 0; j < 4; ++j) cbg[j] = cb[j] * silu(cg[j]);
                    u32x2 wu, wc2; wu.x = pk2(uu[0], uu[1]); wu.y = pk2(uu[2], uu[3]); wc2.x = pk2(cbg[0], cbg[1]); wc2.y = pk2(cbg[2], cbg[3]);
                    *(u32x2*)(U + (size_t)row * 512 + c0) = wu; *(u32x2*)(CBG + (size_t)row * 512 + c0) = wc2;
                    if (prompt) { const int t = row & (TS - 1); if (t >= TS - 2) *(f32x4*)(out + O_CSP + ((size_t)(row >> 13) * 2 + (t - (TS - 2))) * 512 + c0) = uu; }
                    else *(f32x4*)(out + O_CSS + ((size_t)(row - MP) * 2 + 1) * 512 + c0) = uu;
                } else {
                    if (!rok) continue;
                    const int col = (pn - 15) * 128 + wc * 32 + fq * 8;
                    const f32x4 a0 = acc[ai][0][m][0], a1 = acc[ai][0][m][1], b0 = acc[ai][1][m][0], b1 = acc[ai][1][m][1];
                    float rr[8], gg[8];
#pragma unroll
                    for (int j = 0; j < 4; ++j) { const float ea0 = 1.f + __expf(-a0[j]), eb0 = 1.f + __expf(-b0[j]), ea1 = 1.f + __expf(-a1[j]), eb1 = 1.f + __expf(-b1[j]);
                        const float r0 = fast_rcp(ea0 * eb0), r1 = fast_rcp(ea1 * eb1);
                        rr[j] = eb0 * eb0 * r0; gg[j] = ea0 * r0; rr[4 + j] = eb1 * eb1 * r1; gg[4 + j] = ea1 * r1; }
                    u32x4 wr_, wg_; wr_.x = pk2(rr[0], rr[1]); wr_.y = pk2(rr[2], rr[3]); wr_.z = pk2(rr[4], rr[5]); wr_.w = pk2(rr[6], rr[7]);
                    wg_.x = pk2(gg[0], gg[1]); wg_.y = pk2(gg[2], gg[3]); wg_.z = pk2(gg[4], gg[5]); wg_.w = pk2(gg[6], gg[7]);
                    *(u32x4*)(GA + (size_t)row * 1024 + col) = wr_; *(u32x4*)(GB + (size_t)row * 1024 + col) = wg_;
                }
            }
    }
};
struct SchedMain {
    int G, c;
    __device__ __forceinline__ bool next(int i, pg8::Unit& u) const {
        int pm, pn; if (!pg8::static_tile(i, G, c, 65, 23, pm, pn)) return false;
        u.pm = pm; u.pn = pn; u.aux = 0; u.aoff = (size_t)pm * 256 * 1024 * 2; u.boff = (size_t)pn * 256 * 1024 * 2; return true; }
};

struct EpiCmp1 {
    static constexpr bool PERM = true, HAS_MID = false, HAS_BETWEEN = false;
    bf16_t* HID; const float* peb;
    __device__ __forceinline__ void operator()(const Acc& acc, const pg8::Unit& u, int wr, int wc, int fr, int fq) const {
        const int kind = u.aux; bf16_t* H = HID + (size_t)kind * (HID_KIND_BYTES / 2);
        f32x4 bv[2][2];
#pragma unroll
        for (int bj = 0; bj < 2; ++bj)
#pragma unroll
            for (int n = 0; n < 2; ++n) bv[bj][n] = *(const f32x4*)(peb + kind * 256 + bj * 128 + wc * 32 + fq * 8 + n * 4);
#pragma unroll
        for (int ai = 0; ai < 2; ++ai)
#pragma unroll
            for (int m = 0; m < 4; ++m) { const int row = u.pm * 256 + ai * 128 + wr * 64 + m * 16 + fr;
#pragma unroll
                for (int bj = 0; bj < 2; ++bj) { const f32x4 v0 = acc[ai][bj][m][0] + bv[bj][0], v1 = acc[ai][bj][m][1] + bv[bj][1];
                    u32x4 w; w.x = pk2(silu(v0[0]), silu(v0[1])); w.y = pk2(silu(v0[2]), silu(v0[3])); w.z = pk2(silu(v1[0]), silu(v1[1])); w.w = pk2(silu(v1[2]), silu(v1[3]));
                    *(u32x4*)(H + (size_t)row * 256 + bj * 128 + wc * 32 + fq * 8) = w; } }
    }
};
struct SchedCmp {
    int G, c, pm0, npm;
    __device__ __forceinline__ bool next(int i, pg8::Unit& u) const {
        const int L = i * G + c; if (c < 0 || L >= 2 * npm) return false;
        const int kind = L / npm, pm = pm0 + L % npm;
        u.pm = pm; u.pn = 0; u.aux = kind; u.aoff = (size_t)kind * CMPA_KIND_BYTES + (size_t)pm * 256 * 1024 * 2; u.boff = (size_t)kind * 256 * 2048 * 2; return true; }
};


struct EpiCmp2 {
    static constexpr bool PERM = true, HAS_MID = false, HAS_BETWEEN = false;
    unsigned char* KC;
    __device__ __forceinline__ void operator()(const Acc& acc, const pg8::Unit& u, int wr, int wc, int fr, int fq) const {
        if (wc >= 2) return;
        const int kind = u.aux, d0 = 32 * wc + 8 * fq; unsigned char* img = KC + (size_t)kind * KC_KIND_BYTES;
#pragma unroll
        for (int ai = 0; ai < 2; ++ai)
#pragma unroll
            for (int m = 0; m < 4; ++m) { const int row = u.pm * 256 + ai * 128 + wr * 64 + m * 16 + fr, tile = row >> 6, key = row & 63;
                const f32x4 v0 = acc[ai][0][m][0], v1 = acc[ai][0][m][1];
                u32x4 w; w.x = pk2(v0[0], v0[1]); w.y = pk2(v0[2], v0[3]); w.z = pk2(v1[0], v1[1]); w.w = pk2(v1[2], v1[3]);
                if (kind == 0) *(u32x4*)(img + (size_t)tile * 8192 + (d0 >> 3) * 1024 + key * 16) = w;
                else { const int k16 = key & 15, pp = 8 * ((k16 >> 2) & 1) + 4 * (k16 >> 3) + (k16 & 3); unsigned char* vq = img + (size_t)tile * 8192 + (key >> 4) * 2048 + d0 * 32 + pp * 2;
                    *(bf16_t*)(vq) = (bf16_t)w.x; *(bf16_t*)(vq + 32) = (bf16_t)(w.x >> 16); *(bf16_t*)(vq + 64) = (bf16_t)w.y; *(bf16_t*)(vq + 96) = (bf16_t)(w.y >> 16);
                    *(bf16_t*)(vq + 128) = (bf16_t)w.z; *(bf16_t*)(vq + 160) = (bf16_t)(w.z >> 16); *(bf16_t*)(vq + 192) = (bf16_t)w.w; *(bf16_t*)(vq + 224) = (bf16_t)(w.w >> 16); } }
    }
};
struct SchedCmp2 {
    int G, c, pm0, npm;
    __device__ __forceinline__ bool next(int i, pg8::Unit& u) const {
        const int L = i * G + c; if (c < 0 || L >= 2 * npm) return false;
        const int kind = L / npm, pm = pm0 + L % npm;
        u.pm = pm; u.pn = 0; u.aux = kind; u.aoff = (size_t)kind * HID_KIND_BYTES + (size_t)pm * 256 * 256 * 2; u.boff = (size_t)kind * 256 * 256 * 2; return true; }
};
struct EpiE1 {
    static constexpr bool PERM = true, HAS_MID = true, HAS_BETWEEN = false;
    const bf16_t *GR, *GB; bf16_t* OPRE;
    __device__ __forceinline__ void mid(Acc& acc, const pg8::Unit& u, int wr, int wc, int fr, int fq) const {
#pragma unroll
        for (int ai = 0; ai < 2; ++ai) {
            u32x4 gw[4][2];
#pragma unroll
            for (int m = 0; m < 4; ++m)
#pragma unroll
                for (int bj = 0; bj < 2; ++bj) { int row = u.pm * 256 + ai * 128 + wr * 64 + m * 16 + fr; row = row < MALL ? row : MALL - 1;
                    gw[m][bj] = *(const u32x4*)(GR + (size_t)row * 1024 + u.pn * 256 + bj * 128 + wc * 32 + fq * 8); }
#pragma unroll
            for (int m = 0; m < 4; ++m)
#pragma unroll
                for (int bj = 0; bj < 2; ++bj) { const u32x4 g = gw[m][bj];
                    acc[ai][bj][m][0][0] *= bflo(g.x); acc[ai][bj][m][0][1] *= bfhi(g.x); acc[ai][bj][m][0][2] *= bflo(g.y); acc[ai][bj][m][0][3] *= bfhi(g.y);
                    acc[ai][bj][m][1][0] *= bflo(g.z); acc[ai][bj][m][1][1] *= bfhi(g.z); acc[ai][bj][m][1][2] *= bflo(g.w); acc[ai][bj][m][1][3] *= bfhi(g.w); }
        }
    }
    __device__ __forceinline__ void operator()(const Acc& acc, const pg8::Unit& u, int wr, int wc, int fr, int fq) const {
#pragma unroll
        for (int ai = 0; ai < 2; ++ai) {
            u32x4 gw[4][2];
#pragma unroll
            for (int m = 0; m < 4; ++m)
#pragma unroll
                for (int bj = 0; bj < 2; ++bj) { int row = u.pm * 256 + ai * 128 + wr * 64 + m * 16 + fr; row = row < MALL ? row : MALL - 1;
                    gw[m][bj] = *(const u32x4*)(GB + (size_t)row * 1024 + u.pn * 256 + bj * 128 + wc * 32 + fq * 8); }
#pragma unroll
            for (int m = 0; m < 4; ++m) { const int row = u.pm * 256 + ai * 128 + wr * 64 + m * 16 + fr; if (row >= MALL) continue;
#pragma unroll
                for (int bj = 0; bj < 2; ++bj) { const u32x4 g = gw[m][bj]; const f32x4 v0 = acc[ai][bj][m][0], v1 = acc[ai][bj][m][1];
                    u32x4 w; w.x = pk2(v0[0] * bflo(g.x), v0[1] * bfhi(g.x)); w.y = pk2(v0[2] * bflo(g.y), v0[3] * bfhi(g.y)); w.z = pk2(v1[0] * bflo(g.z), v1[1] * bfhi(g.z)); w.w = pk2(v1[2] * bflo(g.w), v1[3] * bfhi(g.w));
                    *(u32x4*)(OPRE + (size_t)row * 1024 + u.pn * 256 + bj * 128 + wc * 32 + fq * 8) = w; } }
        }
    }
};
struct EpiE2 {
    static constexpr bool PERM = true, HAS_MID = false, HAS_BETWEEN = false;
    bf16_t* O; float* SSQP;
    __device__ __forceinline__ void operator()(const Acc& acc, const pg8::Unit& u, int wr, int wc, int fr, int fq) const {
#pragma unroll
        for (int ai = 0; ai < 2; ++ai)
#pragma unroll
            for (int m = 0; m < 4; ++m) { const int row = u.pm * 256 + ai * 128 + wr * 64 + m * 16 + fr; float s = 0.f;
#pragma unroll
                for (int bj = 0; bj < 2; ++bj) { const f32x4 v0 = acc[ai][bj][m][0], v1 = acc[ai][bj][m][1];
                    s += ((v0[0] * v0[0] + v0[1] * v0[1]) + (v0[2] * v0[2] + v0[3] * v0[3])) + ((v1[0] * v1[0] + v1[1] * v1[1]) + (v1[2] * v1[2] + v1[3] * v1[3]));
                    u32x4 w; w.x = pk2(v0[0], v0[1]); w.y = pk2(v0[2], v0[3]); w.z = pk2(v1[0], v1[1]); w.w = pk2(v1[2], v1[3]);
                    *(u32x4*)(O + (size_t)row * 1024 + u.pn * 256 + bj * 128 + wc * 32 + fq * 8) = w; }
                s += __shfl_xor(s, 16); s += __shfl_xor(s, 32);
                if (fq == 0) SSQP[(size_t)row * 16 + u.pn * 4 + wc] = s; }
    }
};
struct SchedE2 {
    int G, c;
    __device__ __forceinline__ bool next(int i, pg8::Unit& u) const {
        int pm, pn; if (!pg8::static_tile(i, G, c, 64, 4, pm, pn)) return false;
        u.pm = pm; u.pn = pn; u.aux = 0; u.aoff = (size_t)pm * 256 * 1024 * 2; u.boff = (size_t)pn * 256 * 1024 * 2; return true; }
};
struct SchedOne {
    int pm, pn;
    __device__ __forceinline__ bool next(int i, pg8::Unit& u) const {
        if (i != 0) return false;
        u.pm = pm; u.pn = pn; u.aux = 0; u.aoff = (size_t)pm * 256 * 1024 * 2; u.boff = (size_t)pn * 256 * 1024 * 2; return true; }
};
struct Frame { LAS unsigned char* lds; int tid, lane, wave, vcu, G; };

__device__ __forceinline__ float wave_sum(float v) {
#pragma unroll
    for (int o = 1; o < 64; o <<= 1) v += __shfl_xor(v, o);
    return v;
}
__device__ __forceinline__ int win_src(int v) {
    const int pn = v >> 8, w = v & 255;
    if (pn < 5) return v;
    if (pn < 7) return C_A + (v - 5 * 256);
    if (pn < 15) { const int ti = pn - 7, bj = w >> 7, wc = (w >> 5) & 3, fq = (w >> 3) & 3, e = w & 7, tsel = e >> 2, e3 = e & 3;
        const int ch = 64 * ti + 16 * wc + 4 * fq + e3, type = bj * 2 + tsel;
        return (type == 0 ? C_CB : type == 1 ? C_CG : type == 2 ? C_CC : C_CX) + ch; }
    return C_GA + ((w >> 7) ? 1024 : 0) + (pn - 15) * 128 + (w & 127);
}
template <class SrcMap>
__device__ __forceinline__ void transpose_item(const float* W, int N, bf16_t* WT, int ldt, int kcol0, LAS float* scr, int k0, int n0, int lane, const SrcMap& src) {
    const int kq = lane >> 3, n4 = (lane & 7) * 4; const int sc = src(n0 + n4);
    f32x4 v[8];
#pragma unroll
    for (int i = 0; i < 8; ++i) v[i] = *(const f32x4*)(W + (size_t)(k0 + kq + 8 * i) * N + sc);
#pragma unroll
    for (int i = 0; i < 8; ++i) { LAS float* d = scr + (kq + 8 * i) * 33 + n4; d[0] = v[i][0]; d[1] = v[i][1]; d[2] = v[i][2]; d[3] = v[i][3]; }
    asm volatile("s_waitcnt lgkmcnt(0)" ::: "memory");
    const int c = lane & 7;
#pragma unroll
    for (int j = 0; j < 4; ++j) { const int n = (lane >> 3) + 8 * j; const LAS float* s = scr + (8 * c) * 33 + n;
        u32x4 o; o.x = pk2(s[0 * 33], s[1 * 33]); o.y = pk2(s[2 * 33], s[3 * 33]); o.z = pk2(s[4 * 33], s[5 * 33]); o.w = pk2(s[6 * 33], s[7 * 33]);
        *(u32x4*)(WT + (size_t)(n0 + n) * ldt + kcol0 + k0 + 8 * c) = o; }
    asm volatile("s_waitcnt lgkmcnt(0)" ::: "memory");
}
struct IdMap { __device__ __forceinline__ int operator()(int n) const { return n; } };
struct GateMap { __device__ __forceinline__ int operator()(int n) const { return C_G + n; } };
struct WinMap { __device__ __forceinline__ int operator()(int n) const { return win_src(n); } };

__device__ __forceinline__ void phase0(const Params& p, const Frame& F) {
    LAS float* scr = (LAS float*)(F.lds + F.wave * 16384);
    unsigned char* ws = p.ws; const int lane = F.lane;
    const int gw = F.vcu * NWAVES + F.wave, NGW = F.G * NWAVES;
    constexpr int I_PEB = 256, I_ROPE = 1024, I_WIN = 16 * 184, I_WBA = 8 * 32, I_WBB = 8 * 32, I_WOUT = 16 * 32, I_WC1 = 2 * 32 * 8, I_WC2 = 2 * 4 * 2, I_WC2Z = 2 * 24, I_WGT = 16,
                  I_CSC = 256;
    constexpr int TOTAL = I_PEB + I_ROPE + I_WIN + I_WBA + I_WBB + I_WOUT + I_WC1 + I_WC2 + I_WC2Z + I_WGT + I_CSC;
    float* mod = (float*)(ws + WS_MOD);
    for (int item = F.vcu; item < 48 * 5; item += F.G) {
        const int nb = item % 48, rt = item / 48, j32 = lane & 31, h = lane >> 5, kbase = F.wave * 128;
        int arow = 32 * rt + j32; arow = arow < 130 ? arow : 129;
        const float* cr = (arow < 2 ? p.cp + (size_t)arow * 1024 : p.cs + (size_t)(arow - 2) * 1024) + kbase + 4 * h;
        const float* wb = p.w_ada + (size_t)(kbase + 4 * h) * 3072 + nb * 64 + 2 * j32;
        f32x16 acc0 = {}, acc1 = {};
#pragma unroll 4
        for (int g8 = 0; g8 < 16; ++g8) {
            const f32x4 cx = *(const f32x4*)(cr + 8 * g8);
            f32x2 bw[4];
#pragma unroll
            for (int s4 = 0; s4 < 4; ++s4) bw[s4] = *(const f32x2*)(wb + (size_t)(8 * g8 + s4) * 3072);
#pragma unroll
            for (int s4 = 0; s4 < 4; ++s4) { const float x = cx[s4]; const float a = x / (1.f + __expf(-x));
                acc0 = __builtin_amdgcn_mfma_f32_32x32x2f32(a, bw[s4][0], acc0, 0, 0, 0); acc1 = __builtin_amdgcn_mfma_f32_32x32x2f32(a, bw[s4][1], acc1, 0, 0, 0); }
        }
        LAS float* red = (LAS float*)F.lds;
        __syncthreads();
#pragma unroll
        for (int r = 0; r < 16; ++r) { red[(F.wave * 32 + r) * 64 + lane] = acc0[r]; red[(F.wave * 32 + 16 + r) * 64 + lane] = acc1[r]; }
        __syncthreads();
        for (int e = F.tid; e < 32 * 64; e += NTHR) { const int v = e >> 6, l = e & 63, ecol = v >> 4, r = v & 15;
            const int row = 32 * rt + (r & 3) + 8 * (r >> 2) + 4 * (l >> 5), col = nb * 64 + 2 * (l & 31) + ecol;
            float sum = p.b_ada[col];
#pragma unroll
            for (int w = 0; w < 8; ++w) sum += red[(w * 32 + v) * 64 + l];
            if (row < 130) mod[(size_t)row * 3072 + col] = sum; }
        __syncthreads();
    }
    for (int it = gw; it < TOTAL; it += NGW) {
        int r = it;
        if (r < I_PEB) {
            const int kind = r >> 7, nb = (r >> 5) & 3, kc = r & 31, n = nb * 64 + lane; float s = 0.f;
            const float* pe = p.pe + kind * 2048 + kc * 64; const float* w = p.w1 + ((size_t)kind * 2048 + kc * 64) * 256 + n;
#pragma unroll
            for (int k = 0; k < 64; ++k) s += pe[k] * w[(size_t)k * 256];
            ((float*)(ws + WS_PEBP))[(kind * 32 + kc) * 256 + n] = s;
            continue;
        }
        r -= I_PEB;
        if (r < I_ROPE) {
            const int idx = r * 64 + lane, pos = idx >> 3, i = idx & 7;
            float inv = 1.0f; inv = i == 1 ? 0.1939227432012558f : inv; inv = i == 2 ? 0.03760603070259094f : inv; inv = i == 3 ? 0.007292664609849453f : inv; inv = i == 4 ? 0.0014142135623842478f : inv;
            inv = i == 5 ? 0.00027424818836152554f : inv; inv = i == 6 ? 5.3182957344688475e-05f : inv; inv = i == 7 ? 1.0313385246263351e-05f : inv;
            const float ang = (float)pos * inv;
            double tr = (double)ang * 0.15915494309189535; tr -= __builtin_rint(tr);
            float sn, cs; sincosf((float)(tr * 6.283185307179586), &sn, &cs);
            float* rp = (float*)(ws + WS_ROPE) + (size_t)pos * 16;
            rp[i] = cs; rp[8 + i] = sn;
            continue;
        }
        r -= I_ROPE;
        if (r < I_WIN) { transpose_item(p.w_in, INW, (bf16_t*)(ws + WS_WINT), 1024, 0, scr, 64 * (r / 184), 32 * (r % 184), lane, WinMap()); continue; }
        r -= I_WIN;
        if (r < I_WBA) { transpose_item(p.wba, 1024, (bf16_t*)(ws + WS_WBR), 1024, 0, scr, 64 * (r / 32), 32 * (r % 32), lane, IdMap()); continue; }
        r -= I_WBA;
        if (r < I_WBB) { transpose_item(p.wbb, 1024, (bf16_t*)(ws + WS_WBR), 1024, 512, scr, 64 * (r / 32), 32 * (r % 32), lane, IdMap()); continue; }
        r -= I_WBB;
        if (r < I_WOUT) { transpose_item(p.wout, 1024, (bf16_t*)(ws + WS_WOUT), 1024, 0, scr, 64 * (r / 32), 32 * (r % 32), lane, IdMap()); continue; }
        r -= I_WOUT;
        if (r < I_WC1) { const int kind = r / 256, q = r % 256; transpose_item(p.w1 + (size_t)kind * 2048 * 256, 256, (bf16_t*)(ws + WS_WC1) + (size_t)kind * 256 * 2048, 2048, 0, scr, 64 * (q / 8), 32 * (q % 8), lane, IdMap()); continue; }
        r -= I_WC1;
        if (r < I_WC2) { const int kind = r / 8, q = r % 8; transpose_item(p.w2 + (size_t)kind * 256 * 64, 64, (bf16_t*)(ws + WS_WC2) + (size_t)kind * 256 * 256, 256, 0, scr, 64 * (q / 2), 32 * (q % 2), lane, IdMap()); continue; }
        r -= I_WC2;
        if (r < I_WC2Z) { const int kind = r / 24, q = r % 24;
            u32x4* z = (u32x4*)((bf16_t*)(ws + WS_WC2) + (size_t)kind * 256 * 256 + (size_t)(64 + 8 * q) * 256);
#pragma unroll
            for (int j = 0; j < 4; ++j) z[j * 64 + lane] = (u32x4){0u, 0u, 0u, 0u};
            continue; }
        r -= I_WC2Z;
        if (r < I_WGT) { transpose_item(p.w_in, INW, (bf16_t*)(ws + WS_WGT), 1024, 0, scr, 64 * r, 0, lane, GateMap()); continue; }
        r -= I_WGT;
        { const int idx = r * 256 + lane * 4, bs = idx >> 9, c = idx & 511;
          *(f32x4*)(p.out + O_CSS + ((size_t)bs * 2) * 512 + c) = *(const f32x4*)(p.sconv + ((size_t)bs * 2 + 1) * 512 + c); }
    }
}

constexpr int N_WINC = (128 * 511 + 15) / 16;
__device__ __forceinline__ void wincopy_item(const Params& p, int r, int lane) {
    f32x4 v[16];
#pragma unroll
    for (int j = 0; j < 16; ++j) { const int ridx = r * 16 + j; if (ridx < 128 * 511) { const int bs = ridx / 511, jj = ridx % 511; v[j] = *(const f32x4*)(p.swin + ((size_t)bs * 512 + jj + 1) * 256 + lane * 4); } }
#pragma unroll
    for (int j = 0; j < 16; ++j) { const int ridx = r * 16 + j; if (ridx < 128 * 511) { const int bs = ridx / 511, jj = ridx % 511; *(f32x4*)(p.out + O_WINS + ((size_t)bs * 512 + jj) * 256 + lane * 4) = v[j]; } }
}
__device__ __forceinline__ float dot2bf(unsigned w, unsigned x, float acc) { typedef __bf16 bf16x2_t __attribute__((ext_vector_type(2)));
    return __builtin_amdgcn_fdot2_f32_bf16(__builtin_bit_cast(bf16x2_t, w), __builtin_bit_cast(bf16x2_t, x), acc, false); }
__device__ __forceinline__ void phase1(const Params& p, const Frame& F) {
    unsigned char* ws = p.ws; const int lane = F.lane;
    LAS unsigned* wg = (LAS unsigned*)F.lds;
    { const u32x4* src = (const u32x4*)(ws + WS_WGT);
#pragma unroll
      for (int i = 0; i < 6; ++i) ((LAS u32x4*)wg)[i * NTHR + F.tid] = src[i * NTHR + F.tid]; }
    __syncthreads();
    const int gw = F.vcu * NWAVES + F.wave, NGW = F.G * NWAVES;
    const float* mod = (const float*)(ws + WS_MOD); bf16_t* H = (bf16_t*)(ws + WS_H); float* NG = (float*)(ws + WS_NG);
    if (gw < 8) { const int kind = gw >> 2, n = (gw & 3) * 64 + lane; float s = 0.f; const float* pp = (const float*)(ws + WS_PEBP) + kind * 32 * 256 + n;
#pragma unroll
        for (int kc = 0; kc < 32; ++kc) s += pp[kc * 256];
        ((float*)(ws + WS_PEB))[kind * 256 + n] = s; }
    f32x4 vn[2][4];
#define P1_LOADX(dst, r_) do { const int r__ = (r_); if (r__ < MALL) { const float* x = r__ < MP ? p.xp + (size_t)r__ * DM : p.xs + (size_t)(r__ - MP) * DM; \
        _Pragma("unroll") for (int j = 0; j < 4; ++j) dst[j] = *(const f32x4*)(x + (j >> 1) * 512 + lane * 8 + (j & 1) * 4); } } while (0)
#pragma unroll
    for (int j = 0; j < 4; ++j) { vn[0][j] = (f32x4){0.f, 0.f, 0.f, 0.f}; vn[1][j] = vn[0][j]; }
    P1_LOADX(vn[0], gw); P1_LOADX(vn[1], gw + NGW);
    for (int row = gw; row < MALL; row += 2 * NGW) {
        const bool ok1 = row + NGW < MALL; const int rw[2] = {row, ok1 ? row + NGW : row};
        f32x4 v[2][4]; float s[2];
#pragma unroll
        for (int u = 0; u < 2; ++u) { s[u] = 0.f;
#pragma unroll
            for (int j = 0; j < 4; ++j) { v[u][j] = vn[u][j]; s[u] += (v[u][j][0] * v[u][j][0] + v[u][j][1] * v[u][j][1]) + (v[u][j][2] * v[u][j][2] + v[u][j][3] * v[u][j][3]); } }
        s[0] = wave_sum(s[0]); s[1] = wave_sum(s[1]);
        u32x4 hp[2][2];
#pragma unroll
        for (int u = 0; u < 2; ++u) { const float rs = rsqrtf(s[u] * (1.f / DM) + 1e-6f); const int r_ = rw[u];
            const float* md = mod + (size_t)(r_ < MP ? (r_ >> 13) : 2 + (r_ - MP)) * 3072;
#pragma unroll
            for (int j = 0; j < 4; ++j) { const int k = (j >> 1) * 512 + lane * 8 + (j & 1) * 4; const f32x4 gp = *(const f32x4*)(p.g_pre + k), sh = *(const f32x4*)(md + k), sc = *(const f32x4*)(md + 1024 + k);
                const f32x4 h = v[u][j] * rs * gp * (1.f + sc) + sh;
                if (j & 1) { hp[u][j >> 1].z = pk2(h[0], h[1]); hp[u][j >> 1].w = pk2(h[2], h[3]); } else { hp[u][j >> 1].x = pk2(h[0], h[1]); hp[u][j >> 1].y = pk2(h[2], h[3]); } }
            if (u == 0 || ok1) { *(u32x4*)(H + (size_t)r_ * DM + lane * 8) = hp[u][0]; *(u32x4*)(H + (size_t)r_ * DM + 512 + lane * 8) = hp[u][1]; } }
        P1_LOADX(vn[0], row + 2 * NGW); P1_LOADX(vn[1], row + 3 * NGW);
        float d[2][24];
#pragma unroll
        for (int c = 0; c < 24; ++c) { if ((c & 3) == 0) asm volatile("" ::: "memory");
            const u32x4 w0 = *(const LAS u32x4*)(wg + c * 512 + lane * 4), w1 = *(const LAS u32x4*)(wg + c * 512 + 256 + lane * 4);
#pragma unroll
            for (int u = 0; u < 2; ++u) { float a = dot2bf(w0.x, hp[u][0].x, 0.f), b = dot2bf(w1.x, hp[u][1].x, 0.f);
                a = dot2bf(w0.y, hp[u][0].y, a); b = dot2bf(w1.y, hp[u][1].y, b); a = dot2bf(w0.z, hp[u][0].z, a); b = dot2bf(w1.z, hp[u][1].z, b); a = dot2bf(w0.w, hp[u][0].w, a); b = dot2bf(w1.w, hp[u][1].w, b);
                d[u][c] = a + b; } }
        const bool b5 = lane & 32, b4 = lane & 16, b3 = lane & 8;
        float e12[2][12], e6[2][6], e3[2][3];
#pragma unroll
        for (int i = 0; i < 12; ++i)
#pragma unroll
            for (int u = 0; u < 2; ++u) { const float snd = b5 ? d[u][i] : d[u][12 + i]; const float rcv = __shfl_xor(snd, 32); e12[u][i] = (b5 ? d[u][12 + i] : d[u][i]) + rcv; }
#pragma unroll
        for (int i = 0; i < 6; ++i)
#pragma unroll
            for (int u = 0; u < 2; ++u) { const float snd = b4 ? e12[u][i] : e12[u][6 + i]; const float rcv = __shfl_xor(snd, 16); e6[u][i] = (b4 ? e12[u][6 + i] : e12[u][i]) + rcv; }
#pragma unroll
        for (int i = 0; i < 3; ++i)
#pragma unroll
            for (int u = 0; u < 2; ++u) { const float snd = b3 ? e6[u][i] : e6[u][3 + i]; const float rcv = __shfl_xor(snd, 8); e3[u][i] = (b3 ? e6[u][3 + i] : e6[u][i]) + rcv; }
#pragma unroll
        for (int i = 0; i < 3; ++i)
#pragma unroll
            for (int u = 0; u < 2; ++u) { float x = e3[u][i]; x += __shfl_xor(x, 4); x += __shfl_xor(x, 2); x += __shfl_xor(x, 1); e3[u][i] = x; }
        { const int l7 = lane & 7;
#pragma unroll
          for (int u = 0; u < 2; ++u) if (l7 < 3 && (u == 0 || ok1)) { const float gsum = l7 == 0 ? e3[u][0] : (l7 == 1 ? e3[u][1] : e3[u][2]);
            NG[(size_t)rw[u] * 32 + (b5 ? 12 : 0) + (b4 ? 6 : 0) + (b3 ? 3 : 0) + l7] = sigm(gsum); } }
    }
#undef P1_LOADX
}

__device__ __forceinline__ void cmp2_item(unsigned char* ws, int kind, int row0, int lane) {
    const bf16_t* H = (const bf16_t*)(ws + WS_HID + (size_t)kind * HID_KIND_BYTES); const bf16_t* W = (const bf16_t*)(ws + WS_WC2) + (size_t)kind * 64 * 256;
    const int r32 = lane & 31, hi = lane >> 5;
    f32x16 acc0 = {}, acc1 = {};
#pragma unroll 4
    for (int s = 0; s < 16; ++s) {
        const bf16x8 a = *(const bf16x8*)(H + (size_t)(row0 + r32) * 256 + s * 16 + hi * 8);
        const bf16x8 b0 = *(const bf16x8*)(W + (size_t)r32 * 256 + s * 16 + hi * 8), b1 = *(const bf16x8*)(W + (size_t)(32 + r32) * 256 + s * 16 + hi * 8);
        acc0 = __builtin_amdgcn_mfma_f32_32x32x16_bf16(a, b0, acc0, 0, 0, 0); acc1 = __builtin_amdgcn_mfma_f32_32x32x16_bf16(a, b1, acc1, 0, 0, 0);
    }
    unsigned char* img = ws + WS_KC + (size_t)kind * KC_KIND_BYTES;
#pragma unroll
    for (int r = 0; r < 16; ++r) { const int row = row0 + (r & 3) + 8 * (r >> 2) + 4 * hi, tile = row >> 6, key = row & 63;
#pragma unroll
        for (int h2 = 0; h2 < 2; ++h2) { const int d = r32 + 32 * h2; const float v = h2 ? acc1[r] : acc0[r];
            size_t off;
            if (kind == 0) off = (size_t)tile * 8192 + (d >> 3) * 1024 + key * 16 + (d & 7) * 2;
            else { const int k16 = key & 15; off = (size_t)tile * 8192 + (key >> 4) * 2048 + d * 32 + (8 * ((k16 >> 2) & 1) + 4 * (k16 >> 3) + (k16 & 3)) * 2; }
            *(bf16_t*)(img + off) = (bf16_t)f2bf(v); } }
}
__device__ __forceinline__ void ybin_row(const Params& p, int row, int lane) {
    unsigned char* ws = p.ws; const bf16_t* U = (const bf16_t*)(ws + WS_U); const bf16_t* CBG = (const bf16_t*)(ws + WS_CBG); bf16_t* AOY = (bf16_t*)(ws + WS_AOY);
    const int c = lane * 8;
    float u0[8], u1[8], u2[8];
    { const u32x4 w = *(const u32x4*)(U + (size_t)row * 512 + c); u2[0] = bflo(w.x); u2[1] = bfhi(w.x); u2[2] = bflo(w.y); u2[3] = bfhi(w.y); u2[4] = bflo(w.z); u2[5] = bfhi(w.z); u2[6] = bflo(w.w); u2[7] = bfhi(w.w); }
    if (row < MP) { const int t = row & (TS - 1);
        if (t >= 1) { const u32x4 w = *(const u32x4*)(U + (size_t)(row - 1) * 512 + c); u1[0] = bflo(w.x); u1[1] = bfhi(w.x); u1[2] = bflo(w.y); u1[3] = bfhi(w.y); u1[4] = bflo(w.z); u1[5] = bfhi(w.z); u1[6] = bflo(w.w); u1[7] = bfhi(w.w); }
        else {
#pragma unroll
            for (int j = 0; j < 8; ++j) u1[j] = 0.f; }
        if (t >= 2) { const u32x4 w = *(const u32x4*)(U + (size_t)(row - 2) * 512 + c); u0[0] = bflo(w.x); u0[1] = bfhi(w.x); u0[2] = bflo(w.y); u0[3] = bfhi(w.y); u0[4] = bflo(w.z); u0[5] = bfhi(w.z); u0[6] = bflo(w.w); u0[7] = bfhi(w.w); }
        else {
#pragma unroll
            for (int j = 0; j < 8; ++j) u0[j] = 0.f; }
    } else { const int bs = row - MP; const float* s0 = p.sconv + ((size_t)bs * 2) * 512 + c; const float* s1 = s0 + 512;
#pragma unroll
        for (int j = 0; j < 8; ++j) { u0[j] = s0[j]; u1[j] = s1[j]; } }
    const u32x4 wcb = *(const u32x4*)(CBG + (size_t)row * 512 + c);
    float cb[8] = {bflo(wcb.x), bfhi(wcb.x), bflo(wcb.y), bfhi(wcb.y), bflo(wcb.z), bfhi(wcb.z), bflo(wcb.w), bfhi(wcb.w)};
    float o[8];
#pragma unroll
    for (int j = 0; j < 8; ++j) o[j] = cb[j] * (p.conv_w[c + j] * u0[j] + p.conv_w[512 + c + j] * u1[j] + p.conv_w[1024 + c + j] * u2[j]);
    u32x4 w; w.x = pk2(o[0], o[1]); w.y = pk2(o[2], o[3]); w.z = pk2(o[4], o[5]); w.w = pk2(o[6], o[7]);
    *(u32x4*)(AOY + (size_t)row * 1024 + 512 + c) = w;
}
__device__ __forceinline__ void final_row(const Params& p, float* outbase, int row, int lane) {
    unsigned char* ws = p.ws; const bf16_t* O = (const bf16_t*)(ws + WS_O) + (size_t)row * 1024; const float* sq = (const float*)(ws + WS_SSQP) + (size_t)row * 16;
    float s = 0.f;
#pragma unroll
    for (int j = 0; j < 16; ++j) s += sq[j];
    const float rs = rsqrtf(s * (1.f / DM) + 1e-6f);
    const float* x = row < MP ? p.xp + (size_t)row * DM : p.xs + (size_t)(row - MP) * DM;
    float* y = row < MP ? outbase + O_YP + (size_t)row * DM : outbase + O_YS + (size_t)(row - MP) * DM;
    const float* gate = (const float*)(ws + WS_MOD) + (size_t)(row < MP ? (row >> 13) : 2 + (row - MP)) * 3072 + 2048;
#pragma unroll
    for (int j = 0; j < 4; ++j) { const int k = j * 256 + lane * 4; const u32x2 ow = *(const u32x2*)(O + k); const f32x4 xv = *(const f32x4*)(x + k), ov = {bflo(ow.x), bfhi(ow.x), bflo(ow.y), bfhi(ow.y)}, gv = *(const f32x4*)(gate + k), gp = *(const f32x4*)(p.g_post + k);
        *(f32x4*)(y + k) = xv + gv * ov * rs * gp; }
}
namespace att {
constexpr int L_K = 0, L_V = 16384, L_GS = 32768, L_LS = 65536, L_SELM = 98304, L_WSF = 99328, L_UN = 101376, L_Q = 101632, L_END = 134400;
typedef short s16x4 __attribute__((ext_vector_type(4)));
typedef LAS const unsigned char* lptr;
__device__ __forceinline__ int crow(int r, int hi) { return (r & 3) + 8 * (r >> 2) + 4 * hi; }
__device__ __forceinline__ s16x4 vtr(lptr p) { return __builtin_bit_cast(s16x4, __builtin_amdgcn_ds_read_tr16_b64_v4i16((LAS s16x4*)p)); }
__device__ __forceinline__ float half_swap_max(float m) { auto rr = __builtin_amdgcn_permlane32_swap(__float_as_uint(m), __float_as_uint(m), false, false); return fmaxf(__uint_as_float(rr[0]), __uint_as_float(rr[1])); }
__device__ __forceinline__ float half_swap_sum(float m) { auto rr = __builtin_amdgcn_permlane32_swap(__float_as_uint(m), __float_as_uint(m), false, false); return __uint_as_float(rr[0]) + __uint_as_float(rr[1]); }
__device__ __forceinline__ unsigned cvtpk(float lo, float hi) { typedef __bf16 bf16x2_t __attribute__((ext_vector_type(2))); f32x2 v = {lo, hi}; bf16x2_t b = __builtin_convertvector(v, bf16x2_t); return __builtin_bit_cast(unsigned, b); }
__device__ __forceinline__ float quad_sum(float v) { v += __shfl_xor(v, 1); v += __shfl_xor(v, 2); return v; }

struct Tile16 { u32x4 k, v; };
__device__ __forceinline__ void qkt(f32x16& p0, f32x16& p1, lptr kslot, const LAS bf16x8* qr, int r32, int hi) {
    lptr kb = kslot + hi * 1024 + r32 * 16;
    p0 = f32x16{}; p1 = f32x16{};
#pragma unroll
    for (int d0 = 0; d0 < 4; ++d0) {
        const bf16x8 b0 = *(const LAS bf16x8*)(kb + d0 * 2048), b1 = *(const LAS bf16x8*)(kb + d0 * 2048 + 512);
        const bf16x8 qf = qr[d0 * 64]; p0 = __builtin_amdgcn_mfma_f32_32x32x16_bf16(b0, qf, p0, 0, 0, 0); p1 = __builtin_amdgcn_mfma_f32_32x32x16_bf16(b1, qf, p1, 0, 0, 0);
    }
}
__device__ __forceinline__ void pv(f32x16* o, lptr vslot, const f32x16& p0, const f32x16& p1, int lane, int hi) {
    u32x4 pw[4];
    pw[0] = (u32x4){cvtpk(p0[0], p0[1]), cvtpk(p0[2], p0[3]), cvtpk(p0[4], p0[5]), cvtpk(p0[6], p0[7])};
    pw[1] = (u32x4){cvtpk(p0[8], p0[9]), cvtpk(p0[10], p0[11]), cvtpk(p0[12], p0[13]), cvtpk(p0[14], p0[15])};
    pw[2] = (u32x4){cvtpk(p1[0], p1[1]), cvtpk(p1[2], p1[3]), cvtpk(p1[4], p1[5]), cvtpk(p1[6], p1[7])};
    pw[3] = (u32x4){cvtpk(p1[8], p1[9]), cvtpk(p1[10], p1[11]), cvtpk(p1[12], p1[13]), cvtpk(p1[14], p1[15])};
    lptr vp = vslot + ((lane >> 4) & 1) * 32 + (lane & 3) * 8 + (4 * hi + ((lane & 15) >> 2)) * 64;
#pragma unroll
    for (int d0 = 0; d0 < 2; ++d0)
#pragma unroll
        for (int ks = 0; ks < 4; ++ks) {
            const s16x4 lo = vtr(vp + d0 * 4096 + ks * 1024), hh = vtr(vp + d0 * 4096 + ks * 1024 + 512);
            const bf16x8 vf = (bf16x8){lo[0], lo[1], lo[2], lo[3], hh[0], hh[1], hh[2], hh[3]};
            o[d0] = __builtin_amdgcn_mfma_f32_32x32x16_bf16(__builtin_bit_cast(bf16x8, pw[ks]), vf, o[d0], 0, 0, 0);
        }
}
__device__ __forceinline__ void mask_range(f32x16& p0, f32x16& p1, int lo, int hi_, int hi) {
    const int lo2 = lo - 4 * hi, hi2 = hi_ - 4 * hi;
#pragma unroll
    for (int r = 0; r < 16; ++r) { const int c = (r & 3) + 8 * (r >> 2);
        p0[r] = (c >= lo2 && c <= hi2) ? p0[r] : -INFINITY; p1[r] = (c + 32 >= lo2 && c + 32 <= hi2) ? p1[r] : -INFINITY; }
}
__device__ __forceinline__ void mask_rows(f32x16& p0, f32x16& p1, float bias) {
#pragma unroll
    for (int r = 0; r < 16; ++r) { p0[r] += bias; p1[r] += bias; }
}
__device__ __forceinline__ void online_step(f32x16& p0, f32x16& p1, float& m, float& l, f32x16* o, LAS float* wsf, int r32, int hi, bool en = true) {
    float rm = p0[0];
#pragma unroll
    for (int r = 1; r < 16; ++r) rm = fmaxf(rm, p0[r]);
#pragma unroll
    for (int r = 0; r < 16; ++r) rm = fmaxf(rm, p1[r]);
    rm = half_swap_max(rm);
    rm = en ? rm : -INFINITY;
    const bool need = __any(rm - m > 8.f);
    const float mn = need ? fmaxf(m, rm) : m;
    const float alpha = need ? __builtin_amdgcn_exp2f(m - mn) : 1.f;
    const float msub = en ? mn : INFINITY;
    float s = 0.f;
#pragma unroll
    for (int r = 0; r < 16; ++r) { p0[r] = __builtin_amdgcn_exp2f(p0[r] - msub); p1[r] = __builtin_amdgcn_exp2f(p1[r] - msub); s += p0[r] + p1[r]; }
    l = l * alpha + s; m = mn;
    if (need) {
        if (hi == 0) wsf[r32] = alpha;
        asm volatile("s_waitcnt lgkmcnt(0)" ::: "memory");
#pragma unroll
        for (int r = 0; r < 16; ++r) { const float a = wsf[crow(r, hi)]; o[0][r] *= a; o[1][r] *= a; }
    }
}
template <int MODE  >
__device__ __forceinline__ void accum_lds(LAS float* ot0, LAS float* ot1, const f32x16* o, float coef, LAS float* wsf, int lane, int r32, int hi) {
    if (hi == 0) wsf[32 + r32] = coef;
    asm volatile("s_waitcnt lgkmcnt(0)" ::: "memory");
#pragma unroll
    for (int r = 0; r < 16; ++r) { const float a = wsf[32 + crow(r, hi)];
        if (MODE == 0) { ot0[r * 64 + lane] = a * o[0][r]; ot1[r * 64 + lane] = a * o[1][r]; }
        else { ot0[r * 64 + lane] += a * o[0][r]; ot1[r * 64 + lane] += a * o[1][r]; } }
}
__device__ __forceinline__ unsigned pick4(unsigned a0, unsigned a1, unsigned a2, unsigned a3, int i) { unsigned r = a0; r = (i == 1) ? a1 : r; r = (i == 2) ? a2 : r; r = (i == 3) ? a3 : r; return r; }
__device__ __forceinline__ int next_bit(unsigned u0, unsigned u1, unsigned u2, unsigned u3, int j, int jmax) {
    while (j <= jmax) { const unsigned w = pick4(u0, u1, u2, u3, j >> 5) >> (j & 31); if (w) { j += __builtin_ctz(w); return j <= jmax ? j : jmax + 1; } j = (j | 31) + 1; }
    return jmax + 1;
}

__device__ __forceinline__ void loadK(bf16x8 (&kf)[8], const unsigned char* tile, unsigned koff) {
#pragma unroll
    for (int d0 = 0; d0 < 4; ++d0) { kf[2 * d0] = *(const bf16x8*)(tile + koff + d0 * 2048); kf[2 * d0 + 1] = *(const bf16x8*)(tile + koff + d0 * 2048 + 512); }
}
__device__ __forceinline__ void loadV(bf16x8 (&vf)[8], const unsigned char* tile, unsigned voff) {
#pragma unroll
    for (int d0 = 0; d0 < 2; ++d0)
#pragma unroll
        for (int ks = 0; ks < 4; ++ks) vf[d0 * 4 + ks] = *(const bf16x8*)(tile + voff + ks * 2048 + d0 * 1024);
}
__device__ __forceinline__ void qkt_reg(f32x16& p0, f32x16& p1, const bf16x8 (&kf)[8], const LAS bf16x8* qr) {
    p0 = f32x16{}; p1 = f32x16{};
    bf16x8 qf[4];
#pragma unroll
    for (int d0 = 0; d0 < 4; ++d0) qf[d0] = qr[d0 * 64];
    __builtin_amdgcn_sched_barrier(0);
#pragma unroll
    for (int d0 = 0; d0 < 4; ++d0) {
        p0 = __builtin_amdgcn_mfma_f32_32x32x16_bf16(kf[2 * d0], qf[d0], p0, 0, 0, 0); p1 = __builtin_amdgcn_mfma_f32_32x32x16_bf16(kf[2 * d0 + 1], qf[d0], p1, 0, 0, 0); }
}
__device__ __forceinline__ void pv_reg(f32x16* o, const bf16x8 (&vf)[8], const f32x16& p0, const f32x16& p1) {
    u32x4 pw[4];
    pw[0] = (u32x4){cvtpk(p0[0], p0[1]), cvtpk(p0[2], p0[3]), cvtpk(p0[4], p0[5]), cvtpk(p0[6], p0[7])};
    pw[1] = (u32x4){cvtpk(p0[8], p0[9]), cvtpk(p0[10], p0[11]), cvtpk(p0[12], p0[13]), cvtpk(p0[14], p0[15])};
    pw[2] = (u32x4){cvtpk(p1[0], p1[1]), cvtpk(p1[2], p1[3]), cvtpk(p1[4], p1[5]), cvtpk(p1[6], p1[7])};
    pw[3] = (u32x4){cvtpk(p1[8], p1[9]), cvtpk(p1[10], p1[11]), cvtpk(p1[12], p1[13]), cvtpk(p1[14], p1[15])};
#pragma unroll
    for (int d0 = 0; d0 < 2; ++d0)
#pragma unroll
        for (int ks = 0; ks < 4; ++ks) o[d0] = __builtin_amdgcn_mfma_f32_32x32x16_bf16(__builtin_bit_cast(bf16x8, pw[ks]), vf[d0 * 4 + ks], o[d0], 0, 0, 0);
}

__device__ __forceinline__ void prompt_unit(const Params& p, const Frame& F, int b, int g, int cur, int tg) {
    unsigned char* ws = p.ws; LAS unsigned char* lds = F.lds;
    const int lane = F.lane, wid = F.wave, r32 = lane & 31, hi = lane >> 5;
    const int bg = b * 2 + g, t0 = cur * 64, tokl = 8 * tg + (r32 >> 2), head = r32 & 3, t = t0 + tokl;
    const size_t grow = (size_t)b * TS + t;
    LAS float* wsf = (LAS float*)(lds + L_WSF) + wid * 64;
    LAS float* GS = (LAS float*)(lds + L_GS); LAS float* LS = (LAS float*)(lds + L_LS);
    LAS bf16x8* qr = (LAS bf16x8*)(lds + L_Q + wid * 4096) + hi * 32 + r32;
    { const bf16_t* qp = (const bf16_t*)(ws + WS_QB) + grow * 512 + (g * 4 + head) * 64 + hi * 8;
#pragma unroll
      for (int d0 = 0; d0 < 4; ++d0) qr[d0 * 64] = *(const bf16x8*)(qp + d0 * 16); }
    const float* ngp = (const float*)(ws + WS_NG) + grow * 32 + g * 12 + head * 3;
    const float g_cmp = ngp[0], g_sel = ngp[1], g_win = ngp[2];
    f32x16 o[2]; f32x16 p0, p1;
    LAS float* ot0 = GS + wid * 1024; LAS float* ot1 = LS + wid * 1024;
    const unsigned char* kc_img = ws + WS_KC + (size_t)(512 + bg * 8) * 8192;
    const unsigned char* vc_img = ws + WS_KC + KC_KIND_BYTES + (size_t)(512 + bg * 8) * 8192;
    const unsigned char* ks_img = ws + WS_KVI + (size_t)(0 * 4 + bg) * 128 * 8192;
    const unsigned char* vs_img = ws + WS_KVI + (size_t)(1 * 4 + bg) * 128 * 8192;
    const unsigned char* kw_img = ws + WS_KVI + (size_t)(2 * 4 + bg) * 128 * 8192;
    const unsigned char* vw_img = ws + WS_KVI + (size_t)(3 * 4 + bg) * 128 * 8192;
    unsigned koff = (unsigned)(hi * 1024 + r32 * 16), voff = (unsigned)(r32 * 32 + hi * 16);
    asm volatile("" : "+v"(koff), "+v"(voff));
    bf16x8 kf[8], vf[8];
    const int cmaxl = (t >= 31) ? ((t - 31) >> 4) : -1;
    const int nct = (4 * cur + 3 + 63) >> 6;
    float m = -1e30f, l = 0.f;
    loadK(kf, kc_img, koff);
#pragma unroll 1
    for (int ct = 0; ct < nct; ++ct) {
        qkt_reg(p0, p1, kf, qr);
        loadK(kf, kc_img + (size_t)(ct + 1 < nct ? ct + 1 : ct) * 8192, koff);
        mask_range(p0, p1, 0, cmaxl - 64 * ct, hi);
        float rm = p0[0];
#pragma unroll
        for (int r = 1; r < 16; ++r) rm = fmaxf(rm, p0[r]);
#pragma unroll
        for (int r = 0; r < 16; ++r) rm = fmaxf(rm, p1[r]);
        rm = half_swap_max(rm);
        const float mn = fmaxf(m, rm); float s = 0.f;
#pragma unroll
        for (int r = 0; r < 16; ++r) s += __builtin_amdgcn_exp2f(p0[r] - mn) + __builtin_amdgcn_exp2f(p1[r] - mn);
        l = l * __builtin_amdgcn_exp2f(m - mn) + s; m = mn;
    }
    l = half_swap_sum(l);
    const float linv = 1.f / fmaxf(l, 1e-30f);
    o[0] = f32x16{}; o[1] = f32x16{};
    loadK(kf, kc_img, koff);
#pragma unroll 1
    for (int ct = 0; ct < nct; ++ct) {
        loadV(vf, vc_img + (size_t)ct * 8192, voff);
        qkt_reg(p0, p1, kf, qr);
        loadK(kf, kc_img + (size_t)(ct + 1 < nct ? ct + 1 : ct) * 8192, koff);
        mask_range(p0, p1, 0, cmaxl - 64 * ct, hi);
#pragma unroll
        for (int r = 0; r < 16; ++r) { p0[r] = __builtin_amdgcn_exp2f(p0[r] - m) * linv; p1[r] = __builtin_amdgcn_exp2f(p1[r] - m) * linv; }
#pragma unroll
        for (int q = 0; q < 4; ++q) {
            const float ga = quad_sum((p0[4 * q] + p0[4 * q + 1]) + (p0[4 * q + 2] + p0[4 * q + 3])), la = quad_sum(p0[4 * q + 3]);
            const float gb = quad_sum((p1[4 * q] + p1[4 * q + 1]) + (p1[4 * q + 2] + p1[4 * q + 3])), lb = quad_sum(p1[4 * q + 3]);
            const int j = 16 * ct + 2 * q + hi;
            if (head == 0) { const int lrow = 8 * wid + (r32 >> 2); GS[lrow * 128 + j] = ga; LS[lrow * 128 + j] = la; GS[lrow * 128 + j + 8] = gb; LS[lrow * 128 + j + 8] = lb; }
        }
        pv_reg(o, vf, p0, p1);
    }
    asm volatile("s_waitcnt lgkmcnt(0)" ::: "memory");
#pragma unroll 4
    for (int i = 0; i < 16; ++i) { const int e = (8 * wid) * 128 + i * 64 + lane, j = e & 127;
        float sc; if (j == 0 || j == cur || j == cur - 1) sc = 1e6f; else if (j <= cur) sc = GS[e] + LS[e - 1]; else sc = -1.f;
        GS[e] = sc; }
    asm volatile("s_waitcnt lgkmcnt(0)" ::: "memory");
    unsigned wm0 = 0, wm1 = 0, wm2 = 0, wm3 = 0, sm0 = 0, sm1 = 0, sm2 = 0, sm3 = 0;
#pragma unroll 1
    for (int tk = 0; tk < 8; ++tk) { const int tok = 8 * wid + tk; const LAS float* sp = GS + tok * 128;
        const unsigned va = __float_as_uint(fmaxf(sp[lane], 0.f)), vb = __float_as_uint(fmaxf(sp[lane + 64], 0.f));
        unsigned T = 0;
#pragma unroll 1
        for (int bit = 30; bit >= 0; --bit) { const unsigned cand = T | (1u << bit);
            const int cnt = __builtin_popcountll(__ballot(va >= cand)) + __builtin_popcountll(__ballot(vb >= cand));
            T = cnt >= 16 ? cand : T; }
        unsigned long long ma = __ballot(va > T), mb = __ballot(vb > T);
        unsigned long long ea = __ballot(va == T), eb = __ballot(vb == T);
        int need = 16 - (__builtin_popcountll(ma) + __builtin_popcountll(mb));
#pragma unroll 1
        while (need > 0 && ea) { ma |= ea & (0ull - ea); ea &= ea - 1; --need; }
#pragma unroll 1
        while (need > 0 && eb) { mb |= eb & (0ull - eb); eb &= eb - 1; --need; }
        const unsigned a0 = (unsigned)ma, a1 = (unsigned)(ma >> 32), b0 = (unsigned)mb, b1 = (unsigned)(mb >> 32);
        if ((r32 >> 2) == tk) { sm0 = a0; sm1 = a1; sm2 = b0; sm3 = b1; }
        wm0 |= a0; wm1 |= a1; wm2 |= b0; wm3 |= b1; }
    wm0 = __builtin_amdgcn_readfirstlane(wm0); wm1 = __builtin_amdgcn_readfirstlane(wm1); wm2 = __builtin_amdgcn_readfirstlane(wm2); wm3 = __builtin_amdgcn_readfirstlane(wm3);
    asm volatile("s_waitcnt lgkmcnt(0)" ::: "memory");
    accum_lds<0>(ot0, ot1, o, g_cmp, wsf, lane, r32, hi);
    m = -1e30f; l = 0.f; o[0] = f32x16{}; o[1] = f32x16{};
    {
        int j = next_bit(wm0, wm1, wm2, wm3, 0, cur);
        if (j <= cur) loadK(kf, ks_img + (size_t)j * 8192, koff);
#pragma unroll 1
        while (j <= cur) {
            loadV(vf, vs_img + (size_t)j * 8192, voff);
            qkt_reg(p0, p1, kf, qr);
            const int jn = next_bit(wm0, wm1, wm2, wm3, j + 1, cur);
            loadK(kf, ks_img + (size_t)(jn <= cur ? jn : j) * 8192, koff);
            const bool en = (pick4(sm0, sm1, sm2, sm3, j >> 5) >> (j & 31)) & 1u;
            if (j == cur) mask_range(p0, p1, 0, tokl, hi);
            online_step(p0, p1, m, l, o, wsf, r32, hi, en);
            pv_reg(o, vf, p0, p1);
            j = jn;
        }
    }
    l = half_swap_sum(l);
    accum_lds<1>(ot0, ot1, o, g_sel / fmaxf(l, 1e-30f), wsf, lane, r32, hi);
    m = -1e30f; l = 0.f; o[0] = f32x16{}; o[1] = f32x16{};
    {
        const int j0 = cur >= 8 ? cur - 8 : 0;
        loadK(kf, kw_img + (size_t)j0 * 8192, koff);
#pragma unroll 1
        for (int j = j0; j <= cur; ++j) {
            loadV(vf, vw_img + (size_t)j * 8192, voff);
            qkt_reg(p0, p1, kf, qr);
            loadK(kf, kw_img + (size_t)(j < cur ? j + 1 : j) * 8192, koff);
            if (j == cur - 8 || j == cur) { const int lo = (j == cur - 8) ? tokl + 1 : 0, hh = (j == cur) ? tokl : 63; mask_range(p0, p1, lo, hh, hi); }
            online_step(p0, p1, m, l, o, wsf, r32, hi);
            pv_reg(o, vf, p0, p1);
        }
    }
    l = half_swap_sum(l);
    accum_lds<1>(ot0, ot1, o, g_win / fmaxf(l, 1e-30f), wsf, lane, r32, hi);
    asm volatile("s_waitcnt lgkmcnt(0)" ::: "memory");
    { const size_t rowb = (size_t)b * TS + t0 + 8 * tg + hi;
      const bf16_t* sab = (const bf16_t*)(ws + WS_SA) + rowb * 512 + g * 256 + r32; bf16_t* aob = (bf16_t*)(ws + WS_AOY) + rowb * 1024 + g * 256 + r32;
#pragma unroll
      for (int r = 0; r < 16; ++r)
#pragma unroll
        for (int d0 = 0; d0 < 2; ++d0) { const int co = (r & 3) * 64 + d0 * 32;
            aob[(2 * (r >> 2)) * 1024 + co] = (bf16_t)f2bf((d0 ? ot1 : ot0)[r * 64 + lane] * bf2f(sab[(2 * (r >> 2)) * 512 + co])); } }
}

__device__ __forceinline__ float row16_sum(float v) {
    v += __builtin_bit_cast(float, __builtin_amdgcn_update_dpp(0, __builtin_bit_cast(int, v), 0x128, 0xF, 0xF, false));
    v += __builtin_bit_cast(float, __builtin_amdgcn_update_dpp(0, __builtin_bit_cast(int, v), 0x124, 0xF, 0xF, false));
    v += __builtin_bit_cast(float, __builtin_amdgcn_update_dpp(0, __builtin_bit_cast(int, v), 0x122, 0xF, 0xF, false));
    v += __builtin_bit_cast(float, __builtin_amdgcn_update_dpp(0, __builtin_bit_cast(int, v), 0x121, 0xF, 0xF, false));
    return v; }
template <int PART  >
__device__ __forceinline__ void sample_unit(const Params& p, const Frame& F, int bs) {
    unsigned char* ws = p.ws;
    const int lane = F.lane, g = F.wave >> 2, wid = F.wave & 3, tid = F.tid & 255;
    LAS unsigned char* lds = F.lds + g * 40960;
    LAS float* q = (LAS float*)lds; LAS float* sc = (LAS float*)(lds + 1024); LAS float* impv = (LAS float*)(lds + 1024 + 4 * 1664 * 4);
    LAS int* sel = (LAS int*)(impv + 64); LAS float* osum = (LAS float*)(sel + 16);
    const size_t row = (size_t)MP + bs;
    __syncthreads();
    q[tid] = bf2f(((const bf16_t*)(ws + WS_QB))[row * 512 + g * 256 + tid]);
    __syncthreads();
    const int bg = bs * 2 + g;
    if (PART == 0) { const int c = tid & 127, hp = tid >> 7;
      float s0 = 0.f, s1 = 0.f;
      const unsigned char* img = ws + WS_KC + (size_t)(bg * 2 + (c >> 6)) * 8192; const int key = c & 63;
      u32x4 w[8];
#pragma unroll
      for (int ch = 0; ch < 8; ++ch) w[ch] = *(const u32x4*)(img + ch * 1024 + key * 16);
#pragma unroll
      for (int ch = 0; ch < 8; ++ch) { const float kf[8] = {bflo(w[ch].x), bfhi(w[ch].x), bflo(w[ch].y), bfhi(w[ch].y), bflo(w[ch].z), bfhi(w[ch].z), bflo(w[ch].w), bfhi(w[ch].w)};
#pragma unroll
          for (int e = 0; e < 8; ++e) { s0 += q[(2 * hp) * 64 + ch * 8 + e] * kf[e]; s1 += q[(2 * hp + 1) * 64 + ch * 8 + e] * kf[e]; } }
      sc[(2 * hp) * 1664 + c] = c < 127 ? s0 : -INFINITY; sc[(2 * hp + 1) * 1664 + c] = c < 127 ? s1 : -INFINITY; }
    const int kq_s = lane >> 4, d4_s = lane & 15;
    f32x4 qh[4];
#pragma unroll
    for (int h = 0; h < 4; ++h) qh[h] = *(const LAS f32x4*)(q + h * 64 + 4 * d4_s);
    if (PART == 1) {
        const float* ks = p.swin + ((size_t)bs * 512 + 1) * 256 + g * 64 + 4 * d4_s; const float* kn = p.out + O_WINS + ((size_t)bs * 512 + 511) * 256 + g * 64 + 4 * d4_s;
#pragma unroll
        for (int hb = 0; hb < 2; ++hb) { asm volatile("" ::: "memory"); f32x4 kv[16];
#pragma unroll
            for (int it = 0; it < 16; ++it) { const int i = 128 * wid + 4 * (16 * hb + it) + kq_s; kv[it] = *(const f32x4*)(i < 511 ? ks + (size_t)i * 256 : kn); }
#pragma unroll
            for (int it = 0; it < 16; ++it) { const int i = 128 * wid + 4 * (16 * hb + it) + kq_s; float sv = 0.f;
#pragma unroll
                for (int h = 0; h < 4; ++h) { const float d = row16_sum((qh[h][0] * kv[it][0] + qh[h][1] * kv[it][1]) + (qh[h][2] * kv[it][2] + qh[h][3] * kv[it][3])); sv = (d4_s == h) ? d : sv; }
                if (d4_s < 4) sc[d4_s * 1664 + 1152 + i] = sv; } }
    }
    __syncthreads();
    auto softmax_head = [&](int off, int n) {
        { LAS float* sp = sc + wid * 1664 + off; float mx = -INFINITY;
            for (int i = lane; i < n; i += 64) mx = fmaxf(mx, sp[i]);
#pragma unroll
            for (int o2 = 1; o2 < 64; o2 <<= 1) mx = fmaxf(mx, __shfl_xor(mx, o2));
            float sm = 0.f;
            for (int i = lane; i < n; i += 64) { const float e = __builtin_amdgcn_exp2f(sp[i] - mx); sp[i] = e; sm += e; }
            sm = wave_sum(sm); const float inv = 1.f / fmaxf(sm, 1e-30f);
            for (int i = lane; i < n; i += 64) sp[i] *= inv; }
        __syncthreads();
    };
    if (PART == 1) softmax_head(1152, 512);
    if (PART == 0) {
    softmax_head(0, 128);
    if (tid < 64) { float s = -1.f; const int j = tid;
        if (j < 33) { s = 0.f; for (int c = 4 * j - 1; c <= 4 * j + 3; ++c) if (c >= 0 && c < 127) s += (sc[c] + sc[1664 + c]) + (sc[2 * 1664 + c] + sc[3 * 1664 + c]);
            if (j == 0 || j == 31 || j == 32) s = 1e6f; }
        impv[j] = j < 33 ? s : -2.f; }
    __syncthreads();
    if (tid < 64) { const float sj = impv[tid]; int rk = 0; for (int i = 0; i < 33; ++i) { const float v = impv[i]; rk += (v > sj || (v == sj && i < tid)) ? 1 : 0; }
        if (tid < 33 && rk < 16) sel[rk] = tid; }
    __syncthreads();
#pragma unroll 1
    for (int rr = 0; rr < 4; ++rr) { const int r = 4 * wid + rr, j = sel[r];
        const float* kb = j < 32 ? p.cache + (((size_t)p.ptab[bs * 16 + (j >> 1)] * 128 + (j & 1) * 64) * 4 + 2) * 128 + g * 64 + 4 * d4_s : p.out + O_KVS + ((size_t)bs * 4 + 2) * 128 + g * 64 + 4 * d4_s;
        f32x4 kv[16];
#pragma unroll
        for (int it = 0; it < 16; ++it) kv[it] = *(const f32x4*)(kb + (j < 32 ? (size_t)(4 * it + kq_s) * 512 : 0));
#pragma unroll
        for (int it = 0; it < 16; ++it) { const int i = 4 * it + kq_s; float sv = 0.f;
#pragma unroll
            for (int h = 0; h < 4; ++h) { const float d = row16_sum((qh[h][0] * kv[it][0] + qh[h][1] * kv[it][1]) + (qh[h][2] * kv[it][2] + qh[h][3] * kv[it][3])); sv = (d4_s == h) ? d : sv; }
            if (d4_s < 4) sc[d4_s * 1664 + 128 + r * 64 + i] = (j < 32 || i == 0) ? sv : -INFINITY; } }
    __syncthreads();
    softmax_head(128, 1024);
    }
    const float* ngp = (const float*)(ws + WS_NG) + row * 32 + g * 12;
    const int kq = lane >> 4, d4 = lane & 15;
    f32x4 tot[4]; f32x4 br[4];
#pragma unroll
    for (int h = 0; h < 4; ++h) { tot[h] = (f32x4){0.f, 0.f, 0.f, 0.f}; br[h] = tot[h]; }
    if (PART == 0) {
#pragma unroll
    for (int it = 0; it < 8; ++it) { const int c = 32 * wid + 4 * it + kq; const unsigned char* img = ws + WS_KC + KC_KIND_BYTES + (size_t)(bg * 2 + (c >> 6)) * 8192; const int key = c & 63, d = 4 * d4;
        const int k16 = key & 15, pp = 8 * ((k16 >> 2) & 1) + 4 * (k16 >> 3) + (k16 & 3); const unsigned char* vp_ = img + (key >> 4) * 2048 + d * 32 + pp * 2;
        const f32x4 v = {bf2f(*(const bf16_t*)vp_), bf2f(*(const bf16_t*)(vp_ + 32)), bf2f(*(const bf16_t*)(vp_ + 64)), bf2f(*(const bf16_t*)(vp_ + 96))};
#pragma unroll
        for (int h = 0; h < 4; ++h) br[h] += sc[h * 1664 + c] * v; }
#pragma unroll
    for (int h = 0; h < 4; ++h) { tot[h] += ngp[h * 3] * br[h]; br[h] = (f32x4){0.f, 0.f, 0.f, 0.f}; }
    { const float* vbs[4]; int jj[4];
#pragma unroll
      for (int rr = 0; rr < 4; ++rr) { const int r = 4 * wid + rr; jj[rr] = sel[r]; const int jc = jj[rr] < 32 ? jj[rr] : 0;
          vbs[rr] = p.cache + (((size_t)p.ptab[bs * 16 + (jc >> 1)] * 128 + (jc & 1) * 64) * 4 + 3) * 128 + g * 64 + 4 * d4; }
#pragma unroll
      for (int rr = 0; rr < 4; ++rr) { const int r = 4 * wid + rr;
          asm volatile("" ::: "memory");
          if (jj[rr] < 32) {
              f32x4 v[16];
#pragma unroll
              for (int it = 0; it < 16; ++it) v[it] = *(const f32x4*)(vbs[rr] + (size_t)(4 * it + kq) * 512);
#pragma unroll
              for (int it = 0; it < 16; ++it) { const int i = 4 * it + kq;
#pragma unroll
                  for (int h = 0; h < 4; ++h) br[h] += sc[h * 1664 + 128 + r * 64 + i] * v[it]; } }
          else if (kq == 0) { const f32x4 v = *(const f32x4*)(p.out + O_KVS + ((size_t)bs * 4 + 3) * 128 + g * 64 + 4 * d4);
#pragma unroll
              for (int h = 0; h < 4; ++h) br[h] += sc[h * 1664 + 128 + r * 64] * v; } } }
#pragma unroll
    for (int h = 0; h < 4; ++h) { tot[h] += ngp[h * 3 + 1] * br[h]; br[h] = (f32x4){0.f, 0.f, 0.f, 0.f}; }
    }
    if (PART == 1) { const float* vbs = p.swin + ((size_t)bs * 512 + 1) * 256 + 128 + g * 64 + 4 * d4; const float* vbn = p.out + O_WINS + ((size_t)bs * 512 + 511) * 256 + 128 + g * 64 + 4 * d4;
#pragma unroll
      for (int hb = 0; hb < 2; ++hb) { asm volatile("" ::: "memory"); f32x4 v[16];
#pragma unroll
          for (int it = 0; it < 16; ++it) { const int i = 128 * wid + 4 * (16 * hb + it) + kq; v[it] = *(const f32x4*)(i < 511 ? vbs + (size_t)i * 256 : vbn); }
#pragma unroll
          for (int it = 0; it < 16; ++it) { const int i = 4 * (16 * hb + it) + kq;
#pragma unroll
              for (int h = 0; h < 4; ++h) br[h] += sc[h * 1664 + 1152 + 128 * wid + i] * v[it]; } } }
#pragma unroll
    for (int h = 0; h < 4; ++h) { tot[h] += ngp[h * 3 + 2] * br[h];
#pragma unroll
        for (int e = 0; e < 4; ++e) { float x = tot[h][e]; x += __shfl_xor(x, 16); x += __shfl_xor(x, 32); tot[h][e] = x; } }
    if (kq == 0) {
#pragma unroll
        for (int h = 0; h < 4; ++h) *(LAS f32x4*)(osum + (wid * 4 + h) * 64 + 4 * d4) = tot[h]; }
    __syncthreads();
    { const int h = tid >> 6, d = tid & 63; float s = 0.f;
#pragma unroll
        for (int w = 0; w < 4; ++w) s += osum[(w * 4 + h) * 64 + d];
        const int col = (g * 4 + h) * 64 + d;
        ((float*)(ws + WS_SPART))[((size_t)PART * 128 + bs) * 512 + col] = s; }
}
}
#define XB_TMO      128
#define XB_XCNT(j)  (256  + 64 * (j))
#define XB_XSUB(j)  (1280 + 64 * (j))
#define XB_XGEN(j)  (2304 + 64 * (j))
#define XB_TOP      3328
#define XB_TOPGEN   3392
#define XCD_BAR_WORDS 3456
#define XB_SPIN_CAP (1u << 22)
__device__ __forceinline__ unsigned xb_ld(unsigned* p)              { return __hip_atomic_load(p, __ATOMIC_RELAXED, __HIP_MEMORY_SCOPE_AGENT); }
__device__ __forceinline__ unsigned xb_add(unsigned* p, unsigned v) { return __hip_atomic_fetch_add(p, v, __ATOMIC_RELAXED, __HIP_MEMORY_SCOPE_AGENT); }
__device__ __forceinline__ unsigned xb_xcc_id() { return (unsigned)__builtin_amdgcn_s_getreg((3 << 11) | 20) & 0xFu; }
#define XB_SPIN(cond, bar) do { unsigned _sp = 0; while (cond) { __builtin_amdgcn_s_sleep(1); \
    if ((++_sp & 255u) == 0u) { if (xb_ld(&(bar)[XB_TMO])) break; if (_sp > XB_SPIN_CAP) { atomicAdd(&(bar)[XB_TMO], 1u); break; } } } } while (0)
struct XcdBarrier { unsigned* bar; unsigned x; volatile LAS unsigned* st; };
__device__ __forceinline__ XcdBarrier xcd_barrier_post(unsigned* bar, volatile LAS unsigned* st) {
    XcdBarrier b; b.bar = bar; b.x = xb_xcc_id(); b.st = st;
    if (threadIdx.x == 0) (void)xb_add(&bar[XB_XCNT(b.x)], 1u);
    return b;
}
__device__ __forceinline__ void xcd_barrier_complete(unsigned* bar, unsigned x, unsigned& nloc, unsigned& nx) {
    const unsigned G = gridDim.x * gridDim.y * gridDim.z;
    unsigned sum, cnt, mine, sp = 0u;
    for (;;) {
        sum = 0u; cnt = 0u; mine = 0u;
#pragma unroll
        for (unsigned j = 0; j < 16; ++j) { const unsigned c = xb_ld(&bar[XB_XCNT(j)]); sum += c; cnt += (c > 0u) ? 1u : 0u; mine = (j == x) ? c : mine; }
        if (sum == G) break;
        __builtin_amdgcn_s_sleep(1);
        if ((++sp & 255u) == 0u) { if (xb_ld(&bar[XB_TMO])) break; if (sp > XB_SPIN_CAP) { atomicAdd(&bar[XB_TMO], 1u); break; } }
    }
    nloc = mine > 0u ? mine : 1u; nx = cnt > 0u ? cnt : 1u;
}
__device__ __forceinline__ void xcd_barrier(const XcdBarrier& b) {
    asm volatile("s_waitcnt vmcnt(0)" ::: "memory");
    __syncthreads();
    if (threadIdx.x == 0) {
        unsigned* bar = b.bar;
        __builtin_amdgcn_s_waitcnt(0);
        unsigned nloc = b.st[0], nx = b.st[1];
        if (nloc == 0u) { xcd_barrier_complete(bar, b.x, nloc, nx); b.st[0] = nloc; b.st[1] = nx; }
        const unsigned old = xb_add(&bar[XB_XSUB(b.x)], 1u);
        const unsigned gen = old / nloc;
        if (old + 1u == (gen + 1u) * nloc) {
            __builtin_amdgcn_fence(__ATOMIC_RELEASE, "agent");
            asm volatile("s_waitcnt vmcnt(0)" ::: "memory");
            const unsigned og = xb_add(&bar[XB_TOP], 1u);
            const unsigned tg = og / nx;
            if (og + 1u == (tg + 1u) * nx) xb_add(&bar[XB_TOPGEN], 1u);
            else XB_SPIN(xb_ld(&bar[XB_TOPGEN]) == tg, bar);
            __builtin_amdgcn_fence(__ATOMIC_ACQUIRE, "agent");
            xb_add(&bar[XB_XGEN(b.x)], 1u);
            asm volatile("s_waitcnt vmcnt(0)" ::: "memory");
        } else {
            XB_SPIN(xb_ld(&bar[XB_XGEN(b.x)]) == gen, bar);
            __builtin_amdgcn_fence(__ATOMIC_ACQUIRE, "agent");
            asm volatile("s_waitcnt vmcnt(0)" ::: "memory");
        }
    }
    __syncthreads();
}
constexpr int LDS_MISC_OFF = 147200;

constexpr int LDS_BYTES = 147456;
constexpr int NPHASE = 8;

__global__ void __launch_bounds__(NTHR, 2) mk_fwd(Params p) {
    extern __shared__ __attribute__((aligned(16))) unsigned char lds_raw[];
    Frame F; F.lds = (LAS unsigned char*)lds_raw; F.tid = threadIdx.x; F.lane = F.tid & 63; F.wave = __builtin_amdgcn_readfirstlane(F.tid >> 6);
    F.G = gridDim.x; { const int bx = blockIdx.x; F.vcu = (F.G % 8 == 0) ? (bx % 8) * (F.G / 8) + bx / 8 : bx; }
    unsigned char* ws = p.ws;
    const int lo = p.ph_lo, hi = p.ph_hi;
    volatile LAS unsigned* misc = (volatile LAS unsigned*)(F.lds + LDS_MISC_OFF);
    if (F.tid < 2) misc[F.tid] = 0u;
    __syncthreads();
    XcdBarrier xbar; xbar.bar = (unsigned*)(ws + WS_CTL) + 4096; xbar.x = 0; xbar.st = misc;
    if (hi - lo > 1) xbar = xcd_barrier_post((unsigned*)(ws + WS_CTL) + 4096, misc);
#ifndef MK_PHASE_MASK
#define MK_PHASE_MASK 0xff
#endif
#define IN(k) (((MK_PHASE_MASK >> (k)) & 1) && lo <= (k) && (k) < hi)
#if defined(MK_TIMING)
    unsigned* tsw = (unsigned*)(ws + WS_CTL + (2u << 20));
#define TDONE(k) do { if (IN(k) && F.tid == 0) atomicMax(&tsw[16 + (k)], (unsigned)__builtin_amdgcn_s_memrealtime()); } while (0)
#define TSTART(k) do { if (blockIdx.x == 0 && F.tid == 0) tsw[(k)] = (unsigned)__builtin_amdgcn_s_memrealtime(); } while (0)
#else
#define TDONE(k) do { } while (0)
#define TSTART(k) do { } while (0)
#endif
#define SEAM(k) do { TDONE(k); if (IN(k) && IN((k) + 1)) { MK_GRID_SYNC(); } TSTART((k) + 1); } while (0)
#ifndef MK_GRID_SYNC
#define MK_GRID_SYNC() xcd_barrier(xbar)
#endif
#define PUBLISH(cp) do { asm volatile("s_waitcnt vmcnt(0)" ::: "memory"); __syncthreads(); \
        if (F.tid == 0) { __builtin_amdgcn_fence(__ATOMIC_RELEASE, "agent"); asm volatile("s_waitcnt vmcnt(0)" ::: "memory"); __hip_atomic_fetch_add((cp), 1u, __ATOMIC_RELAXED, __HIP_MEMORY_SCOPE_AGENT); } } while (0)
#define AWAIT(cp, n) do { if (F.tid == 0) { unsigned sp_ = 0; while (__hip_atomic_load((cp), __ATOMIC_RELAXED, __HIP_MEMORY_SCOPE_AGENT) < (unsigned)(n)) { __builtin_amdgcn_s_sleep(2); if (++sp_ > (1u << 22)) break; } \
            __builtin_amdgcn_fence(__ATOMIC_ACQUIRE, "agent"); asm volatile("s_waitcnt vmcnt(0)" ::: "memory"); } __syncthreads(); } while (0)
    unsigned* p34 = (unsigned*)(ws + WS_CTL + 57344);
    TSTART(0);
    if (IN(0)) { phase0(p, F); } SEAM(0);
    if (IN(1)) { phase1(p, F); } SEAM(1);
    if (IN(2)) {
        if (F.G != 256) { cache_span(p.cache, p.ptab, ws, (int)blockIdx.x * NWAVES + F.wave, N_CACHE_ITEMS, F.G * NWAVES, F.lane); asm volatile("s_waitcnt vmcnt(0)" ::: "memory"); __syncthreads(); }
        { pg8::Gemm g{(const bf16_t*)(ws + WS_H), (const bf16_t*)(ws + WS_WINT), 1024, 1024, 1024}; SchedMain S{F.G, (int)blockIdx.x};
          EpiMain E{p.out, (bf16_t*)(ws + WS_QB), (bf16_t*)(ws + WS_CMPA) + (size_t)32768 * 1024, (bf16_t*)(ws + WS_CMPA + CMPA_KIND_BYTES) + (size_t)32768 * 1024, (bf16_t*)(ws + WS_KVI),
                    (bf16_t*)(ws + WS_SA), (bf16_t*)(ws + WS_U), (bf16_t*)(ws + WS_CBG), (bf16_t*)(ws + WS_GA), (bf16_t*)(ws + WS_GB), (const float*)(ws + WS_ROPE), p.cache, p.ptab, ws, (int)blockIdx.x, F.G};
          pg8::gemm_phase(F.lds, g, S, E); }
#if defined(MK_SPLIT2)
    }
    if (lo <= 8 && 8 < hi) {
#else
        if (hi - lo > 1) MK_GRID_SYNC();
#endif
        { pg8::Gemm g{(const bf16_t*)(ws + WS_CMPA), (const bf16_t*)(ws + WS_WC1), 1024, 2048, 2048}; SchedCmp S{F.G, (int)blockIdx.x, 0, 128};
          EpiCmp1 E{(bf16_t*)(ws + WS_HID), (const float*)(ws + WS_PEB)};
          pg8::gemm_phase(F.lds, g, S, E);
          asm volatile("s_waitcnt vmcnt(0)" ::: "memory"); __syncthreads();
          { pg8::Gemm g2{(const bf16_t*)(ws + WS_HID), (const bf16_t*)(ws + WS_WC2), 256, 256, 256}; SchedCmp2 S2{F.G, (int)blockIdx.x, 0, 128};
            EpiCmp2 E2{ws + WS_KC}; pg8::gemm_phase(F.lds, g2, S2, E2); } }
        PUBLISH(p34 + 128);
    }
    TDONE(2); TSTART(3);
    if (IN(3)) {
        const int c = (int)blockIdx.x;
        if (c < 16) {
            pg8::Gemm g{(const bf16_t*)(ws + WS_CMPA), (const bf16_t*)(ws + WS_WC1), 1024, 2048, 2048}; SchedCmp S{F.G, c, 128, 8};
            EpiCmp1 E{(bf16_t*)(ws + WS_HID), (const float*)(ws + WS_PEB)};
            pg8::gemm_phase(F.lds, g, S, E);
            asm volatile("s_waitcnt vmcnt(0)" ::: "memory"); __syncthreads();
            { pg8::Gemm g2{(const bf16_t*)(ws + WS_HID), (const bf16_t*)(ws + WS_WC2), 256, 256, 256}; SchedCmp2 S2{F.G, c, 128, 8};
              EpiCmp2 E2{ws + WS_KC}; pg8::gemm_phase(F.lds, g2, S2, E2); }
            PUBLISH(p34);
        } else {
            const int gw = (c - 16) * NWAVES + F.wave, NGW = (F.G - 16) * NWAVES;
            for (int it = gw; it < MALL; it += NGW) ybin_row(p, it, F.lane);
            if (c < 144) { AWAIT(p34 + 128, F.G); for (int u = c - 16; u < 128; u += 128) att::sample_unit<0>(p, F, u); PUBLISH(p34 + 64); }
            else { for (int u = c - 144; u < 128; u += F.G - 144) att::sample_unit<1>(p, F, u);
                PUBLISH(p34 + 64);
                for (int it = (c - 144) * NWAVES + F.wave; it < N_WINC; it += (F.G - 144) * NWAVES) wincopy_item(p, it, F.lane); }
        }
    }
    TDONE(3); TSTART(4);
    if (IN(4)) {
        AWAIT(p34, 16);
        if ((F.vcu % (F.G >> 2)) == 0 && F.G >= 4 && F.vcu / (F.G >> 2) < 4) {
            AWAIT(p34 + 64, F.G - 16);
            const int pn = F.vcu / (F.G >> 2); unsigned* gcnt = (unsigned*)(ws + WS_CTL + 49152);
            for (int gi = F.tid; gi < 128 * 512; gi += NTHR) { const float* sp = (const float*)(ws + WS_SPART); const size_t row = (size_t)MP + (gi >> 9); const int col = gi & 511;
                ((bf16_t*)(ws + WS_AOY))[row * 1024 + col] = (bf16_t)f2bf((sp[gi] + sp[128 * 512 + gi]) * bf2f(((const bf16_t*)(ws + WS_SA))[row * 512 + col])); }
            asm volatile("s_waitcnt vmcnt(0)" ::: "memory"); __syncthreads();
#define GROUP4_SYNC(k) do { asm volatile("s_waitcnt vmcnt(0)" ::: "memory"); __syncthreads(); \
            if (F.tid == 0) { __builtin_amdgcn_fence(__ATOMIC_RELEASE, "agent"); asm volatile("s_waitcnt vmcnt(0)" ::: "memory"); \
                __hip_atomic_fetch_add(gcnt + 64 * (k), 1u, __ATOMIC_RELAXED, __HIP_MEMORY_SCOPE_AGENT); unsigned sp_ = 0; \
                while (__hip_atomic_load(gcnt + 64 * (k), __ATOMIC_RELAXED, __HIP_MEMORY_SCOPE_AGENT) < 4u) { __builtin_amdgcn_s_sleep(2); if (++sp_ > (1u << 22)) break; } \
                __builtin_amdgcn_fence(__ATOMIC_ACQUIRE, "agent"); asm volatile("s_waitcnt vmcnt(0)" ::: "memory"); } \
            __syncthreads(); } while (0)
            { pg8::Gemm g{(const bf16_t*)(ws + WS_AOY), (const bf16_t*)(ws + WS_WBR), 1024, 1024, 1024}; SchedOne S{64, pn};
              EpiE1 E{(const bf16_t*)(ws + WS_GA), (const bf16_t*)(ws + WS_GB), (bf16_t*)(ws + WS_OPRE)}; pg8::gemm_phase(F.lds, g, S, E); }
            GROUP4_SYNC(0);
            { pg8::Gemm g{(const bf16_t*)(ws + WS_OPRE), (const bf16_t*)(ws + WS_WOUT), 1024, 1024, 1024}; SchedOne S{64, pn};
              EpiE2 E{(bf16_t*)(ws + WS_O), (float*)(ws + WS_SSQP)}; pg8::gemm_phase(F.lds, g, S, E); }
            GROUP4_SYNC(1);
            for (int r = F.wave; r < 32; r += NWAVES) final_row(p, p.out, MP + 32 * pn + r, F.lane);
#undef GROUP4_SYNC
        }
        { const int bgi = (F.vcu * 4) / F.G; unsigned* ctr = (unsigned*)(ws + WS_CTL + 32768) + 64 * bgi;
#pragma unroll 1
          for (;;) { unsigned k = 0; if (F.lane == 0) k = __hip_atomic_fetch_add(ctr, 1u, __ATOMIC_RELAXED, __HIP_MEMORY_SCOPE_AGENT);
              k = (unsigned)__builtin_amdgcn_readfirstlane((int)k); if (k >= 1024u) break;
              att::prompt_unit(p, F, bgi >> 1, bgi & 1, 127 - (int)(k >> 3), (int)(k & 7)); } }
    }
    SEAM(4);
    if (IN(5)) { pg8::Gemm g{(const bf16_t*)(ws + WS_AOY), (const bf16_t*)(ws + WS_WBR), 1024, 1024, 1024}; SchedE2 S{F.G, (int)blockIdx.x};
        EpiE1 E{(const bf16_t*)(ws + WS_GA), (const bf16_t*)(ws + WS_GB), (bf16_t*)(ws + WS_OPRE)};
        pg8::gemm_phase(F.lds, g, S, E); }
    SEAM(5);
    if (IN(6)) { pg8::Gemm g{(const bf16_t*)(ws + WS_OPRE), (const bf16_t*)(ws + WS_WOUT), 1024, 1024, 1024}; SchedE2 S{F.G, (int)blockIdx.x};
        EpiE2 E{(bf16_t*)(ws + WS_O), (float*)(ws + WS_SSQP)};
        pg8::gemm_phase(F.lds, g, S, E); }
    SEAM(6);
    if (IN(7)) { const int gw = F.vcu * NWAVES + F.wave, NGW = F.G * NWAVES;
        for (int row = gw; row < MP; row += NGW) final_row(p, p.out, row, F.lane); }
    TDONE(7);
#undef IN
#undef SEAM
}
}

static mk::Params make_params(void* const* d_in, float* out, unsigned char* ws) {
    mk::Params p{};
    p.xp = (const float*)d_in[0]; p.xs = (const float*)d_in[1]; p.cache = (const float*)d_in[2]; p.swin = (const float*)d_in[3]; p.sconv = (const float*)d_in[4]; p.ptab = (const int*)d_in[5];
    p.cp = (const float*)d_in[6]; p.cs = (const float*)d_in[7]; p.w_ada = (const float*)d_in[8]; p.b_ada = (const float*)d_in[9]; p.g_pre = (const float*)d_in[10]; p.g_post = (const float*)d_in[11];
    p.w_in = (const float*)d_in[12]; p.pe = (const float*)d_in[13]; p.w1 = (const float*)d_in[14]; p.w2 = (const float*)d_in[15]; p.conv_w = (const float*)d_in[16];
    p.wba = (const float*)d_in[17]; p.wbb = (const float*)d_in[18]; p.wout = (const float*)d_in[19];
    p.out = out; p.ws = ws; p.ph_lo = 0; p.ph_hi = mk::NPHASE;
    return p;
}
static int mk_grid() {
    static int grid = 0;
    if (grid == 0) {
        int dev = 0, cus = 0, per_cu = 0;
        (void)hipGetDevice(&dev); (void)hipDeviceGetAttribute(&cus, hipDeviceAttributeMultiprocessorCount, dev);
        (void)hipFuncSetAttribute((const void*)mk::mk_fwd, hipFuncAttributeMaxDynamicSharedMemorySize, mk::LDS_BYTES);
        (void)hipOccupancyMaxActiveBlocksPerMultiprocessor(&per_cu, (const void*)mk::mk_fwd, mk::NTHR, mk::LDS_BYTES);
        if (per_cu < 1) { fprintf(stderr, "mk: occupancy query says %d blocks per CU\n", per_cu); per_cu = 1; }
        grid = cus;
        (void)hipGetLastError();
    }
    return grid;
}
static void mk_launch(mk::Params p, int lo, int hi, hipStream_t stream) {
    p.ph_lo = lo; p.ph_hi = hi; const int grid = mk_grid();
    if (hi - lo > 1) { void* args[] = {&p}; hipError_t e = hipLaunchCooperativeKernel((const void*)mk::mk_fwd, dim3(grid), dim3(mk::NTHR), args, mk::LDS_BYTES, stream);
        if (e != hipSuccess) fprintf(stderr, "cooperative launch failed: %s (grid %d)\n", hipGetErrorString(e), grid); }
    else hipLaunchKernelGGL(mk::mk_fwd, dim3(grid), dim3(mk::NTHR), mk::LDS_BYTES, stream, p);
}
extern "C" void kernel_launch(void* const* d_in, const int* in_sizes, int n_in, void* d_out, int out_size, void* d_ws, size_t ws_size, hipStream_t stream) {
    (void)in_sizes; (void)n_in; (void)out_size; (void)ws_size;
    (void)hipMemsetAsync((unsigned char*)d_ws + mk::WS_CTL, 0, 65536, stream);
    mk::Params p = make_params(d_in, (float*)d_out, (unsigned char*)d_ws);
#if defined(MK_MULTI_LAUNCH)
    for (int ph = 0; ph < mk::NPHASE; ++ph) mk_launch(p, ph, ph + 1, stream);
#else
    mk_launch(p, 0, mk::NPHASE, stream);
#endif
}
```

```cpp
#include <hip/hip_runtime.h>
#include <hip/hip_cooperative_groups.h>
#include <cstdio>
#include <cstdint>
#include <cmath>
namespace cg = cooperative_groups;
#define LAS __attribute__((address_space(3)))
typedef unsigned short bf16_t;
typedef short bf16x8 __attribute__((ext_vector_type(8)));
typedef float f32x4 __attribute__((ext_vector_type(4)));
typedef float f32x2 __attribute__((ext_vector_type(2)));
typedef float f32x16 __attribute__((ext_vector_type(16)));
typedef unsigned u32x4 __attribute__((ext_vector_type(4)));
typedef unsigned u32x2 __attribute__((ext_vector_type(2)));

namespace mk {
constexpr int DM = 1024, TS = 8192, MP = 16384, SB = 128, MALL = 16512, MPAD = 16640, INW = 5912, NV = 5888;
constexpr int C_G = 1280, C_A = 1304, C_CB = 1816, C_CC = 2328, C_CX = 2840, C_CG = 3352, C_GA = 3864;
constexpr size_t O_YP = 0, O_YS = 16777216, O_KVP = 16908288, O_WINP = 25296896, O_CSP = 25559040, O_KVS = 25561088, O_WINS = 25626624, O_CSS = 42403840, O_END = 42534912;
constexpr float QSCALE = 0.125f * 1.4426950408889634f;
constexpr int NWAVES = 8, NTHR = 512;

constexpr size_t MiB = 1u << 20;
constexpr size_t WS_CTL = 0;
constexpr size_t CTL_BYTES = 4 * MiB;
constexpr size_t WS_MOD = 4 * MiB;
constexpr size_t WS_ROPE = 6 * MiB;
constexpr size_t WS_PEBP = 7 * MiB;
constexpr size_t WS_PEB = 7 * MiB + 65536;
constexpr size_t WS_WGT = 7 * MiB + 262144;
constexpr size_t WS_NG = 8 * MiB;
constexpr size_t WS_SPART = 13 * MiB;
constexpr size_t WS_SSQP = 11 * MiB;
constexpr size_t WS_WINT = 16 * MiB;
constexpr size_t WS_WBR = 28 * MiB;
constexpr size_t WS_WOUT = 30 * MiB;
constexpr size_t WS_WC1 = 32 * MiB;
constexpr size_t WS_WC2 = 34 * MiB;
constexpr size_t WS_H = 36 * MiB;
constexpr size_t WS_QB = 72 * MiB;
constexpr size_t WS_SA = 90 * MiB;
constexpr size_t WS_U = 108 * MiB;
constexpr size_t WS_CBG = 126 * MiB;
constexpr size_t WS_GA = 144 * MiB;
constexpr size_t WS_GB = 178 * MiB;
constexpr size_t WS_KVI = 212 * MiB;
constexpr size_t WS_KC = 230 * MiB;
constexpr size_t KC_KIND_BYTES = (size_t)34816 * 64 * 2;
constexpr size_t WS_HID = 240 * MiB;
constexpr size_t HID_KIND_BYTES = (size_t)34816 * 256 * 2;
constexpr size_t WS_CMPA = 276 * MiB;
constexpr size_t CMPA_KIND_BYTES = (size_t)(34816 + 2) * 1024 * 2;
constexpr size_t WS_AOY = 420 * MiB;
constexpr size_t WS_T1 = 456 * MiB;
constexpr size_t WS_OPRE = 524 * MiB;
constexpr size_t WS_O = 560 * MiB;
constexpr size_t WS_END = 628 * MiB;
constexpr size_t WS_OUT2 = 640 * MiB;
constexpr size_t WS_ORC = 1024 * MiB;

struct Params {
    const float *xp, *xs, *cache, *swin, *sconv; const int* ptab; const float *cp, *cs, *w_ada, *b_ada, *g_pre, *g_post, *w_in, *pe, *w1, *w2, *conv_w, *wba, *wbb, *wout;
    float* out; unsigned char* ws; int ph_lo, ph_hi;
};

__device__ __forceinline__ float fast_rcp(float x) { return __builtin_amdgcn_rcpf(x); }
__device__ __forceinline__ float sigm(float x) { return fast_rcp(1.f + __expf(-x)); }
__device__ __forceinline__ float silu(float x) { return x * fast_rcp(1.f + __expf(-x)); }
__device__ __forceinline__ unsigned f2bf(float f) { unsigned u = __builtin_bit_cast(unsigned, f); return (u + 0x7fffu + ((u >> 16) & 1u)) >> 16; }
__device__ __forceinline__ unsigned pk2(float lo, float hi) { typedef __bf16 bf16x2_t __attribute__((ext_vector_type(2))); f32x2 v = {lo, hi}; bf16x2_t b = __builtin_convertvector(v, bf16x2_t); return __builtin_bit_cast(unsigned, b); }
__device__ __forceinline__ float bf2f(unsigned short b) { return __builtin_bit_cast(float, (unsigned)b << 16); }
__device__ __forceinline__ float bflo(unsigned w) { return __builtin_bit_cast(float, w << 16); }
__device__ __forceinline__ float bfhi(unsigned w) { return __builtin_bit_cast(float, w & 0xffff0000u); }

namespace pg8 {
constexpr int BM = 256, BK = 64, HALF = 128, HTB = HALF * BK * 2, STAGE_BYTES = 8 * HTB, NXCD = 8, WGM = 8;
__host__ __device__ __forceinline__ int lds_byte(int r, int c) { const int st = (r >> 4) * 2 + (c >> 5), rr = r & 15, cc = c & 31, ob = rr * 64 + cc * 2; return st * 1024 + (ob ^ (((ob >> 9) & 1) << 5)); }
__host__ __device__ __forceinline__ void stage_rc(int b, int& R, int& C) { const int st = b / 1024, sb = b % 1024, swz = sb ^ (((sb >> 9) & 1) << 5); R = (st >> 1) * 16 + swz / 64; C = (st & 1) * 32 + (swz % 64) / 2; }
__host__ __device__ __forceinline__ int perm32(int rho) { const int n = rho >> 4, i = rho & 15; return 8 * (i >> 2) + 4 * n + (i & 3); }

struct Unit { int pm, pn, aux; size_t aoff, boff; };
struct Gemm { const bf16_t* A; const bf16_t* Bt; int lda, ldb, K; };

__device__ __forceinline__ bool static_tile_L(long L, int nM, int nN, int& pm, int& pn);
__device__ __forceinline__ bool static_tile(int i, int G, int c, int nM, int nN, int& pm, int& pn) { return static_tile_L((long)i * G + c, nM, nN, pm, pn); }
__device__ __forceinline__ bool static_tile_L(long L, int nM, int nN, int& pm, int& pn) {
    const int nwg = nM * nN; if (L >= nwg) return false;
    int wgid = (int)L; { const int q = nwg / NXCD, r = nwg % NXCD, xcd = wgid % NXCD, off = wgid / NXCD; wgid = (xcd < r ? xcd * (q + 1) : r * (q + 1) + (xcd - r) * q) + off; }
    const int nig = WGM * nN, gid = wgid / nig, fm = gid * WGM, gsz = (nM - fm) < WGM ? (nM - fm) : WGM;
    pm = fm + ((wgid % nig) % gsz); pn = (wgid % nig) / gsz; return true;
}

template <class Epi, class Sched>
__device__ __forceinline__ void gemm_phase(LAS unsigned char* lds, const Gemm g, const Sched& S, const Epi& E) {
    const int tid = threadIdx.x, wid = __builtin_amdgcn_readfirstlane(tid >> 6), lane = tid & 63, wr = wid >> 2, wc = wid & 3, fr = lane & 15, fq = lane >> 4;
    const int nt = g.K / BK;
    unsigned voffA[2], voffB[2];
#pragma unroll
    for (int i = 0; i < 2; ++i) { int R, C; stage_rc(tid * 16 + i * 8192, R, C); const int Rb = Epi::PERM ? ((R & ~31) + perm32(R & 31)) : R;
        voffA[i] = (unsigned)(R * g.lda + C) * 2u; voffB[i] = (unsigned)(Rb * g.ldb + C) * 2u; }
    const size_t kstep = (size_t)(BK * 2);
    const size_t hstepA = (size_t)HALF * g.lda * 2, hstepB = (size_t)HALF * g.ldb * 2;
    const unsigned ldsw = (unsigned)wid * 1024u;
    const int aoff = lds_byte(wr * 64 + fr, fq * 8), boff = lds_byte(wc * 32 + fr, fq * 8);
#define PG8_SA(b, h) (((b) * 2 + (h)) * HTB)
#define PG8_SB(b, h) ((4 + (b) * 2 + (h)) * HTB)
#define PG8_STAGE(bufoff, gbase, voff) do { _Pragma("unroll") for (int _i = 0; _i < 2; ++_i) \
        __builtin_amdgcn_global_load_lds((const unsigned*)((const char*)(gbase) + (voff)[_i]), (LAS unsigned*)(lds + (bufoff) + ldsw + _i * 8192), 16, 0, 0); } while (0)
#define PG8_LDA(dst, b, h) do { _Pragma("unroll") for (int m = 0; m < 4; ++m) _Pragma("unroll") for (int k = 0; k < 2; ++k) dst[m][k] = *(const LAS bf16x8*)(lds + PG8_SA(b, h) + aoff + m * 2048 + k * 1024); } while (0)
#define PG8_LDB(dst, b, h) do { _Pragma("unroll") for (int n = 0; n < 2; ++n) _Pragma("unroll") for (int k = 0; k < 2; ++k) dst[n][k] = *(const LAS bf16x8*)(lds + PG8_SB(b, h) + boff + n * 2048 + k * 1024); } while (0)
#define PG8_MMA(ai, bj, At, Bt) do { __builtin_amdgcn_s_setprio(1); _Pragma("unroll") for (int m = 0; m < 4; ++m) _Pragma("unroll") for (int n = 0; n < 2; ++n) _Pragma("unroll") for (int k = 0; k < 2; ++k) \
        acc[ai][bj][m][n] = __builtin_amdgcn_mfma_f32_16x16x32_bf16(Bt[n][k], At[m][k], acc[ai][bj][m][n], 0, 0, 0); __builtin_amdgcn_s_setprio(0); } while (0)
#define PG8_WAIT_V(n) asm volatile("s_waitcnt vmcnt(" #n ")" ::: "memory")
#define PG8_WAIT_L(n) asm volatile("s_waitcnt lgkmcnt(" #n ")" ::: "memory")
#define PG8_BAR __builtin_amdgcn_s_barrier()
#define PG8_SCHED __builtin_amdgcn_sched_barrier(0)
    Unit cur, nxt; int ui = 0;
    if (!S.next(0, cur)) return;
    f32x4 acc[2][2][4][2];
#pragma unroll
    for (int a = 0; a < 2; ++a)
#pragma unroll
        for (int b = 0; b < 2; ++b)
#pragma unroll
            for (int m = 0; m < 4; ++m)
#pragma unroll
                for (int n = 0; n < 2; ++n) acc[a][b][m][n] = (f32x4){0.f, 0.f, 0.f, 0.f};
    bf16x8 At[4][2], B0[2][2], B1[2][2];
    const char* cA = (const char*)g.A + cur.aoff; const char* cB = (const char*)g.Bt + cur.boff;
    PG8_STAGE(PG8_SB(0, 0), cB, voffB); PG8_STAGE(PG8_SB(0, 1), cB + hstepB, voffB); PG8_STAGE(PG8_SA(0, 0), cA, voffA); PG8_STAGE(PG8_SA(0, 1), cA + hstepA, voffA);
    if (wr == 1) PG8_BAR;
    PG8_WAIT_V(2); PG8_BAR;
    PG8_STAGE(PG8_SB(1, 0), cB + kstep, voffB); PG8_STAGE(PG8_SA(1, 0), cA + kstep, voffA); PG8_STAGE(PG8_SB(1, 1), cB + hstepB + kstep, voffB);
    PG8_WAIT_V(6); PG8_BAR;
    for (;;) {
        const bool has_next = S.next(ui + 1, nxt);
        const char* nA = has_next ? (const char*)g.A + nxt.aoff : cA; const char* nB = has_next ? (const char*)g.Bt + nxt.boff : cB;
        for (int t = 0; t < nt; t += 2) {
            if constexpr (Epi::HAS_MID) { if (t == (nt >> 1)) { int fr_ = fr, fq_ = fq; asm volatile("" : "+v"(fr_), "+v"(fq_)); E.mid(acc, cur, wr, wc, fr_, fq_); } }
            const bool last = (t == nt - 2);
            const char* a1 = cA + (size_t)(t + 1) * kstep;
            const char* a2 = last ? nA : cA + (size_t)(t + 2) * kstep; const char* b2 = last ? nB : cB + (size_t)(t + 2) * kstep;
            const char* a3 = a2 + kstep; const char* b3 = b2 + kstep;
            PG8_LDB(B0, 0, 0); PG8_LDB(B1, 0, 1); PG8_SCHED; PG8_LDA(At, 0, 0); PG8_STAGE(PG8_SA(1, 1), a1 + hstepA, voffA);
            PG8_WAIT_V(8); PG8_WAIT_L(0); PG8_BAR; PG8_MMA(0, 0, At, B0); PG8_MMA(0, 1, At, B1); PG8_BAR; PG8_SCHED;
            PG8_LDA(At, 0, 1); PG8_STAGE(PG8_SB(0, 0), b2, voffB); PG8_STAGE(PG8_SB(0, 1), b2 + hstepB, voffB); PG8_STAGE(PG8_SA(0, 0), a2, voffA);
            PG8_WAIT_V(8); PG8_WAIT_L(0); PG8_BAR; PG8_MMA(1, 0, At, B0); PG8_MMA(1, 1, At, B1); PG8_BAR; PG8_SCHED;
            PG8_LDB(B0, 1, 0); PG8_LDB(B1, 1, 1); PG8_SCHED; PG8_LDA(At, 1, 0); PG8_STAGE(PG8_SA(0, 1), a2 + hstepA, voffA);
            PG8_WAIT_V(8); PG8_WAIT_L(0); PG8_BAR; PG8_MMA(0, 0, At, B0); PG8_MMA(0, 1, At, B1); PG8_BAR; PG8_SCHED;
            PG8_LDA(At, 1, 1); PG8_STAGE(PG8_SB(1, 0), b3, voffB); PG8_STAGE(PG8_SB(1, 1), b3 + hstepB, voffB); PG8_STAGE(PG8_SA(1, 0), a3, voffA);
            PG8_WAIT_V(8); PG8_WAIT_L(0); PG8_BAR; PG8_MMA(1, 0, At, B0); PG8_MMA(1, 1, At, B1); PG8_BAR; PG8_SCHED;
        }
        if (wr == 0) PG8_BAR;
        { int fr_ = fr, fq_ = fq; asm volatile("" : "+v"(fr_), "+v"(fq_)); E(acc, cur, wr, wc, fr_, fq_); }
        if constexpr (Epi::HAS_BETWEEN) E.between(ui, wid, lane);
        if (!has_next) break;
#pragma unroll
        for (int a = 0; a < 2; ++a)
#pragma unroll
            for (int b = 0; b < 2; ++b)
#pragma unroll
                for (int m = 0; m < 4; ++m)
#pragma unroll
                    for (int n = 0; n < 2; ++n) acc[a][b][m][n] = (f32x4){0.f, 0.f, 0.f, 0.f};
        cur = nxt; cA = nA; cB = nB; ++ui;
        if (wr == 1) PG8_BAR;
    }
    PG8_WAIT_V(0);
    PG8_BAR;
#undef PG8_SA
#undef PG8_SB
#undef PG8_STAGE
#undef PG8_LDA
#undef PG8_LDB
#undef PG8_MMA
#undef PG8_WAIT_V
#undef PG8_WAIT_L
#undef PG8_BAR
#undef PG8_SCHED
}

template <class Epi>
__device__ __forceinline__ void gemm_f32a_unit(LAS unsigned char* lds, const float* cache, const int* ptab, const bf16_t* Bt, int ldb, const Unit& u, const Epi& E) {
    const int tid = threadIdx.x, wid = __builtin_amdgcn_readfirstlane(tid >> 6), lane = tid & 63, wr = wid >> 2, wc = wid & 3, fr = lane & 15, fq = lane >> 4;
    constexpr int ns = 16;
    unsigned voffB[2]; int tok0[2], cc[2], pg0[2], pg1[2];
#pragma unroll
    for (int i = 0; i < 2; ++i) { int R, C; stage_rc(tid * 16 + i * 8192, R, C); const int Rb = Epi::PERM ? ((R & ~31) + perm32(R & 31)) : R;
        voffB[i] = (unsigned)(Rb * ldb + C) * 2u; tok0[i] = 16 * R; cc[i] = C;
        const int tl = tok0[i] + 15 < 2047 ? tok0[i] + 15 : 2047;
        pg0[i] = ptab[u.pm * 16 + (tok0[i] >> 7)]; pg1[i] = ptab[u.pm * 16 + (tl >> 7)]; }
    const size_t kstep = (size_t)(BK * 2), hstepB = (size_t)HALF * ldb * 2;
    const unsigned ldsw = (unsigned)wid * 1024u;
    const int aoff = lds_byte(wr * 64 + fr, fq * 8), boff = lds_byte(wc * 32 + fr, fq * 8);
    int a1off[4];
#pragma unroll
    for (int m = 0; m < 4; ++m) { const int r1 = wr * 64 + 16 * m + fr + 1; a1off[m] = lds_byte(r1 < 128 ? r1 : 127, fq * 8); }
    const float* cbase = cache + u.aux * 128;
    f32x4 acc[2][2][4][2];
#pragma unroll
    for (int a = 0; a < 2; ++a)
#pragma unroll
        for (int b = 0; b < 2; ++b)
#pragma unroll
            for (int m = 0; m < 4; ++m)
#pragma unroll
                for (int n = 0; n < 2; ++n) acc[a][b][m][n] = (f32x4){0.f, 0.f, 0.f, 0.f};
    bf16x8 At[4][2], B0[2][2];
    f32x4 ar[2][2][2];
    const char* cB = (const char*)Bt + u.boff;
#define F32A_SA(st_, h_) (((st_) * 2 + (h_)) * HTB)
#define F32A_SB(sl_, h_) ((4 + (sl_) * 2 + (h_)) * HTB)
#define F32A_DMAB(sl_, kt_) do { _Pragma("unroll") for (int h_ = 0; h_ < 2; ++h_) _Pragma("unroll") for (int _i = 0; _i < 2; ++_i) \
        __builtin_amdgcn_global_load_lds((const unsigned*)(cB + (size_t)(kt_) * kstep + h_ * hstepB + voffB[_i]), (LAS unsigned*)(lds + F32A_SB(sl_, h_) + ldsw + _i * 8192), 16, 0, 0); } while (0)
#define F32A_ISSUE(t_) do { _Pragma("unroll") for (int i_ = 0; i_ < 2; ++i_) { int tk_ = tok0[i_] + (t_); tk_ = tk_ < 2047 ? tk_ : 2047; \
            const int pg_ = (tk_ >> 7) == (tok0[i_] >> 7) ? pg0[i_] : pg1[i_]; const float* src_ = cbase + ((size_t)pg_ * 128 + (tk_ & 127)) * 512 + cc[i_]; \
            ar[0][i_][0] = *(const f32x4*)(src_); ar[0][i_][1] = *(const f32x4*)(src_ + 4); ar[1][i_][0] = *(const f32x4*)(src_ + 64); ar[1][i_][1] = *(const f32x4*)(src_ + 68); } } while (0)
#define F32A_WRITE(st_) do { _Pragma("unroll") for (int h_ = 0; h_ < 2; ++h_) _Pragma("unroll") for (int i_ = 0; i_ < 2; ++i_) { u32x4 w_; \
            w_.x = pk2(ar[h_][i_][0][0], ar[h_][i_][0][1]); w_.y = pk2(ar[h_][i_][0][2], ar[h_][i_][0][3]); w_.z = pk2(ar[h_][i_][1][0], ar[h_][i_][1][1]); w_.w = pk2(ar[h_][i_][1][2], ar[h_][i_][1][3]); \
            *(LAS u32x4*)(lds + F32A_SA(st_, h_) + tid * 16 + i_ * 8192) = w_; } } while (0)
#define F32A_LDA0(st_, h_) do { _Pragma("unroll") for (int m = 0; m < 4; ++m) _Pragma("unroll") for (int k = 0; k < 2; ++k) At[m][k] = *(const LAS bf16x8*)(lds + F32A_SA(st_, h_) + aoff + m * 2048 + k * 1024); } while (0)
#define F32A_LDA1(st_, h_) do { _Pragma("unroll") for (int m = 0; m < 4; ++m) _Pragma("unroll") for (int k = 0; k < 2; ++k) At[m][k] = *(const LAS bf16x8*)(lds + F32A_SA(st_, h_) + a1off[m] + k * 1024); } while (0)
#define F32A_LDB(sl_, h_) do { _Pragma("unroll") for (int n = 0; n < 2; ++n) _Pragma("unroll") for (int k = 0; k < 2; ++k) B0[n][k] = *(const LAS bf16x8*)(lds + F32A_SB(sl_, h_) + boff + n * 2048 + k * 1024); } while (0)
#define F32A_MMA(ai, bj) do { _Pragma("unroll") for (int m = 0; m < 4; ++m) _Pragma("unroll") for (int n = 0; n < 2; ++n) _Pragma("unroll") for (int k = 0; k < 2; ++k) \
        acc[ai][bj][m][n] = __builtin_amdgcn_mfma_f32_16x16x32_bf16(B0[n][k], At[m][k], acc[ai][bj][m][n], 0, 0, 0); } while (0)
#define F32A_WL asm volatile("s_waitcnt lgkmcnt(0)" ::: "memory")
#define F32A_KSTEP(LDA_, st_, sl_) do { LDA_(st_, 0); F32A_LDB(sl_, 0); F32A_WL; F32A_MMA(0, 0); F32A_LDB(sl_, 1); F32A_WL; F32A_MMA(0, 1); \
        LDA_(st_, 1); F32A_WL; F32A_MMA(1, 1); F32A_LDB(sl_, 0); F32A_WL; F32A_MMA(1, 0); } while (0)
    int st = 0, bA = 0, bB = 1, bF = 2;
    F32A_ISSUE(0); F32A_DMAB(0, 0); F32A_DMAB(1, 16);
    asm volatile("s_waitcnt vmcnt(0)" ::: "memory"); F32A_WRITE(0); F32A_WL;
    __builtin_amdgcn_s_barrier();
#pragma unroll 1
    for (int sidx = 0; sidx < ns; ++sidx) {
        const bool more = sidx + 1 < ns;
        if (more) { F32A_ISSUE(sidx + 1); F32A_DMAB(bF, sidx + 1); }
        F32A_KSTEP(F32A_LDA0, st, bA);
        __builtin_amdgcn_s_barrier();
        if (more) F32A_DMAB(bA, sidx + 17);
        F32A_KSTEP(F32A_LDA1, st, bB);
        if (more) { asm volatile("s_waitcnt vmcnt(0)" ::: "memory"); F32A_WRITE(st ^ 1); F32A_WL; }
        __builtin_amdgcn_s_barrier();
        { const int t_ = bB; bB = bA; bA = bF; bF = t_; } st ^= 1;
    }
    { int fr_ = fr, fq_ = fq; asm volatile("" : "+v"(fr_), "+v"(fq_)); E(acc, u, wr, wc, fr_, fq_); }
    asm volatile("s_waitcnt vmcnt(0)" ::: "memory");
    __builtin_amdgcn_s_barrier();
#undef F32A_KSTEP
#undef F32A_WL
#undef F32A_MMA
#undef F32A_LDB
#undef F32A_LDA1
#undef F32A_LDA0
#undef F32A_WRITE
#undef F32A_ISSUE
#undef F32A_DMAB
#undef F32A_SB
#undef F32A_SA
}
}

typedef f32x4 Acc[2][2][4][2];

constexpr int N_CACHE_ITEMS = 16384;
__device__ __forceinline__ void cache_load(const float* cache, const int* ptab, int r, int lane, f32x4 (&v)[16]) {
    const int tok0 = r * 16, bs = tok0 >> 11, t0 = tok0 & 2047; const int phys = ptab[bs * 16 + (t0 >> 7)];
    const float* src = cache + ((size_t)phys * 128 + (t0 & 127)) * 512 + lane * 4;
#pragma unroll
    for (int j = 0; j < 16; ++j) v[j] = *(const f32x4*)(src + (size_t)j * 512);
}
__device__ __forceinline__ void cache_store(unsigned char* ws, int r, int lane, const f32x4 (&v)[16]) {
    const int tok0 = r * 16, bs = tok0 >> 11, t0 = tok0 & 2047;
    const int kind = lane >> 5, g = (lane >> 4) & 1, d = (lane & 15) * 4;
    bf16_t* dst = (bf16_t*)(ws + WS_CMPA + (size_t)kind * CMPA_KIND_BYTES) + ((size_t)(bs * 2 + g) * 2048 + t0) * 64 + d;
#pragma unroll
    for (int j = 0; j < 16; ++j) { u32x2 w; w.x = pk2(v[j][0], v[j][1]); w.y = pk2(v[j][2], v[j][3]); *(u32x2*)(dst + j * 64) = w; }
}
__device__ __forceinline__ void cache_span(const float* cache, const int* ptab, unsigned char* ws, int lo, int hi, int step, int lane) {
    f32x4 va[16], vb[16];
    if (lo < hi) cache_load(cache, ptab, lo, lane, va);
#pragma unroll 1
    for (int it = lo; it < hi; it += 2 * step) {
        if (it + step < hi) cache_load(cache, ptab, it + step, lane, vb);
        cache_store(ws, it, lane, va);
        if (it + 2 * step < hi) cache_load(cache, ptab, it + 2 * step, lane, va);
        if (it + step < hi) cache_store(ws, it + step, lane, vb); }
}

struct EpiMain {
    static constexpr bool PERM = true, HAS_MID = false, HAS_BETWEEN = false;
    float* out; bf16_t *Qb, *CMPAp0, *CMPAp1, *KVI, *SA, *U, *CBG, *GA, *GB; const float* rope;
    const float* cache; const int* ptab; unsigned char* wsb; int c, G;
    __device__ __forceinline__ void between(int ui, int wid, int lane) const {
        if (G != 256 || ui != c % 5) return;
        const int lo = c < 215 ? c * 58 : 215 * 58 + (c - 215) * 96, n = c < 215 ? 58 : 96; const int hi = lo + n < N_CACHE_ITEMS ? lo + n : N_CACHE_ITEMS;
        cache_span(cache, ptab, wsb, lo + wid, hi, 8, lane);
        asm volatile("s_waitcnt vmcnt(0)" ::: "memory");
    }
    __device__ __forceinline__ void operator()(const Acc& acc, const pg8::Unit& u, int wr, int wc, int fr, int fq) const {
        const int pn = u.pn;
        const int lane16 = fq;
        f32x4 ncs0 = {0.f, 0.f, 0.f, 0.f}, ncs1 = ncs0, nsn0 = ncs0, nsn1 = ncs0;
#pragma unroll
        for (int ai = 0; ai < 2; ++ai)
#pragma unroll
            for (int m = 0; m < 4; ++m) {
                asm volatile("" ::: "memory");
                const int row = u.pm * 256 + ai * 128 + wr * 64 + m * 16 + fr;
                const bool rok = row < MALL;
                const bool prompt = row < MP;
                const int pos = prompt ? (row & (TS - 1)) : 2048;
                if (pn < 5) {
                    const bool isq = pn < 2;
                    const bool ropelane = ((wc & 1) == 0) && (lane16 < 2);
                    if (ai == 0 && m == 0) { if (ropelane) { const float* rp = rope + (size_t)pos * 16; ncs0 = *(const f32x4*)(rp); ncs1 = *(const f32x4*)(rp + 4); nsn0 = *(const f32x4*)(rp + 8); nsn1 = *(const f32x4*)(rp + 12); } }
                    const f32x4 cs0 = ncs0, cs1 = ncs1, sn0 = nsn0, sn1 = nsn1;
                    if (!(ai == 1 && m == 3)) { const int nrow = u.pm * 256 + (m == 3 ? 128 : ai * 128) + wr * 64 + ((m + 1) & 3) * 16 + fr; const int npos = nrow < MP ? (nrow & (TS - 1)) : 2048;
                        if (ropelane) { const float* rp = rope + (size_t)npos * 16; ncs0 = *(const f32x4*)(rp); ncs1 = *(const f32x4*)(rp + 4); nsn0 = *(const f32x4*)(rp + 8); nsn1 = *(const f32x4*)(rp + 12); } }
#pragma unroll
                    for (int bj = 0; bj < 2; ++bj) {
                        f32x4 v0 = acc[ai][bj][m][0], v1 = acc[ai][bj][m][1];
                        const bool dorope = isq || (bj == 0);
                        if (dorope) {
                            f32x4 p0, p1;
#pragma unroll
                            for (int j = 0; j < 4; ++j) { p0[j] = __shfl_xor(v0[j], 16); p1[j] = __shfl_xor(v1[j], 16); }
                            if (ropelane) {
                                if (lane16 == 0) { v0 = v0 * cs0 - p0 * sn0; v1 = v1 * cs1 - p1 * sn1; }
                                else { v0 = p0 * sn0 + v0 * cs0; v1 = p1 * sn1 + v1 * cs1; }
                            }
                        }
                        if (!rok) continue;
                        if (isq) {
                            u32x4 w; w.x = pk2(v0[0] * QSCALE, v0[1] * QSCALE); w.y = pk2(v0[2] * QSCALE, v0[3] * QSCALE); w.z = pk2(v1[0] * QSCALE, v1[1] * QSCALE); w.w = pk2(v1[2] * QSCALE, v1[3] * QSCALE);
                            *(u32x4*)(Qb + (size_t)row * 512 + pn * 256 + bj * 128 + wc * 32 + fq * 8) = w;
                        } else {
                            const int kind = 2 * (pn - 2) + bj, g = wc >> 1, dim0 = 32 * (wc & 1) + 8 * fq;
                            if (prompt) {
                                const int b = row >> 13, t = row & (TS - 1), bg = b * 2 + g;
                                if (kind < 4) { float* o = out + O_KVP + ((size_t)row * 4 + kind) * 128 + g * 64 + dim0; *(f32x4*)o = v0; *(f32x4*)(o + 4) = v1; }
                                else if (t >= TS - 512) { float* o = out + O_WINP + ((size_t)(b * 512 + t - (TS - 512)) * 2 + (kind - 4)) * 128 + g * 64 + dim0; *(f32x4*)o = v0; *(f32x4*)(o + 4) = v1; }
                                u32x4 w; w.x = pk2(v0[0], v0[1]); w.y = pk2(v0[2], v0[3]); w.z = pk2(v1[0], v1[1]); w.w = pk2(v1[2], v1[3]);
                                if (kind < 2) { bf16_t* base = kind ? CMPAp1 : CMPAp0; *(u32x4*)(base + ((size_t)bg * TS + t) * 64 + dim0) = w; }
                                else {
                                    unsigned char* img = (unsigned char*)KVI + ((size_t)((kind - 2) * 4 + bg) * 128 + (t >> 6)) * 8192; const int key = t & 63;
                                    if ((kind & 1) == 0) *(u32x4*)(img + (dim0 >> 3) * 1024 + key * 16) = w;
                                    else { const int k16 = key & 15, pp = 8 * ((k16 >> 2) & 1) + 4 * (k16 >> 3) + (k16 & 3); unsigned char* vq = img + (key >> 4) * 2048 + dim0 * 32 + pp * 2;
                                        *(bf16_t*)(vq) = (bf16_t)w.x; *(bf16_t*)(vq + 32) = (bf16_t)(w.x >> 16); *(bf16_t*)(vq + 64) = (bf16_t)w.y; *(bf16_t*)(vq + 96) = (bf16_t)(w.y >> 16);
                                        *(bf16_t*)(vq + 128) = (bf16_t)w.z; *(bf16_t*)(vq + 160) = (bf16_t)(w.z >> 16); *(bf16_t*)(vq + 192) = (bf16_t)w.w; *(bf16_t*)(vq + 224) = (bf16_t)(w.w >> 16); }
                                }
                            } else {
                                const int bs = row - MP;
                                float* o = kind < 4 ? out + O_KVS + ((size_t)bs * 4 + kind) * 128 + g * 64 + dim0 : out + O_WINS + ((size_t)(bs * 512 + 511) * 2 + (kind - 4)) * 128 + g * 64 + dim0;
                                *(f32x4*)o = v0; *(f32x4*)(o + 4) = v1;
                            }
                        }
                    }
                } else if (pn < 7) {
                    if (!rok) continue;
#pragma unroll
                    for (int bj = 0; bj < 2; ++bj) { const f32x4 v0 = acc[ai][bj][m][0], v1 = acc[ai][bj][m][1];
                        u32x4 w; w.x = pk2(silu(v0[0]), silu(v0[1])); w.y = pk2(silu(v0[2]), silu(v0[3])); w.z = pk2(silu(v1[0]), silu(v1[1])); w.w = pk2(silu(v1[2]), silu(v1[3]));
                        *(u32x4*)(SA + (size_t)row * 512 + (pn - 5) * 256 + bj * 128 + wc * 32 + fq * 8) = w; }
                } else if (pn < 15) {
                    if (!rok) continue;
                    const f32x4 cb = acc[ai][0][m][0], cg = acc[ai][0][m][1], cc = acc[ai][1][m][0], cx = acc[ai][1][m][1];
                    const int c0 = 64 * (pn - 7) + 16 * wc + 4 * fq;
                    const f32x4 uu = cc * cx; f32x4 cbg;
#pragma unroll
                    for (int j = 0; j < 4; ++j) cbg[j] = cb[j] * silu(cg[j]);
                    u32x2 wu, wc2; wu.x = pk2(uu[0], uu[1]); wu.y = pk2(uu[2], uu[3]); wc2.x = pk2(cbg[0], cbg[1]); wc2.y = pk2(cbg[2], cbg[3]);
                    *(u32x2*)(U + (size_t)row * 512 + c0) = wu; *(u32x2*)(CBG + (size_t)row * 512 + c0) = wc2;
                    if (prompt) { const int t = row & (TS - 1); if (t >= TS - 2) *(f32x4*)(out + O_CSP + ((size_t)(row >> 13) * 2 + (t - (TS - 2))) * 512 + c0) = uu; }
                    else *(f32x4*)(out + O_CSS + ((size_t)(row - MP) * 2 + 1) * 512 + c0) = uu;
                } else {
                    if (!rok) continue;
                    const int col = (pn - 15) * 128 + wc * 32 + fq * 8;
                    const f32x4 a0 = acc[ai][0][m][0], a1 = acc[ai][0][m][1], b0 = acc[ai][1][m][0], b1 = acc[ai][1][m][1];
                    float rr[8], gg[8];
#pragma unroll
                    for (int j = 0; j < 4; ++j) { const float ea0 = 1.f + __expf(-a0[j]), eb0 = 1.f + __expf(-b0[j]), ea1 = 1.f + __expf(-a1[j]), eb1 = 1.f + __expf(-b1[j]);
                        const float r0 = fast_rcp(ea0 * eb0), r1 = fast_rcp(ea1 * eb1);
                        rr[j] = eb0 * eb0 * r0; gg[j] = ea0 * r0; rr[4 + j] = eb1 * eb1 * r1; gg[4 + j] = ea1 * r1; }
                    u32x4 wr_, wg_; wr_.x = pk2(rr[0], rr[1]); wr_.y = pk2(rr[2], rr[3]); wr_.z = pk2(rr[4], rr[5]); wr_.w = pk2(rr[6], rr[7]);
                    wg_.x = pk2(gg[0], gg[1]); wg_.y = pk2(gg[2], gg[3]); wg_.z = pk2(gg[4], gg[5]); wg_.w = pk2(gg[6], gg[7]);
                    *(u32x4*)(GA + (size_t)row * 1024 + col) = wr_; *(u32x4*)(GB + (size_t)row * 1024 + col) = wg_;
                }
            }
    }
};
struct SchedMain {
    int G, c;
    __device__ __forceinline__ bool next(int i, pg8::Unit& u) const {
        int pm, pn; if (!pg8::static_tile(i, G, c, 65, 23, pm, pn)) return false;
        u.pm = pm; u.pn = pn; u.aux = 0; u.aoff = (size_t)pm * 256 * 1024 * 2; u.boff = (size_t)pn * 256 * 1024 * 2; return true; }
};

struct EpiCmp1 {
    static constexpr bool PERM = true, HAS_MID = false, HAS_BETWEEN = false;
    bf16_t* HID; const float* peb;
    __device__ __forceinline__ void operator()(const Acc& acc, const pg8::Unit& u, int wr, int wc, int fr, int fq) const {
        const int kind = u.aux; bf16_t* H = HID + (size_t)kind * (HID_KIND_BYTES / 2);
        f32x4 bv[2][2];
#pragma unroll
        for (int bj = 0; bj < 2; ++bj)
#pragma unroll
            for (int n = 0; n < 2; ++n) bv[bj][n] = *(const f32x4*)(peb + kind * 256 + bj * 128 + wc * 32 + fq * 8 + n * 4);
#pragma unroll
        for (int ai = 0; ai < 2; ++ai)
#pragma unroll
            for (int m = 0; m < 4; ++m) { const int row = u.pm * 256 + ai * 128 + wr * 64 + m * 16 + fr;
#pragma unroll
                for (int bj = 0; bj < 2; ++bj) { const f32x4 v0 = acc[ai][bj][m][0] + bv[bj][0], v1 = acc[ai][bj][m][1] + bv[bj][1];
                    u32x4 w; w.x = pk2(silu(v0[0]), silu(v0[1])); w.y = pk2(silu(v0[2]), silu(v0[3])); w.z = pk2(silu(v1[0]), silu(v1[1])); w.w = pk2(silu(v1[2]), silu(v1[3]));
                    *(u32x4*)(H + (size_t)row * 256 + bj * 128 + wc * 32 + fq * 8) = w; } }
    }
};
struct SchedCmp {
    int G, c, pm0, npm;
    __device__ __forceinline__ bool next(int i, pg8::Unit& u) const {
        const int L = i * G + c; if (c < 0 || L >= 2 * npm) return false;
        const int kind = L / npm, pm = pm0 + L % npm;
        u.pm = pm; u.pn = 0; u.aux = kind; u.aoff = (size_t)kind * CMPA_KIND_BYTES + (size_t)pm * 256 * 1024 * 2; u.boff = (size_t)kind * 256 * 2048 * 2; return true; }
};


struct EpiCmp2 {
    static constexpr bool PERM = true, HAS_MID = false, HAS_BETWEEN = false;
    unsigned char* KC;
    __device__ __forceinline__ void operator()(const Acc& acc, const pg8::Unit& u, int wr, int wc, int fr, int fq) const {
        if (wc >= 2) return;
        const int kind = u.aux, d0 = 32 * wc + 8 * fq; unsigned char* img = KC + (size_t)kind * KC_KIND_BYTES;
#pragma unroll
        for (int ai = 0; ai < 2; ++ai)
#pragma unroll
            for (int m = 0; m < 4; ++m) { const int row = u.pm * 256 + ai * 128 + wr * 64 + m * 16 + fr, tile = row >> 6, key = row & 63;
                const f32x4 v0 = acc[ai][0][m][0], v1 = acc[ai][0][m][1];
                u32x4 w; w.x = pk2(v0[0], v0[1]); w.y = pk2(v0[2], v0[3]); w.z = pk2(v1[0], v1[1]); w.w = pk2(v1[2], v1[3]);
                if (kind == 0) *(u32x4*)(img + (size_t)tile * 8192 + (d0 >> 3) * 1024 + key * 16) = w;
                else { const int k16 = key & 15, pp = 8 * ((k16 >> 2) & 1) + 4 * (k16 >> 3) + (k16 & 3); unsigned char* vq = img + (size_t)tile * 8192 + (key >> 4) * 2048 + d0 * 32 + pp * 2;
                    *(bf16_t*)(vq) = (bf16_t)w.x; *(bf16_t*)(vq + 32) = (bf16_t)(w.x >> 16); *(bf16_t*)(vq + 64) = (bf16_t)w.y; *(bf16_t*)(vq + 96) = (bf16_t)(w.y >> 16);
                    *(bf16_t*)(vq + 128) = (bf16_t)w.z; *(bf16_t*)(vq + 160) = (bf16_t)(w.z >> 16); *(bf16_t*)(vq + 192) = (bf16_t)w.w; *(bf16_t*)(vq + 224) = (bf16_t)(w.w >> 16); } }
    }
};
struct SchedCmp2 {
    int G, c, pm0, npm;
    __device__ __forceinline__ bool next(int i, pg8::Unit& u) const {
        const int L = i * G + c; if (c < 0 || L >= 2 * npm) return false;
        const int kind = L / npm, pm = pm0 + L % npm;
        u.pm = pm; u.pn = 0; u.aux = kind; u.aoff = (size_t)kind * HID_KIND_BYTES + (size_t)pm * 256 * 256 * 2; u.boff = (size_t)kind * 256 * 256 * 2; return true; }
};
struct EpiE1 {
    static constexpr bool PERM = true, HAS_MID = true, HAS_BETWEEN = false;
    const bf16_t *GR, *GB; bf16_t* OPRE;
    __device__ __forceinline__ void mid(Acc& acc, const pg8::Unit& u, int wr, int wc, int fr, int fq) const {
#pragma unroll
        for (int ai = 0; ai < 2; ++ai) {
            u32x4 gw[4][2];
#pragma unroll
            for (int m = 0; m < 4; ++m)
#pragma unroll
                for (int bj = 0; bj < 2; ++bj) { int row = u.pm * 256 + ai * 128 + wr * 64 + m * 16 + fr; row = row < MALL ? row : MALL - 1;
                    gw[m][bj] = *(const u32x4*)(GR + (size_t)row * 1024 + u.pn * 256 + bj * 128 + wc * 32 + fq * 8); }
#pragma unroll
            for (int m = 0; m < 4; ++m)
#pragma unroll
                for (int bj = 0; bj < 2; ++bj) { const u32x4 g = gw[m][bj];
                    acc[ai][bj][m][0][0] *= bflo(g.x); acc[ai][bj][m][0][1] *= bfhi(g.x); acc[ai][bj][m][0][2] *= bflo(g.y); acc[ai][bj][m][0][3] *= bfhi(g.y);
                    acc[ai][bj][m][1][0] *= bflo(g.z); acc[ai][bj][m][1][1] *= bfhi(g.z); acc[ai][bj][m][1][2] *= bflo(g.w); acc[ai][bj][m][1][3] *= bfhi(g.w); }
        }
    }
    __device__ __forceinline__ void operator()(const Acc& acc, const pg8::Unit& u, int wr, int wc, int fr, int fq) const {
#pragma unroll
        for (int ai = 0; ai < 2; ++ai) {
            u32x4 gw[4][2];
#pragma unroll
            for (int m = 0; m < 4; ++m)
#pragma unroll
                for (int bj = 0; bj < 2; ++bj) { int row = u.pm * 256 + ai * 128 + wr * 64 + m * 16 + fr; row = row < MALL ? row : MALL - 1;
                    gw[m][bj] = *(const u32x4*)(GB + (size_t)row * 1024 + u.pn * 256 + bj * 128 + wc * 32 + fq * 8); }
#pragma unroll
            for (int m = 0; m < 4; ++m) { const int row = u.pm * 256 + ai * 128 + wr * 64 + m * 16 + fr; if (row >= MALL) continue;
#pragma unroll
                for (int bj = 0; bj < 2; ++bj) { const u32x4 g = gw[m][bj]; const f32x4 v0 = acc[ai][bj][m][0], v1 = acc[ai][bj][m][1];
                    u32x4 w; w.x = pk2(v0[0] * bflo(g.x), v0[1] * bfhi(g.x)); w.y = pk2(v0[2] * bflo(g.y), v0[3] * bfhi(g.y)); w.z = pk2(v1[0] * bflo(g.z), v1[1] * bfhi(g.z)); w.w = pk2(v1[2] * bflo(g.w), v1[3] * bfhi(g.w));
                    *(u32x4*)(OPRE + (size_t)row * 1024 + u.pn * 256 + bj * 128 + wc * 32 + fq * 8) = w; } }
        }
    }
};
struct EpiE2 {
    static constexpr bool PERM = true, HAS_MID = false, HAS_BETWEEN = false;
    bf16_t* O; float* SSQP;
    __device__ __forceinline__ void operator()(const Acc& acc, const pg8::Unit& u, int wr, int wc, int fr, int fq) const {
#pragma unroll
        for (int ai = 0; ai < 2; ++ai)
#pragma unroll
            for (int m = 0; m < 4; ++m) { const int row = u.pm * 256 + ai * 128 + wr * 64 + m * 16 + fr; float s = 0.f;
#pragma unroll
                for (int bj = 0; bj < 2; ++bj) { const f32x4 v0 = acc[ai][bj][m][0], v1 = acc[ai][bj][m][1];
                    s += ((v0[0] * v0[0] + v0[1] * v0[1]) + (v0[2] * v0[2] + v0[3] * v0[3])) + ((v1[0] * v1[0] + v1[1] * v1[1]) + (v1[2] * v1[2] + v1[3] * v1[3]));
                    u32x4 w; w.x = pk2(v0[0], v0[1]); w.y = pk2(v0[2], v0[3]); w.z = pk2(v1[0], v1[1]); w.w = pk2(v1[2], v1[3]);
                    *(u32x4*)(O + (size_t)row * 1024 + u.pn * 256 + bj * 128 + wc * 32 + fq * 8) = w; }
                s += __shfl_xor(s, 16); s += __shfl_xor(s, 32);
                if (fq == 0) SSQP[(size_t)row * 16 + u.pn * 4 + wc] = s; }
    }
};
struct SchedE2 {
    int G, c;
    __device__ __forceinline__ bool next(int i, pg8::Unit& u) const {
        int pm, pn; if (!pg8::static_tile(i, G, c, 64, 4, pm, pn)) return false;
        u.pm = pm; u.pn = pn; u.aux = 0; u.aoff = (size_t)pm * 256 * 1024 * 2; u.boff = (size_t)pn * 256 * 1024 * 2; return true; }
};
struct SchedOne {
    int pm, pn;
    __device__ __forceinline__ bool next(int i, pg8::Unit& u) const {
        if (i != 0) return false;
        u.pm = pm; u.pn = pn; u.aux = 0; u.aoff = (size_t)pm * 256 * 1024 * 2; u.boff = (size_t)pn * 256 * 1024 * 2; return true; }
};
struct Frame { LAS unsigned char* lds; int tid, lane, wave, vcu, G; };

__device__ __forceinline__ float wave_sum(float v) {
#pragma unroll
    for (int o = 1; o < 64; o <<= 1) v += __shfl_xor(v, o);
    return v;
}
__device__ __forceinline__ int win_src(int v) {
    const int pn = v >> 8, w = v & 255;
    if (pn < 5) return v;
    if (pn < 7) return C_A + (v - 5 * 256);
    if (pn < 15) { const int ti = pn - 7, bj = w >> 7, wc = (w >> 5) & 3, fq = (w >> 3) & 3, e = w & 7, tsel = e >> 2, e3 = e & 3;
        const int ch = 64 * ti + 16 * wc + 4 * fq + e3, type = bj * 2 + tsel;
        return (type == 0 ? C_CB : type == 1 ? C_CG : type == 2 ? C_CC : C_CX) + ch; }
    return C_GA + ((w >> 7) ? 1024 : 0) + (pn - 15) * 128 + (w & 127);
}
template <class SrcMap>
__device__ __forceinline__ void transpose_item(const float* W, int N, bf16_t* WT, int ldt, int kcol0, LAS float* scr, int k0, int n0, int lane, const SrcMap& src) {
    const int kq = lane >> 3, n4 = (lane & 7) * 4; const int sc = src(n0 + n4);
    f32x4 v[8];
#pragma unroll
    for (int i = 0; i < 8; ++i) v[i] = *(const f32x4*)(W + (size_t)(k0 + kq + 8 * i) * N + sc);
#pragma unroll
    for (int i = 0; i < 8; ++i) { LAS float* d = scr + (kq + 8 * i) * 33 + n4; d[0] = v[i][0]; d[1] = v[i][1]; d[2] = v[i][2]; d[3] = v[i][3]; }
    asm volatile("s_waitcnt lgkmcnt(0)" ::: "memory");
    const int c = lane & 7;
#pragma unroll
    for (int j = 0; j < 4; ++j) { const int n = (lane >> 3) + 8 * j; const LAS float* s = scr + (8 * c) * 33 + n;
        u32x4 o; o.x = pk2(s[0 * 33], s[1 * 33]); o.y = pk2(s[2 * 33], s[3 * 33]); o.z = pk2(s[4 * 33], s[5 * 33]); o.w = pk2(s[6 * 33], s[7 * 33]);
        *(u32x4*)(WT + (size_t)(n0 + n) * ldt + kcol0 + k0 + 8 * c) = o; }
    asm volatile("s_waitcnt lgkmcnt(0)" ::: "memory");
}
struct IdMap { __device__ __forceinline__ int operator()(int n) const { return n; } };
struct GateMap { __device__ __forceinline__ int operator()(int n) const { return C_G + n; } };
struct WinMap { __device__ __forceinline__ int operator()(int n) const { return win_src(n); } };

template <int PASS  >
__device__ __forceinline__ void phase0(const Params& p, const Frame& F) {
    LAS float* scr = (LAS float*)(F.lds + F.wave * 16384);
    unsigned char* ws = p.ws; const int lane = F.lane;
    const int gw = F.vcu * NWAVES + F.wave, NGW = F.G * NWAVES;
    constexpr int I_PEB = 256, I_ROPE = 1024, I_WIN = 16 * 184, I_WBA = 8 * 32, I_WBB = 8 * 32, I_WOUT = 16 * 32, I_WC1 = 2 * 32 * 8, I_WC2 = 2 * 4 * 2, I_WC2Z = 2 * 24, I_WGT = 16,
                  I_CSC = 256;
    constexpr int TOTAL = I_PEB + I_ROPE + I_WIN + I_WBA + I_WBB + I_WOUT + I_WC1 + I_WC2 + I_WC2Z + I_WGT + I_CSC;
    float* mod = (float*)(ws + WS_MOD);
    if (PASS == 0)
    for (int item = F.vcu; item < 48 * 5; item += F.G) {
        const int nb = item % 48, rt = item / 48, j32 = lane & 31, h = lane >> 5, kbase = F.wave * 128;
        int arow = 32 * rt + j32; arow = arow < 130 ? arow : 129;
        const float* cr = (arow < 2 ? p.cp + (size_t)arow * 1024 : p.cs + (size_t)(arow - 2) * 1024) + kbase + 4 * h;
        const float* wb = p.w_ada + (size_t)(kbase + 4 * h) * 3072 + nb * 64 + 2 * j32;
        f32x16 acc0 = {}, acc1 = {};
#pragma unroll 4
        for (int g8 = 0; g8 < 16; ++g8) {
            const f32x4 cx = *(const f32x4*)(cr + 8 * g8);
            f32x2 bw[4];
#pragma unroll
            for (int s4 = 0; s4 < 4; ++s4) bw[s4] = *(const f32x2*)(wb + (size_t)(8 * g8 + s4) * 3072);
#pragma unroll
            for (int s4 = 0; s4 < 4; ++s4) { const float x = cx[s4]; const float a = x / (1.f + __expf(-x));
                acc0 = __builtin_amdgcn_mfma_f32_32x32x2f32(a, bw[s4][0], acc0, 0, 0, 0); acc1 = __builtin_amdgcn_mfma_f32_32x32x2f32(a, bw[s4][1], acc1, 0, 0, 0); }
        }
        LAS float* red = (LAS float*)F.lds;
        __syncthreads();
#pragma unroll
        for (int r = 0; r < 16; ++r) { red[(F.wave * 32 + r) * 64 + lane] = acc0[r]; red[(F.wave * 32 + 16 + r) * 64 + lane] = acc1[r]; }
        __syncthreads();
        for (int e = F.tid; e < 32 * 64; e += NTHR) { const int v = e >> 6, l = e & 63, ecol = v >> 4, r = v & 15;
            const int row = 32 * rt + (r & 3) + 8 * (r >> 2) + 4 * (l >> 5), col = nb * 64 + 2 * (l & 31) + ecol;
            float sum = p.b_ada[col];
#pragma unroll
            for (int w = 0; w < 8; ++w) sum += red[(w * 32 + v) * 64 + l];
            if (row < 130) mod[(size_t)row * 3072 + col] = sum; }
        __syncthreads();
    }
    static_assert(I_PEB + I_WGT <= 256 * NWAVES, "first-pass items");
    const int skipw = (F.G == 256) ? 16 : 0;
    if (PASS == 1 && F.vcu < skipw) return;
    const int gw2 = (F.vcu - skipw) * NWAVES + F.wave, NGW2 = (F.G - skipw) * NWAVES;
    for (int it = (PASS == 0 ? gw : NGW + gw2); it < (PASS == 0 ? (gw + 1 < TOTAL ? gw + 1 : TOTAL) : TOTAL); it += (PASS == 0 ? NGW : NGW2)) {
        int r = it;
        if (r < I_PEB) {
            const int kind = r >> 7, nb = (r >> 5) & 3, kc = r & 31, n = nb * 64 + lane; float s = 0.f;
            const float* pe = p.pe + kind * 2048 + kc * 64; const float* w = p.w1 + ((size_t)kind * 2048 + kc * 64) * 256 + n;
#pragma unroll
            for (int k = 0; k < 64; ++k) s += pe[k] * w[(size_t)k * 256];
            ((float*)(ws + WS_PEBP))[(kind * 32 + kc) * 256 + n] = s;
            continue;
        }
        r -= I_PEB;
        if (r < I_WGT) { transpose_item(p.w_in, INW, (bf16_t*)(ws + WS_WGT), 1024, 0, scr, 64 * r, 0, lane, GateMap()); continue; }
        r -= I_WGT;
        if (r < I_ROPE) {
            const int idx = r * 64 + lane, pos = idx >> 3, i = idx & 7;
            float inv = 1.0f; inv = i == 1 ? 0.1939227432012558f : inv; inv = i == 2 ? 0.03760603070259094f : inv; inv = i == 3 ? 0.007292664609849453f : inv; inv = i == 4 ? 0.0014142135623842478f : inv;
            inv = i == 5 ? 0.00027424818836152554f : inv; inv = i == 6 ? 5.3182957344688475e-05f : inv; inv = i == 7 ? 1.0313385246263351e-05f : inv;
            const float ang = (float)pos * inv;
            double tr = (double)ang * 0.15915494309189535; tr -= __builtin_rint(tr);
            float sn, cs; sincosf((float)(tr * 6.283185307179586), &sn, &cs);
            float* rp = (float*)(ws + WS_ROPE) + (size_t)pos * 16;
            rp[i] = cs; rp[8 + i] = sn;
            continue;
        }
        r -= I_ROPE;
        if (r < I_WIN) { transpose_item(p.w_in, INW, (bf16_t*)(ws + WS_WINT), 1024, 0, scr, 64 * (r / 184), 32 * (r % 184), lane, WinMap()); continue; }
        r -= I_WIN;
        if (r < I_WBA) { transpose_item(p.wba, 1024, (bf16_t*)(ws + WS_WBR), 1024, 0, scr, 64 * (r / 32), 32 * (r % 32), lane, IdMap()); continue; }
        r -= I_WBA;
        if (r < I_WBB) { transpose_item(p.wbb, 1024, (bf16_t*)(ws + WS_WBR), 1024, 512, scr, 64 * (r / 32), 32 * (r % 32), lane, IdMap()); continue; }
        r -= I_WBB;
        if (r < I_WOUT) { transpose_item(p.wout, 1024, (bf16_t*)(ws + WS_WOUT), 1024, 0, scr, 64 * (r / 32), 32 * (r % 32), lane, IdMap()); continue; }
        r -= I_WOUT;
        if (r < I_WC1) { const int kind = r / 256, q = r % 256; transpose_item(p.w1 + (size_t)kind * 2048 * 256, 256, (bf16_t*)(ws + WS_WC1) + (size_t)kind * 256 * 2048, 2048, 0, scr, 64 * (q / 8), 32 * (q % 8), lane, IdMap()); continue; }
        r -= I_WC1;
        if (r < I_WC2) { const int kind = r / 8, q = r % 8; transpose_item(p.w2 + (size_t)kind * 256 * 64, 64, (bf16_t*)(ws + WS_WC2) + (size_t)kind * 256 * 256, 256, 0, scr, 64 * (q / 2), 32 * (q % 2), lane, IdMap()); continue; }
        r -= I_WC2;
        if (r < I_WC2Z) { const int kind = r / 24, q = r % 24;
            u32x4* z = (u32x4*)((bf16_t*)(ws + WS_WC2) + (size_t)kind * 256 * 256 + (size_t)(64 + 8 * q) * 256);
#pragma unroll
            for (int j = 0; j < 4; ++j) z[j * 64 + lane] = (u32x4){0u, 0u, 0u, 0u};
            continue; }
        r -= I_WC2Z;
        { const int idx = r * 256 + lane * 4, bs = idx >> 9, c = idx & 511;
          *(f32x4*)(p.out + O_CSS + ((size_t)bs * 2) * 512 + c) = *(const f32x4*)(p.sconv + ((size_t)bs * 2 + 1) * 512 + c); }
    }
}

constexpr int N_WINC = (128 * 511 + 15) / 16;
__device__ __forceinline__ void wincopy_item(const Params& p, int r, int lane) {
    f32x4 v[16];
#pragma unroll
    for (int j = 0; j < 16; ++j) { const int ridx = r * 16 + j; if (ridx < 128 * 511) { const int bs = ridx / 511, jj = ridx % 511; v[j] = *(const f32x4*)(p.swin + ((size_t)bs * 512 + jj + 1) * 256 + lane * 4); } }
#pragma unroll
    for (int j = 0; j < 16; ++j) { const int ridx = r * 16 + j; if (ridx < 128 * 511) { const int bs = ridx / 511, jj = ridx % 511; *(f32x4*)(p.out + O_WINS + ((size_t)bs * 512 + jj) * 256 + lane * 4) = v[j]; } }
}
__device__ __forceinline__ float dot2bf(unsigned w, unsigned x, float acc) { typedef __bf16 bf16x2_t __attribute__((ext_vector_type(2)));
    return __builtin_amdgcn_fdot2_f32_bf16(__builtin_bit_cast(bf16x2_t, w), __builtin_bit_cast(bf16x2_t, x), acc, false); }
__device__ __forceinline__ void phase1(const Params& p, const Frame& F) {
    unsigned char* ws = p.ws; const int lane = F.lane;
    LAS unsigned* wg = (LAS unsigned*)F.lds;
    { const u32x4* src = (const u32x4*)(ws + WS_WGT);
#pragma unroll
      for (int i = 0; i < 6; ++i) ((LAS u32x4*)wg)[i * NTHR + F.tid] = src[i * NTHR + F.tid]; }
    __syncthreads();
    const int gw = F.vcu * NWAVES + F.wave, NGW = F.G * NWAVES;
    const float* mod = (const float*)(ws + WS_MOD); bf16_t* H = (bf16_t*)(ws + WS_H); float* NG = (float*)(ws + WS_NG);
    if (gw < 8) { const int kind = gw >> 2, n = (gw & 3) * 64 + lane; float s = 0.f; const float* pp = (const float*)(ws + WS_PEBP) + kind * 32 * 256 + n;
#pragma unroll
        for (int kc = 0; kc < 32; ++kc) s += pp[kc * 256];
        ((float*)(ws + WS_PEB))[kind * 256 + n] = s; }
    f32x4 vn[2][4];
#define P1_LOADX(dst, r_) do { const int r__ = (r_); if (r__ < MALL) { const float* x = r__ < MP ? p.xp + (size_t)r__ * DM : p.xs + (size_t)(r__ - MP) * DM; \
        _Pragma("unroll") for (int j = 0; j < 4; ++j) dst[j] = *(const f32x4*)(x + (j >> 1) * 512 + lane * 8 + (j & 1) * 4); } } while (0)
#pragma unroll
    for (int j = 0; j < 4; ++j) { vn[0][j] = (f32x4){0.f, 0.f, 0.f, 0.f}; vn[1][j] = vn[0][j]; }
    P1_LOADX(vn[0], gw); P1_LOADX(vn[1], gw + NGW);
    for (int row = gw; row < MALL; row += 2 * NGW) {
        const bool ok1 = row + NGW < MALL; const int rw[2] = {row, ok1 ? row + NGW : row};
        f32x4 v[2][4]; float s[2];
#pragma unroll
        for (int u = 0; u < 2; ++u) { s[u] = 0.f;
#pragma unroll
            for (int j = 0; j < 4; ++j) { v[u][j] = vn[u][j]; s[u] += (v[u][j][0] * v[u][j][0] + v[u][j][1] * v[u][j][1]) + (v[u][j][2] * v[u][j][2] + v[u][j][3] * v[u][j][3]); } }
        s[0] = wave_sum(s[0]); s[1] = wave_sum(s[1]);
        u32x4 hp[2][2];
#pragma unroll
        for (int u = 0; u < 2; ++u) { const float rs = rsqrtf(s[u] * (1.f / DM) + 1e-6f); const int r_ = rw[u];
            const float* md = mod + (size_t)(r_ < MP ? (r_ >> 13) : 2 + (r_ - MP)) * 3072;
#pragma unroll
            for (int j = 0; j < 4; ++j) { const int k = (j >> 1) * 512 + lane * 8 + (j & 1) * 4; const f32x4 gp = *(const f32x4*)(p.g_pre + k), sh = *(const f32x4*)(md + k), sc = *(const f32x4*)(md + 1024 + k);
                const f32x4 h = v[u][j] * rs * gp * (1.f + sc) + sh;
                if (j & 1) { hp[u][j >> 1].z = pk2(h[0], h[1]); hp[u][j >> 1].w = pk2(h[2], h[3]); } else { hp[u][j >> 1].x = pk2(h[0], h[1]); hp[u][j >> 1].y = pk2(h[2], h[3]); } }
            if (u == 0 || ok1) { *(u32x4*)(H + (size_t)r_ * DM + lane * 8) = hp[u][0]; *(u32x4*)(H + (size_t)r_ * DM + 512 + lane * 8) = hp[u][1]; } }
        P1_LOADX(vn[0], row + 2 * NGW); P1_LOADX(vn[1], row + 3 * NGW);
        float d[2][24];
#pragma unroll
        for (int c = 0; c < 24; ++c) { if ((c & 3) == 0) asm volatile("" ::: "memory");
            const u32x4 w0 = *(const LAS u32x4*)(wg + c * 512 + lane * 4), w1 = *(const LAS u32x4*)(wg + c * 512 + 256 + lane * 4);
#pragma unroll
            for (int u = 0; u < 2; ++u) { float a = dot2bf(w0.x, hp[u][0].x, 0.f), b = dot2bf(w1.x, hp[u][1].x, 0.f);
                a = dot2bf(w0.y, hp[u][0].y, a); b = dot2bf(w1.y, hp[u][1].y, b); a = dot2bf(w0.z, hp[u][0].z, a); b = dot2bf(w1.z, hp[u][1].z, b); a = dot2bf(w0.w, hp[u][0].w, a); b = dot2bf(w1.w, hp[u][1].w, b);
                d[u][c] = a + b; } }
        const bool b5 = lane & 32, b4 = lane & 16, b3 = lane & 8;
        float e12[2][12], e6[2][6], e3[2][3];
#pragma unroll
        for (int i = 0; i < 12; ++i)
#pragma unroll
            for (int u = 0; u < 2; ++u) { const float snd = b5 ? d[u][i] : d[u][12 + i]; const float rcv = __shfl_xor(snd, 32); e12[u][i] = (b5 ? d[u][12 + i] : d[u][i]) + rcv; }
#pragma unroll
        for (int i = 0; i < 6; ++i)
#pragma unroll
            for (int u = 0; u < 2; ++u) { const float snd = b4 ? e12[u][i] : e12[u][6 + i]; const float rcv = __shfl_xor(snd, 16); e6[u][i] = (b4 ? e12[u][6 + i] : e12[u][i]) + rcv; }
#pragma unroll
        for (int i = 0; i < 3; ++i)
#pragma unroll
            for (int u = 0; u < 2; ++u) { const float snd = b3 ? e6[u][i] : e6[u][3 + i]; const float rcv = __shfl_xor(snd, 8); e3[u][i] = (b3 ? e6[u][3 + i] : e6[u][i]) + rcv; }
#pragma unroll
        for (int i = 0; i < 3; ++i)
#pragma unroll
            for (int u = 0; u < 2; ++u) { float x = e3[u][i]; x += __shfl_xor(x, 4); x += __shfl_xor(x, 2); x += __shfl_xor(x, 1); e3[u][i] = x; }
        { const int l7 = lane & 7;
#pragma unroll
          for (int u = 0; u < 2; ++u) if (l7 < 3 && (u == 0 || ok1)) { const float gsum = l7 == 0 ? e3[u][0] : (l7 == 1 ? e3[u][1] : e3[u][2]);
            NG[(size_t)rw[u] * 32 + (b5 ? 12 : 0) + (b4 ? 6 : 0) + (b3 ? 3 : 0) + l7] = sigm(gsum); } }
    }
#undef P1_LOADX
}

__device__ __forceinline__ void cmp2_item(unsigned char* ws, int kind, int row0, int lane) {
    const bf16_t* H = (const bf16_t*)(ws + WS_HID + (size_t)kind * HID_KIND_BYTES); const bf16_t* W = (const bf16_t*)(ws + WS_WC2) + (size_t)kind * 64 * 256;
    const int r32 = lane & 31, hi = lane >> 5;
    f32x16 acc0 = {}, acc1 = {};
#pragma unroll 4
    for (int s = 0; s < 16; ++s) {
        const bf16x8 a = *(const bf16x8*)(H + (size_t)(row0 + r32) * 256 + s * 16 + hi * 8);
        const bf16x8 b0 = *(const bf16x8*)(W + (size_t)r32 * 256 + s * 16 + hi * 8), b1 = *(const bf16x8*)(W + (size_t)(32 + r32) * 256 + s * 16 + hi * 8);
        acc0 = __builtin_amdgcn_mfma_f32_32x32x16_bf16(a, b0, acc0, 0, 0, 0); acc1 = __builtin_amdgcn_mfma_f32_32x32x16_bf16(a, b1, acc1, 0, 0, 0);
    }
    unsigned char* img = ws + WS_KC + (size_t)kind * KC_KIND_BYTES;
#pragma unroll
    for (int r = 0; r < 16; ++r) { const int row = row0 + (r & 3) + 8 * (r >> 2) + 4 * hi, tile = row >> 6, key = row & 63;
#pragma unroll
        for (int h2 = 0; h2 < 2; ++h2) { const int d = r32 + 32 * h2; const float v = h2 ? acc1[r] : acc0[r];
            size_t off;
            if (kind == 0) off = (size_t)tile * 8192 + (d >> 3) * 1024 + key * 16 + (d & 7) * 2;
            else { const int k16 = key & 15; off = (size_t)tile * 8192 + (key >> 4) * 2048 + d * 32 + (8 * ((k16 >> 2) & 1) + 4 * (k16 >> 3) + (k16 & 3)) * 2; }
            *(bf16_t*)(img + off) = (bf16_t)f2bf(v); } }
}
__device__ __forceinline__ void ybin_row(const Params& p, int row, int lane) {
    unsigned char* ws = p.ws; const bf16_t* U = (const bf16_t*)(ws + WS_U); const bf16_t* CBG = (const bf16_t*)(ws + WS_CBG); bf16_t* AOY = (bf16_t*)(ws + WS_AOY);
    const int c = lane * 8;
    float u0[8], u1[8], u2[8];
    { const u32x4 w = *(const u32x4*)(U + (size_t)row * 512 + c); u2[0] = bflo(w.x); u2[1] = bfhi(w.x); u2[2] = bflo(w.y); u2[3] = bfhi(w.y); u2[4] = bflo(w.z); u2[5] = bfhi(w.z); u2[6] = bflo(w.w); u2[7] = bfhi(w.w); }
    if (row < MP) { const int t = row & (TS - 1);
        if (t >= 1) { const u32x4 w = *(const u32x4*)(U + (size_t)(row - 1) * 512 + c); u1[0] = bflo(w.x); u1[1] = bfhi(w.x); u1[2] = bflo(w.y); u1[3] = bfhi(w.y); u1[4] = bflo(w.z); u1[5] = bfhi(w.z); u1[6] = bflo(w.w); u1[7] = bfhi(w.w); }
        else {
#pragma unroll
            for (int j = 0; j < 8; ++j) u1[j] = 0.f; }
        if (t >= 2) { const u32x4 w = *(const u32x4*)(U + (size_t)(row - 2) * 512 + c); u0[0] = bflo(w.x); u0[1] = bfhi(w.x); u0[2] = bflo(w.y); u0[3] = bfhi(w.y); u0[4] = bflo(w.z); u0[5] = bfhi(w.z); u0[6] = bflo(w.w); u0[7] = bfhi(w.w); }
        else {
#pragma unroll
            for (int j = 0; j < 8; ++j) u0[j] = 0.f; }
    } else { const int bs = row - MP; const float* s0 = p.sconv + ((size_t)bs * 2) * 512 + c; const float* s1 = s0 + 512;
#pragma unroll
        for (int j = 0; j < 8; ++j) { u0[j] = s0[j]; u1[j] = s1[j]; } }
    const u32x4 wcb = *(const u32x4*)(CBG + (size_t)row * 512 + c);
    float cb[8] = {bflo(wcb.x), bfhi(wcb.x), bflo(wcb.y), bfhi(wcb.y), bflo(wcb.z), bfhi(wcb.z), bflo(wcb.w), bfhi(wcb.w)};
    float o[8];
#pragma unroll
    for (int j = 0; j < 8; ++j) o[j] = cb[j] * (p.conv_w[c + j] * u0[j] + p.conv_w[512 + c + j] * u1[j] + p.conv_w[1024 + c + j] * u2[j]);
    u32x4 w; w.x = pk2(o[0], o[1]); w.y = pk2(o[2], o[3]); w.z = pk2(o[4], o[5]); w.w = pk2(o[6], o[7]);
    *(u32x4*)(AOY + (size_t)row * 1024 + 512 + c) = w;
}
__device__ __forceinline__ void final_row(const Params& p, float* outbase, int row, int lane) {
    unsigned char* ws = p.ws; const bf16_t* O = (const bf16_t*)(ws + WS_O) + (size_t)row * 1024; const float* sq = (const float*)(ws + WS_SSQP) + (size_t)row * 16;
    float s = 0.f;
#pragma unroll
    for (int j = 0; j < 16; ++j) s += sq[j];
    const float rs = rsqrtf(s * (1.f / DM) + 1e-6f);
    const float* x = row < MP ? p.xp + (size_t)row * DM : p.xs + (size_t)(row - MP) * DM;
    float* y = row < MP ? outbase + O_YP + (size_t)row * DM : outbase + O_YS + (size_t)(row - MP) * DM;
    const float* gate = (const float*)(ws + WS_MOD) + (size_t)(row < MP ? (row >> 13) : 2 + (row - MP)) * 3072 + 2048;
#pragma unroll
    for (int j = 0; j < 4; ++j) { const int k = j * 256 + lane * 4; const u32x2 ow = *(const u32x2*)(O + k); const f32x4 xv = *(const f32x4*)(x + k), ov = {bflo(ow.x), bfhi(ow.x), bflo(ow.y), bfhi(ow.y)}, gv = *(const f32x4*)(gate + k), gp = *(const f32x4*)(p.g_post + k);
        *(f32x4*)(y + k) = xv + gv * ov * rs * gp; }
}
namespace att {
constexpr int L_K = 0, L_V = 16384, L_GS = 32768, L_LS = 65536, L_SELM = 98304, L_WSF = 99328, L_UN = 101376, L_Q = 101632, L_END = 134400;
typedef short s16x4 __attribute__((ext_vector_type(4)));
typedef LAS const unsigned char* lptr;
__device__ __forceinline__ int crow(int r, int hi) { return (r & 3) + 8 * (r >> 2) + 4 * hi; }
__device__ __forceinline__ s16x4 vtr(lptr p) { return __builtin_bit_cast(s16x4, __builtin_amdgcn_ds_read_tr16_b64_v4i16((LAS s16x4*)p)); }
__device__ __forceinline__ float half_swap_max(float m) { auto rr = __builtin_amdgcn_permlane32_swap(__float_as_uint(m), __float_as_uint(m), false, false); return fmaxf(__uint_as_float(rr[0]), __uint_as_float(rr[1])); }
__device__ __forceinline__ float half_swap_sum(float m) { auto rr = __builtin_amdgcn_permlane32_swap(__float_as_uint(m), __float_as_uint(m), false, false); return __uint_as_float(rr[0]) + __uint_as_float(rr[1]); }
__device__ __forceinline__ unsigned cvtpk(float lo, float hi) { typedef __bf16 bf16x2_t __attribute__((ext_vector_type(2))); f32x2 v = {lo, hi}; bf16x2_t b = __builtin_convertvector(v, bf16x2_t); return __builtin_bit_cast(unsigned, b); }
__device__ __forceinline__ float quad_sum(float v) { v += __shfl_xor(v, 1); v += __shfl_xor(v, 2); return v; }

struct Tile16 { u32x4 k, v; };
__device__ __forceinline__ void qkt(f32x16& p0, f32x16& p1, lptr kslot, const LAS bf16x8* qr, int r32, int hi) {
    lptr kb = kslot + hi * 1024 + r32 * 16;
    p0 = f32x16{}; p1 = f32x16{};
#pragma unroll
    for (int d0 = 0; d0 < 4; ++d0) {
        const bf16x8 b0 = *(const LAS bf16x8*)(kb + d0 * 2048), b1 = *(const LAS bf16x8*)(kb + d0 * 2048 + 512);
        const bf16x8 qf = qr[d0 * 64]; p0 = __builtin_amdgcn_mfma_f32_32x32x16_bf16(b0, qf, p0, 0, 0, 0); p1 = __builtin_amdgcn_mfma_f32_32x32x16_bf16(b1, qf, p1, 0, 0, 0);
    }
}
__device__ __forceinline__ void pv(f32x16* o, lptr vslot, const f32x16& p0, const f32x16& p1, int lane, int hi) {
    u32x4 pw[4];
    pw[0] = (u32x4){cvtpk(p0[0], p0[1]), cvtpk(p0[2], p0[3]), cvtpk(p0[4], p0[5]), cvtpk(p0[6], p0[7])};
    pw[1] = (u32x4){cvtpk(p0[8], p0[9]), cvtpk(p0[10], p0[11]), cvtpk(p0[12], p0[13]), cvtpk(p0[14], p0[15])};
    pw[2] = (u32x4){cvtpk(p1[0], p1[1]), cvtpk(p1[2], p1[3]), cvtpk(p1[4], p1[5]), cvtpk(p1[6], p1[7])};
    pw[3] = (u32x4){cvtpk(p1[8], p1[9]), cvtpk(p1[10], p1[11]), cvtpk(p1[12], p1[13]), cvtpk(p1[14], p1[15])};
    lptr vp = vslot + ((lane >> 4) & 1) * 32 + (lane & 3) * 8 + (4 * hi + ((lane & 15) >> 2)) * 64;
#pragma unroll
    for (int d0 = 0; d0 < 2; ++d0)
#pragma unroll
        for (int ks = 0; ks < 4; ++ks) {
            const s16x4 lo = vtr(vp + d0 * 4096 + ks * 1024), hh = vtr(vp + d0 * 4096 + ks * 1024 + 512);
            const bf16x8 vf = (bf16x8){lo[0], lo[1], lo[2], lo[3], hh[0], hh[1], hh[2], hh[3]};
            o[d0] = __builtin_amdgcn_mfma_f32_32x32x16_bf16(__builtin_bit_cast(bf16x8, pw[ks]), vf, o[d0], 0, 0, 0);
        }
}
__device__ __forceinline__ void mask_range(f32x16& p0, f32x16& p1, int lo, int hi_, int hi) {
    const int lo2 = lo - 4 * hi, hi2 = hi_ - 4 * hi;
#pragma unroll
    for (int r = 0; r < 16; ++r) { const int c = (r & 3) + 8 * (r >> 2);
        p0[r] = (c >= lo2 && c <= hi2) ? p0[r] : -INFINITY; p1[r] = (c + 32 >= lo2 && c + 32 <= hi2) ? p1[r] : -INFINITY; }
}
__device__ __forceinline__ void mask_rows(f32x16& p0, f32x16& p1, float bias) {
#pragma unroll
    for (int r = 0; r < 16; ++r) { p0[r] += bias; p1[r] += bias; }
}
__device__ __forceinline__ void online_step(f32x16& p0, f32x16& p1, float& m, float& l, f32x16* o, LAS float* wsf, int r32, int hi, bool en = true) {
    float rm = p0[0];
#pragma unroll
    for (int r = 1; r < 16; ++r) rm = fmaxf(rm, p0[r]);
#pragma unroll
    for (int r = 0; r < 16; ++r) rm = fmaxf(rm, p1[r]);
    rm = half_swap_max(rm);
    rm = en ? rm : -INFINITY;
    const bool need = __any(rm - m > 8.f);
    const float mn = need ? fmaxf(m, rm) : m;
    const float alpha = need ? __builtin_amdgcn_exp2f(m - mn) : 1.f;
    const float msub = en ? mn : INFINITY;
    float s = 0.f;
#pragma unroll
    for (int r = 0; r < 16; ++r) { p0[r] = __builtin_amdgcn_exp2f(p0[r] - msub); p1[r] = __builtin_amdgcn_exp2f(p1[r] - msub); s += p0[r] + p1[r]; }
    l = l * alpha + s; m = mn;
    if (need) {
        if (hi == 0) wsf[r32] = alpha;
        asm volatile("s_waitcnt lgkmcnt(0)" ::: "memory");
#pragma unroll
        for (int r = 0; r < 16; ++r) { const float a = wsf[crow(r, hi)]; o[0][r] *= a; o[1][r] *= a; }
    }
}
template <int MODE  >
__device__ __forceinline__ void accum_lds(LAS float* ot0, LAS float* ot1, const f32x16* o, float coef, LAS float* wsf, int lane, int r32, int hi) {
    if (hi == 0) wsf[32 + r32] = coef;
    asm volatile("s_waitcnt lgkmcnt(0)" ::: "memory");
#pragma unroll
    for (int r = 0; r < 16; ++r) { const float a = wsf[32 + crow(r, hi)];
        if (MODE == 0) { ot0[r * 64 + lane] = a * o[0][r]; ot1[r * 64 + lane] = a * o[1][r]; }
        else { ot0[r * 64 + lane] += a * o[0][r]; ot1[r * 64 + lane] += a * o[1][r]; } }
}
__device__ __forceinline__ unsigned pick4(unsigned a0, unsigned a1, unsigned a2, unsigned a3, int i) { unsigned r = a0; r = (i == 1) ? a1 : r; r = (i == 2) ? a2 : r; r = (i == 3) ? a3 : r; return r; }
__device__ __forceinline__ int next_bit(unsigned u0, unsigned u1, unsigned u2, unsigned u3, int j, int jmax) {
    while (j <= jmax) { const unsigned w = pick4(u0, u1, u2, u3, j >> 5) >> (j & 31); if (w) { j += __builtin_ctz(w); return j <= jmax ? j : jmax + 1; } j = (j | 31) + 1; }
    return jmax + 1;
}

__device__ __forceinline__ void loadK(bf16x8 (&kf)[8], const unsigned char* tile, unsigned koff) {
#pragma unroll
    for (int d0 = 0; d0 < 4; ++d0) { kf[2 * d0] = *(const bf16x8*)(tile + koff + d0 * 2048); kf[2 * d0 + 1] = *(const bf16x8*)(tile + koff + d0 * 2048 + 512); }
}
__device__ __forceinline__ void loadV(bf16x8 (&vf)[8], const unsigned char* tile, unsigned voff) {
#pragma unroll
    for (int d0 = 0; d0 < 2; ++d0)
#pragma unroll
        for (int ks = 0; ks < 4; ++ks) vf[d0 * 4 + ks] = *(const bf16x8*)(tile + voff + ks * 2048 + d0 * 1024);
}
__device__ __forceinline__ void qkt_reg(f32x16& p0, f32x16& p1, const bf16x8 (&kf)[8], const LAS bf16x8* qr) {
    p0 = f32x16{}; p1 = f32x16{};
    bf16x8 qf[4];
#pragma unroll
    for (int d0 = 0; d0 < 4; ++d0) qf[d0] = qr[d0 * 64];
    __builtin_amdgcn_sched_barrier(0);
#pragma unroll
    for (int d0 = 0; d0 < 4; ++d0) {
        p0 = __builtin_amdgcn_mfma_f32_32x32x16_bf16(kf[2 * d0], qf[d0], p0, 0, 0, 0); p1 = __builtin_amdgcn_mfma_f32_32x32x16_bf16(kf[2 * d0 + 1], qf[d0], p1, 0, 0, 0); }
}
__device__ __forceinline__ void pv_reg(f32x16* o, const bf16x8 (&vf)[8], const f32x16& p0, const f32x16& p1) {
    u32x4 pw[4];
    pw[0] = (u32x4){cvtpk(p0[0], p0[1]), cvtpk(p0[2], p0[3]), cvtpk(p0[4], p0[5]), cvtpk(p0[6], p0[7])};
    pw[1] = (u32x4){cvtpk(p0[8], p0[9]), cvtpk(p0[10], p0[11]), cvtpk(p0[12], p0[13]), cvtpk(p0[14], p0[15])};
    pw[2] = (u32x4){cvtpk(p1[0], p1[1]), cvtpk(p1[2], p1[3]), cvtpk(p1[4], p1[5]), cvtpk(p1[6], p1[7])};
    pw[3] = (u32x4){cvtpk(p1[8], p1[9]), cvtpk(p1[10], p1[11]), cvtpk(p1[12], p1[13]), cvtpk(p1[14], p1[15])};
#pragma unroll
    for (int d0 = 0; d0 < 2; ++d0)
#pragma unroll
        for (int ks = 0; ks < 4; ++ks) o[d0] = __builtin_amdgcn_mfma_f32_32x32x16_bf16(__builtin_bit_cast(bf16x8, pw[ks]), vf[d0 * 4 + ks], o[d0], 0, 0, 0);
}

__device__ __forceinline__ void prompt_unit(const Params& p, const Frame& F, int b, int g, int cur, int tg) {
    unsigned char* ws = p.ws; LAS unsigned char* lds = F.lds;
    const int lane = F.lane, wid = F.wave, r32 = lane & 31, hi = lane >> 5;
    const int bg = b * 2 + g, t0 = cur * 64, tokl = 8 * tg + (r32 >> 2), head = r32 & 3, t = t0 + tokl;
    const size_t grow = (size_t)b * TS + t;
    LAS float* wsf = (LAS float*)(lds + L_WSF) + wid * 64;
    LAS float* GS = (LAS float*)(lds + L_GS); LAS float* LS = (LAS float*)(lds + L_LS);
    LAS bf16x8* qr = (LAS bf16x8*)(lds + L_Q + wid * 4096) + hi * 32 + r32;
    { const bf16_t* qp = (const bf16_t*)(ws + WS_QB) + grow * 512 + (g * 4 + head) * 64 + hi * 8;
#pragma unroll
      for (int d0 = 0; d0 < 4; ++d0) qr[d0 * 64] = *(const bf16x8*)(qp + d0 * 16); }
    const float* ngp = (const float*)(ws + WS_NG) + grow * 32 + g * 12 + head * 3;
    const float g_cmp = ngp[0], g_sel = ngp[1], g_win = ngp[2];
    f32x16 o[2]; f32x16 p0, p1;
    LAS float* ot0 = GS + wid * 1024; LAS float* ot1 = LS + wid * 1024;
    const unsigned char* kc_img = ws + WS_KC + (size_t)(512 + bg * 8) * 8192;
    const unsigned char* vc_img = ws + WS_KC + KC_KIND_BYTES + (size_t)(512 + bg * 8) * 8192;
    const unsigned char* ks_img = ws + WS_KVI + (size_t)(0 * 4 + bg) * 128 * 8192;
    const unsigned char* vs_img = ws + WS_KVI + (size_t)(1 * 4 + bg) * 128 * 8192;
    const unsigned char* kw_img = ws + WS_KVI + (size_t)(2 * 4 + bg) * 128 * 8192;
    const unsigned char* vw_img = ws + WS_KVI + (size_t)(3 * 4 + bg) * 128 * 8192;
    unsigned koff = (unsigned)(hi * 1024 + r32 * 16), voff = (unsigned)(r32 * 32 + hi * 16);
    asm volatile("" : "+v"(koff), "+v"(voff));
    bf16x8 kf[8], vf[8];
    const int cmaxl = (t >= 31) ? ((t - 31) >> 4) : -1;
    const int nct = (4 * cur + 3 + 63) >> 6;
    float m = -1e30f, l = 0.f;
    loadK(kf, kc_img, koff);
#pragma unroll 1
    for (int ct = 0; ct < nct; ++ct) {
        qkt_reg(p0, p1, kf, qr);
        loadK(kf, kc_img + (size_t)(ct + 1 < nct ? ct + 1 : ct) * 8192, koff);
        mask_range(p0, p1, 0, cmaxl - 64 * ct, hi);
        float rm = p0[0];
#pragma unroll
        for (int r = 1; r < 16; ++r) rm = fmaxf(rm, p0[r]);
#pragma unroll
        for (int r = 0; r < 16; ++r) rm = fmaxf(rm, p1[r]);
        rm = half_swap_max(rm);
        const float mn = fmaxf(m, rm); float s = 0.f;
#pragma unroll
        for (int r = 0; r < 16; ++r) s += __builtin_amdgcn_exp2f(p0[r] - mn) + __builtin_amdgcn_exp2f(p1[r] - mn);
        l = l * __builtin_amdgcn_exp2f(m - mn) + s; m = mn;
    }
    l = half_swap_sum(l);
    const float linv = 1.f / fmaxf(l, 1e-30f);
    o[0] = f32x16{}; o[1] = f32x16{};
    loadK(kf, kc_img, koff);
#pragma unroll 1
    for (int ct = 0; ct < nct; ++ct) {
        loadV(vf, vc_img + (size_t)ct * 8192, voff);
        qkt_reg(p0, p1, kf, qr);
        loadK(kf, kc_img + (size_t)(ct + 1 < nct ? ct + 1 : ct) * 8192, koff);
        mask_range(p0, p1, 0, cmaxl - 64 * ct, hi);
#pragma unroll
        for (int r = 0; r < 16; ++r) { p0[r] = __builtin_amdgcn_exp2f(p0[r] - m) * linv; p1[r] = __builtin_amdgcn_exp2f(p1[r] - m) * linv; }
#pragma unroll
        for (int q = 0; q < 4; ++q) {
            const float ga = quad_sum((p0[4 * q] + p0[4 * q + 1]) + (p0[4 * q + 2] + p0[4 * q + 3])), la = quad_sum(p0[4 * q + 3]);
            const float gb = quad_sum((p1[4 * q] + p1[4 * q + 1]) + (p1[4 * q + 2] + p1[4 * q + 3])), lb = quad_sum(p1[4 * q + 3]);
            const int j = 16 * ct + 2 * q + hi;
            if (head == 0) { const int lrow = 8 * wid + (r32 >> 2); GS[lrow * 128 + j] = ga; LS[lrow * 128 + j] = la; GS[lrow * 128 + j + 8] = gb; LS[lrow * 128 + j + 8] = lb; }
        }
        pv_reg(o, vf, p0, p1);
    }
    asm volatile("s_waitcnt lgkmcnt(0)" ::: "memory");
#pragma unroll 4
    for (int i = 0; i < 16; ++i) { const int e = (8 * wid) * 128 + i * 64 + lane, j = e & 127;
        float sc; if (j == 0 || j == cur || j == cur - 1) sc = 1e6f; else if (j <= cur) sc = GS[e] + LS[e - 1]; else sc = -1.f;
        GS[e] = sc; }
    asm volatile("s_waitcnt lgkmcnt(0)" ::: "memory");
    unsigned wm0 = 0, wm1 = 0, wm2 = 0, wm3 = 0, sm0 = 0, sm1 = 0, sm2 = 0, sm3 = 0;
#pragma unroll 1
    for (int tk = 0; tk < 8; ++tk) { const int tok = 8 * wid + tk; const LAS float* sp = GS + tok * 128;
        const unsigned va = __float_as_uint(fmaxf(sp[lane], 0.f)), vb = __float_as_uint(fmaxf(sp[lane + 64], 0.f));
        unsigned T = 0;
#pragma unroll 1
        for (int bit = 30; bit >= 0; --bit) { const unsigned cand = T | (1u << bit);
            const int cnt = __builtin_popcountll(__ballot(va >= cand)) + __builtin_popcountll(__ballot(vb >= cand));
            if (cnt == 16) { T = cand - 1u; break; }
            T = cnt >= 16 ? cand : T; }
        unsigned long long ma = __ballot(va > T), mb = __ballot(vb > T);
        unsigned long long ea = __ballot(va == T), eb = __ballot(vb == T);
        int need = 16 - (__builtin_popcountll(ma) + __builtin_popcountll(mb));
#pragma unroll 1
        while (need > 0 && ea) { ma |= ea & (0ull - ea); ea &= ea - 1; --need; }
#pragma unroll 1
        while (need > 0 && eb) { mb |= eb & (0ull - eb); eb &= eb - 1; --need; }
        const unsigned a0 = (unsigned)ma, a1 = (unsigned)(ma >> 32), b0 = (unsigned)mb, b1 = (unsigned)(mb >> 32);
        if ((r32 >> 2) == tk) { sm0 = a0; sm1 = a1; sm2 = b0; sm3 = b1; }
        wm0 |= a0; wm1 |= a1; wm2 |= b0; wm3 |= b1; }
    wm0 = __builtin_amdgcn_readfirstlane(wm0); wm1 = __builtin_amdgcn_readfirstlane(wm1); wm2 = __builtin_amdgcn_readfirstlane(wm2); wm3 = __builtin_amdgcn_readfirstlane(wm3);
    asm volatile("s_waitcnt lgkmcnt(0)" ::: "memory");
    accum_lds<0>(ot0, ot1, o, g_cmp, wsf, lane, r32, hi);
    m = -1e30f; l = 0.f; o[0] = f32x16{}; o[1] = f32x16{};
    {
        int j = next_bit(wm0, wm1, wm2, wm3, 0, cur);
        if (j <= cur) loadK(kf, ks_img + (size_t)j * 8192, koff);
#pragma unroll 1
        while (j <= cur) {
            loadV(vf, vs_img + (size_t)j * 8192, voff);
            qkt_reg(p0, p1, kf, qr);
            const int jn = next_bit(wm0, wm1, wm2, wm3, j + 1, cur);
            loadK(kf, ks_img + (size_t)(jn <= cur ? jn : j) * 8192, koff);
            const bool en = (pick4(sm0, sm1, sm2, sm3, j >> 5) >> (j & 31)) & 1u;
            if (j == cur) mask_range(p0, p1, 0, tokl, hi);
            online_step(p0, p1, m, l, o, wsf, r32, hi, en);
            pv_reg(o, vf, p0, p1);
            j = jn;
        }
    }
    l = half_swap_sum(l);
    accum_lds<1>(ot0, ot1, o, g_sel / fmaxf(l, 1e-30f), wsf, lane, r32, hi);
    m = -1e30f; l = 0.f; o[0] = f32x16{}; o[1] = f32x16{};
    {
        const int j0 = cur >= 8 ? cur - 8 : 0;
        loadK(kf, kw_img + (size_t)j0 * 8192, koff);
#pragma unroll 1
        for (int j = j0; j <= cur; ++j) {
            loadV(vf, vw_img + (size_t)j * 8192, voff);
            qkt_reg(p0, p1, kf, qr);
            loadK(kf, kw_img + (size_t)(j < cur ? j + 1 : j) * 8192, koff);
            if (j == cur - 8 || j == cur) { const int lo = (j == cur - 8) ? tokl + 1 : 0, hh = (j == cur) ? tokl : 63; mask_range(p0, p1, lo, hh, hi); }
            online_step(p0, p1, m, l, o, wsf, r32, hi);
            pv_reg(o, vf, p0, p1);
        }
    }
    l = half_swap_sum(l);
    accum_lds<1>(ot0, ot1, o, g_win / fmaxf(l, 1e-30f), wsf, lane, r32, hi);
    asm volatile("s_waitcnt lgkmcnt(0)" ::: "memory");
    { const size_t rowb = (size_t)b * TS + t0 + 8 * tg + hi;
      const bf16_t* sab = (const bf16_t*)(ws + WS_SA) + rowb * 512 + g * 256 + r32; bf16_t* aob = (bf16_t*)(ws + WS_AOY) + rowb * 1024 + g * 256 + r32;
#pragma unroll
      for (int r = 0; r < 16; ++r)
#pragma unroll
        for (int d0 = 0; d0 < 2; ++d0) { const int co = (r & 3) * 64 + d0 * 32;
            aob[(2 * (r >> 2)) * 1024 + co] = (bf16_t)f2bf((d0 ? ot1 : ot0)[r * 64 + lane] * bf2f(sab[(2 * (r >> 2)) * 512 + co])); } }
}

__device__ __forceinline__ float row16_sum(float v) {
    v += __builtin_bit_cast(float, __builtin_amdgcn_update_dpp(0, __builtin_bit_cast(int, v), 0x128, 0xF, 0xF, false));
    v += __builtin_bit_cast(float, __builtin_amdgcn_update_dpp(0, __builtin_bit_cast(int, v), 0x124, 0xF, 0xF, false));
    v += __builtin_bit_cast(float, __builtin_amdgcn_update_dpp(0, __builtin_bit_cast(int, v), 0x122, 0xF, 0xF, false));
    v += __builtin_bit_cast(float, __builtin_amdgcn_update_dpp(0, __builtin_bit_cast(int, v), 0x121, 0xF, 0xF, false));
    return v; }
template <int PART  >
__device__ __forceinline__ void sample_unit(const Params& p, const Frame& F, int bs) {
    unsigned char* ws = p.ws;
    const int lane = F.lane, g = F.wave >> 2, wid = F.wave & 3, tid = F.tid & 255;
    LAS unsigned char* lds = F.lds + g * 40960;
    LAS float* q = (LAS float*)lds; LAS float* sc = (LAS float*)(lds + 1024); LAS float* impv = (LAS float*)(lds + 1024 + 4 * 1664 * 4);
    LAS int* sel = (LAS int*)(impv + 64); LAS float* osum = (LAS float*)(sel + 16);
    const size_t row = (size_t)MP + bs;
    __syncthreads();
    q[tid] = bf2f(((const bf16_t*)(ws + WS_QB))[row * 512 + g * 256 + tid]);
    __syncthreads();
    const int bg = bs * 2 + g;
    if (PART == 0) { const int c = tid & 127, hp = tid >> 7;
      float s0 = 0.f, s1 = 0.f;
      const unsigned char* img = ws + WS_KC + (size_t)(bg * 2 + (c >> 6)) * 8192; const int key = c & 63;
      u32x4 w[8];
#pragma unroll
      for (int ch = 0; ch < 8; ++ch) w[ch] = *(const u32x4*)(img + ch * 1024 + key * 16);
#pragma unroll
      for (int ch = 0; ch < 8; ++ch) { const float kf[8] = {bflo(w[ch].x), bfhi(w[ch].x), bflo(w[ch].y), bfhi(w[ch].y), bflo(w[ch].z), bfhi(w[ch].z), bflo(w[ch].w), bfhi(w[ch].w)};
#pragma unroll
          for (int e = 0; e < 8; ++e) { s0 += q[(2 * hp) * 64 + ch * 8 + e] * kf[e]; s1 += q[(2 * hp + 1) * 64 + ch * 8 + e] * kf[e]; } }
      sc[(2 * hp) * 1664 + c] = c < 127 ? s0 : -INFINITY; sc[(2 * hp + 1) * 1664 + c] = c < 127 ? s1 : -INFINITY; }
    const int kq_s = lane >> 4, d4_s = lane & 15;
    f32x4 qh[4];
#pragma unroll
    for (int h = 0; h < 4; ++h) qh[h] = *(const LAS f32x4*)(q + h * 64 + 4 * d4_s);
    if (PART == 1) {
        const float* ks = p.swin + ((size_t)bs * 512 + 1) * 256 + g * 64 + 4 * d4_s; const float* kn = p.out + O_WINS + ((size_t)bs * 512 + 511) * 256 + g * 64 + 4 * d4_s;
#pragma unroll
        for (int hb = 0; hb < 2; ++hb) { asm volatile("" ::: "memory"); f32x4 kv[16];
#pragma unroll
            for (int it = 0; it < 16; ++it) { const int i = 128 * wid + 4 * (16 * hb + it) + kq_s; kv[it] = *(const f32x4*)(i < 511 ? ks + (size_t)i * 256 : kn); }
#pragma unroll
            for (int it = 0; it < 16; ++it) { const int i = 128 * wid + 4 * (16 * hb + it) + kq_s; float sv = 0.f;
#pragma unroll
                for (int h = 0; h < 4; ++h) { const float d = row16_sum((qh[h][0] * kv[it][0] + qh[h][1] * kv[it][1]) + (qh[h][2] * kv[it][2] + qh[h][3] * kv[it][3])); sv = (d4_s == h) ? d : sv; }
                if (d4_s < 4) sc[d4_s * 1664 + 1152 + i] = sv; } }
    }
    __syncthreads();
    auto softmax_head = [&](int off, int n) {
        { LAS float* sp = sc + wid * 1664 + off; float mx = -INFINITY;
            for (int i = lane; i < n; i += 64) mx = fmaxf(mx, sp[i]);
#pragma unroll
            for (int o2 = 1; o2 < 64; o2 <<= 1) mx = fmaxf(mx, __shfl_xor(mx, o2));
            float sm = 0.f;
            for (int i = lane; i < n; i += 64) { const float e = __builtin_amdgcn_exp2f(sp[i] - mx); sp[i] = e; sm += e; }
            sm = wave_sum(sm); const float inv = 1.f / fmaxf(sm, 1e-30f);
            for (int i = lane; i < n; i += 64) sp[i] *= inv; }
        __syncthreads();
    };
    if (PART == 1) softmax_head(1152, 512);
    if (PART == 0) {
    softmax_head(0, 128);
    if (tid < 64) { float s = -1.f; const int j = tid;
        if (j < 33) { s = 0.f; for (int c = 4 * j - 1; c <= 4 * j + 3; ++c) if (c >= 0 && c < 127) s += (sc[c] + sc[1664 + c]) + (sc[2 * 1664 + c] + sc[3 * 1664 + c]);
            if (j == 0 || j == 31 || j == 32) s = 1e6f; }
        impv[j] = j < 33 ? s : -2.f; }
    __syncthreads();
    if (tid < 64) { const float sj = impv[tid]; int rk = 0; for (int i = 0; i < 33; ++i) { const float v = impv[i]; rk += (v > sj || (v == sj && i < tid)) ? 1 : 0; }
        if (tid < 33 && rk < 16) sel[rk] = tid; }
    __syncthreads();
#pragma unroll 1
    for (int rr = 0; rr < 4; ++rr) { const int r = 4 * wid + rr, j = sel[r];
        const float* kb = j < 32 ? p.cache + (((size_t)p.ptab[bs * 16 + (j >> 1)] * 128 + (j & 1) * 64) * 4 + 2) * 128 + g * 64 + 4 * d4_s : p.out + O_KVS + ((size_t)bs * 4 + 2) * 128 + g * 64 + 4 * d4_s;
        f32x4 kv[16];
#pragma unroll
        for (int it = 0; it < 16; ++it) kv[it] = *(const f32x4*)(kb + (j < 32 ? (size_t)(4 * it + kq_s) * 512 : 0));
#pragma unroll
        for (int it = 0; it < 16; ++it) { const int i = 4 * it + kq_s; float sv = 0.f;
#pragma unroll
            for (int h = 0; h < 4; ++h) { const float d = row16_sum((qh[h][0] * kv[it][0] + qh[h][1] * kv[it][1]) + (qh[h][2] * kv[it][2] + qh[h][3] * kv[it][3])); sv = (d4_s == h) ? d : sv; }
            if (d4_s < 4) sc[d4_s * 1664 + 128 + r * 64 + i] = (j < 32 || i == 0) ? sv : -INFINITY; } }
    __syncthreads();
    softmax_head(128, 1024);
    }
    const float* ngp = (const float*)(ws + WS_NG) + row * 32 + g * 12;
    const int kq = lane >> 4, d4 = lane & 15;
    f32x4 tot[4]; f32x4 br[4];
#pragma unroll
    for (int h = 0; h < 4; ++h) { tot[h] = (f32x4){0.f, 0.f, 0.f, 0.f}; br[h] = tot[h]; }
    if (PART == 0) {
#pragma unroll
    for (int it = 0; it < 8; ++it) { const int c = 32 * wid + 4 * it + kq; const unsigned char* img = ws + WS_KC + KC_KIND_BYTES + (size_t)(bg * 2 + (c >> 6)) * 8192; const int key = c & 63, d = 4 * d4;
        const int k16 = key & 15, pp = 8 * ((k16 >> 2) & 1) + 4 * (k16 >> 3) + (k16 & 3); const unsigned char* vp_ = img + (key >> 4) * 2048 + d * 32 + pp * 2;
        const f32x4 v = {bf2f(*(const bf16_t*)vp_), bf2f(*(const bf16_t*)(vp_ + 32)), bf2f(*(const bf16_t*)(vp_ + 64)), bf2f(*(const bf16_t*)(vp_ + 96))};
#pragma unroll
        for (int h = 0; h < 4; ++h) br[h] += sc[h * 1664 + c] * v; }
#pragma unroll
    for (int h = 0; h < 4; ++h) { tot[h] += ngp[h * 3] * br[h]; br[h] = (f32x4){0.f, 0.f, 0.f, 0.f}; }
    { const float* vbs[4]; int jj[4];
#pragma unroll
      for (int rr = 0; rr < 4; ++rr) { const int r = 4 * wid + rr; jj[rr] = sel[r]; const int jc = jj[rr] < 32 ? jj[rr] : 0;
          vbs[rr] = p.cache + (((size_t)p.ptab[bs * 16 + (jc >> 1)] * 128 + (jc & 1) * 64) * 4 + 3) * 128 + g * 64 + 4 * d4; }
#pragma unroll
      for (int rr = 0; rr < 4; ++rr) { const int r = 4 * wid + rr;
          asm volatile("" ::: "memory");
          if (jj[rr] < 32) {
              f32x4 v[16];
#pragma unroll
              for (int it = 0; it < 16; ++it) v[it] = *(const f32x4*)(vbs[rr] + (size_t)(4 * it + kq) * 512);
#pragma unroll
              for (int it = 0; it < 16; ++it) { const int i = 4 * it + kq;
#pragma unroll
                  for (int h = 0; h < 4; ++h) br[h] += sc[h * 1664 + 128 + r * 64 + i] * v[it]; } }
          else if (kq == 0) { const f32x4 v = *(const f32x4*)(p.out + O_KVS + ((size_t)bs * 4 + 3) * 128 + g * 64 + 4 * d4);
#pragma unroll
              for (int h = 0; h < 4; ++h) br[h] += sc[h * 1664 + 128 + r * 64] * v; } } }
#pragma unroll
    for (int h = 0; h < 4; ++h) { tot[h] += ngp[h * 3 + 1] * br[h]; br[h] = (f32x4){0.f, 0.f, 0.f, 0.f}; }
    }
    if (PART == 1) { const float* vbs = p.swin + ((size_t)bs * 512 + 1) * 256 + 128 + g * 64 + 4 * d4; const float* vbn = p.out + O_WINS + ((size_t)bs * 512 + 511) * 256 + 128 + g * 64 + 4 * d4;
#pragma unroll
      for (int hb = 0; hb < 2; ++hb) { asm volatile("" ::: "memory"); f32x4 v[16];
#pragma unroll
          for (int it = 0; it < 16; ++it) { const int i = 128 * wid + 4 * (16 * hb + it) + kq; v[it] = *(const f32x4*)(i < 511 ? vbs + (size_t)i * 256 : vbn); }
#pragma unroll
          for (int it = 0; it < 16; ++it) { const int i = 4 * (16 * hb + it) + kq;
#pragma unroll
              for (int h = 0; h < 4; ++h) br[h] += sc[h * 1664 + 1152 + 128 * wid + i] * v[it]; } } }
#pragma unroll
    for (int h = 0; h < 4; ++h) { tot[h] += ngp[h * 3 + 2] * br[h];
#pragma unroll
        for (int e = 0; e < 4; ++e) { float x = tot[h][e]; x += __shfl_xor(x, 16); x += __shfl_xor(x, 32); tot[h][e] = x; } }
    if (kq == 0) {
#pragma unroll
        for (int h = 0; h < 4; ++h) *(LAS f32x4*)(osum + (wid * 4 + h) * 64 + 4 * d4) = tot[h]; }
    __syncthreads();
    { const int h = tid >> 6, d = tid & 63; float s = 0.f;
#pragma unroll
        for (int w = 0; w < 4; ++w) s += osum[(w * 4 + h) * 64 + d];
        const int col = (g * 4 + h) * 64 + d;
        ((float*)(ws + WS_SPART))[((size_t)PART * 128 + bs) * 512 + col] = s; }
}
}
#define XB_TMO      128
#define XB_XCNT(j)  (256  + 64 * (j))
#define XB_XSUB(j)  (1280 + 64 * (j))
#define XB_XGEN(j)  (2304 + 64 * (j))
#define XB_TOP      3328
#define XB_TOPGEN   3392
#define XCD_BAR_WORDS 3456
#define XB_SPIN_CAP (1u << 22)
__device__ __forceinline__ unsigned xb_ld(unsigned* p)              { return __hip_atomic_load(p, __ATOMIC_RELAXED, __HIP_MEMORY_SCOPE_AGENT); }
__device__ __forceinline__ unsigned xb_add(unsigned* p, unsigned v) { return __hip_atomic_fetch_add(p, v, __ATOMIC_RELAXED, __HIP_MEMORY_SCOPE_AGENT); }
__device__ __forceinline__ unsigned xb_xcc_id() { return (unsigned)__builtin_amdgcn_s_getreg((3 << 11) | 20) & 0xFu; }
#define XB_SPIN(cond, bar) do { unsigned _sp = 0; while (cond) { __builtin_amdgcn_s_sleep(1); \
    if ((++_sp & 255u) == 0u) { if (xb_ld(&(bar)[XB_TMO])) break; if (_sp > XB_SPIN_CAP) { atomicAdd(&(bar)[XB_TMO], 1u); break; } } } } while (0)
struct XcdBarrier { unsigned* bar; unsigned x; volatile LAS unsigned* st; unsigned n; unsigned nloc, nx; };
__device__ __forceinline__ XcdBarrier xcd_barrier_post(unsigned* bar, volatile LAS unsigned* st) {
    XcdBarrier b; b.bar = bar; b.x = xb_xcc_id(); b.st = st; b.n = 0u; b.nloc = 0u; b.nx = 0u;
    if (threadIdx.x == 0) (void)xb_add(&bar[XB_XCNT(b.x)], 1u);
    return b;
}
__device__ __forceinline__ void xcd_barrier_complete(unsigned* bar, unsigned x, unsigned& nloc, unsigned& nx) {
    const unsigned G = gridDim.x * gridDim.y * gridDim.z;
    unsigned sum, cnt, mine, sp = 0u;
    for (;;) {
        sum = 0u; cnt = 0u; mine = 0u;
#pragma unroll
        for (unsigned j = 0; j < 16; ++j) { const unsigned c = xb_ld(&bar[XB_XCNT(j)]); sum += c; cnt += (c > 0u) ? 1u : 0u; mine = (j == x) ? c : mine; }
        if (sum == G) break;
        __builtin_amdgcn_s_sleep(1);
        if ((++sp & 255u) == 0u) { if (xb_ld(&bar[XB_TMO])) break; if (sp > XB_SPIN_CAP) { atomicAdd(&bar[XB_TMO], 1u); break; } }
    }
    nloc = mine > 0u ? mine : 1u; nx = cnt > 0u ? cnt : 1u;
}
__device__ __forceinline__ void xcd_barrier(XcdBarrier& b) {
    asm volatile("s_waitcnt vmcnt(0)" ::: "memory");
    __syncthreads();
    if (threadIdx.x == 0) {
        unsigned* bar = b.bar;
        __builtin_amdgcn_s_waitcnt(0);
        unsigned nloc = b.nloc, nx = b.nx;
        if (nloc == 0u) { xcd_barrier_complete(bar, b.x, nloc, nx); b.nloc = nloc; b.nx = nx; }
        const unsigned old = xb_add(&bar[XB_XSUB(b.x)], 1u);
        const unsigned gen = old / nloc;
        if (old + 1u == (gen + 1u) * nloc) {
            __builtin_amdgcn_fence(__ATOMIC_RELEASE, "agent");
            asm volatile("s_waitcnt vmcnt(0)" ::: "memory");
            (void)xb_add(&bar[XB_TOP], 1u);
        }
        XB_SPIN(xb_ld(&bar[XB_TOP]) < (b.n + 1u) * nx, bar);
        __builtin_amdgcn_fence(__ATOMIC_ACQUIRE, "agent");
        asm volatile("s_waitcnt vmcnt(0)" ::: "memory");
    }
    b.n += 1u;
    __syncthreads();
}
constexpr int LDS_MISC_OFF = 163584;

constexpr int LDS_BYTES = 163840;
constexpr int NPHASE = 8;

__global__ void __launch_bounds__(NTHR, 2) mk_fwd(Params p) {
    extern __shared__ __attribute__((aligned(16))) unsigned char lds_raw[];
    Frame F; F.lds = (LAS unsigned char*)lds_raw; F.tid = threadIdx.x; F.lane = F.tid & 63; F.wave = __builtin_amdgcn_readfirstlane(F.tid >> 6);
    F.G = gridDim.x; { const int bx = blockIdx.x; F.vcu = (F.G % 8 == 0) ? (bx % 8) * (F.G / 8) + bx / 8 : bx; }
    unsigned char* ws = p.ws;
    const int lo = p.ph_lo, hi = p.ph_hi;
    volatile LAS unsigned* misc = (volatile LAS unsigned*)(F.lds + LDS_MISC_OFF);
    __syncthreads();
    XcdBarrier xbar; xbar.bar = (unsigned*)(ws + WS_CTL) + 4096; xbar.x = 0; xbar.st = misc; xbar.n = 0u; xbar.nloc = 0u; xbar.nx = 0u;
    if (hi - lo > 1) { xbar = xcd_barrier_post((unsigned*)(ws + WS_CTL) + 4096, misc);
        if (F.tid == 0) { unsigned nloc_ = 0, nx_ = 0; xcd_barrier_complete(xbar.bar, xbar.x, nloc_, nx_); xbar.nloc = nloc_; xbar.nx = nx_; }
        __syncthreads(); }
#ifndef MK_PHASE_MASK
#define MK_PHASE_MASK 0xff
#endif
#define IN(k) (((MK_PHASE_MASK >> (k)) & 1) && lo <= (k) && (k) < hi)
#if defined(MK_TIMING)
    unsigned* tsw = (unsigned*)(ws + WS_CTL + (2u << 20));
#define TDONE(k) do { if (IN(k) && F.tid == 0) atomicMax(&tsw[16 + (k)], (unsigned)__builtin_amdgcn_s_memrealtime()); } while (0)
#define TSTART(k) do { if (blockIdx.x == 0 && F.tid == 0) tsw[(k)] = (unsigned)__builtin_amdgcn_s_memrealtime(); } while (0)
#else
#define TDONE(k) do { } while (0)
#define TSTART(k) do { } while (0)
#endif
#define SEAM(k) do { TDONE(k); if (IN(k) && IN((k) + 1)) { MK_GRID_SYNC(); } TSTART((k) + 1); } while (0)
#ifndef MK_GRID_SYNC
#define MK_GRID_SYNC() xcd_barrier(xbar)
#endif
#define PUBLISH(cp) do { asm volatile("s_waitcnt vmcnt(0)" ::: "memory"); __syncthreads(); \
        if (F.tid == 0) { __builtin_amdgcn_fence(__ATOMIC_RELEASE, "agent"); asm volatile("s_waitcnt vmcnt(0)" ::: "memory"); __hip_atomic_fetch_add((cp), 1u, __ATOMIC_RELAXED, __HIP_MEMORY_SCOPE_AGENT); } } while (0)
#define XPUBLISH(slot, gc) do { asm volatile("s_waitcnt vmcnt(0)" ::: "memory"); __syncthreads(); \
        if (F.tid == 0) { const unsigned nloc_ = xbar.nloc; \
            if (nloc_ == 0u) { __builtin_amdgcn_fence(__ATOMIC_RELEASE, "agent"); asm volatile("s_waitcnt vmcnt(0)" ::: "memory"); __hip_atomic_fetch_add((gc), 1u, __ATOMIC_RELAXED, __HIP_MEMORY_SCOPE_AGENT); } \
            else { unsigned* xc_ = (unsigned*)(ws + WS_CTL + 59392) + (slot) * 256 + xbar.x * 16; \
                const unsigned o_ = __hip_atomic_fetch_add(xc_, 1u, __ATOMIC_RELAXED, __HIP_MEMORY_SCOPE_AGENT); \
                if (o_ + 1u == nloc_) { __builtin_amdgcn_fence(__ATOMIC_RELEASE, "agent"); asm volatile("s_waitcnt vmcnt(0)" ::: "memory"); \
                    __hip_atomic_fetch_add((gc), nloc_, __ATOMIC_RELAXED, __HIP_MEMORY_SCOPE_AGENT); } } } } while (0)
#define AWAIT(cp, n) do { if (F.tid == 0) { unsigned sp_ = 0; while (__hip_atomic_load((cp), __ATOMIC_RELAXED, __HIP_MEMORY_SCOPE_AGENT) < (unsigned)(n)) { __builtin_amdgcn_s_sleep(2); if (++sp_ > (1u << 22)) break; } \
            __builtin_amdgcn_fence(__ATOMIC_ACQUIRE, "agent"); asm volatile("s_waitcnt vmcnt(0)" ::: "memory"); } __syncthreads(); } while (0)
    unsigned* p34 = (unsigned*)(ws + WS_CTL + 57344);
    TSTART(0);
    if (IN(0)) { phase0<0>(p, F); XPUBLISH(2, p34 + 192); phase0<1>(p, F); } TDONE(0); TSTART(1);
    if (IN(1)) { AWAIT(p34 + 192, F.G); phase1(p, F); } SEAM(1);
    if (IN(2)) {
        if (F.G != 256) { cache_span(p.cache, p.ptab, ws, (int)blockIdx.x * NWAVES + F.wave, N_CACHE_ITEMS, F.G * NWAVES, F.lane); asm volatile("s_waitcnt vmcnt(0)" ::: "memory"); __syncthreads(); }
        { pg8::Gemm g{(const bf16_t*)(ws + WS_H), (const bf16_t*)(ws + WS_WINT), 1024, 1024, 1024}; SchedMain S{F.G, (int)blockIdx.x};
          EpiMain E{p.out, (bf16_t*)(ws + WS_QB), (bf16_t*)(ws + WS_CMPA) + (size_t)32768 * 1024, (bf16_t*)(ws + WS_CMPA + CMPA_KIND_BYTES) + (size_t)32768 * 1024, (bf16_t*)(ws + WS_KVI),
                    (bf16_t*)(ws + WS_SA), (bf16_t*)(ws + WS_U), (bf16_t*)(ws + WS_CBG), (bf16_t*)(ws + WS_GA), (bf16_t*)(ws + WS_GB), (const float*)(ws + WS_ROPE), p.cache, p.ptab, ws, (int)blockIdx.x, F.G};
          pg8::gemm_phase(F.lds, g, S, E); }
#if defined(MK_SPLIT2)
    }
    if (lo <= 8 && 8 < hi) {
#else
        XPUBLISH(3, p34 + 256);
#endif
        { pg8::Gemm g{(const bf16_t*)(ws + WS_CMPA), (const bf16_t*)(ws + WS_WC1), 1024, 2048, 2048}; SchedCmp S{F.G, (int)blockIdx.x, 0, 128};
          EpiCmp1 E{(bf16_t*)(ws + WS_HID), (const float*)(ws + WS_PEB)};
          if (F.G == 256) { pg8::Unit u0; if (S.next(0, u0)) pg8::gemm_f32a_unit(F.lds, p.cache, p.ptab, g.Bt, g.ldb, u0, E); }
          else pg8::gemm_phase(F.lds, g, S, E);
          asm volatile("s_waitcnt vmcnt(0)" ::: "memory"); __syncthreads();
          { pg8::Gemm g2{(const bf16_t*)(ws + WS_HID), (const bf16_t*)(ws + WS_WC2), 256, 256, 256}; SchedCmp2 S2{F.G, (int)blockIdx.x, 0, 128};
            EpiCmp2 E2{ws + WS_KC}; pg8::gemm_phase(F.lds, g2, S2, E2); } }
        XPUBLISH(0, p34 + 128);
    }
    TDONE(2); TSTART(3);
    if (IN(3)) {
        const int c = (int)blockIdx.x;
        AWAIT(p34 + 256, F.G);
        if (c < 16) {
            pg8::Gemm g{(const bf16_t*)(ws + WS_CMPA), (const bf16_t*)(ws + WS_WC1), 1024, 2048, 2048}; SchedCmp S{F.G, c, 128, 8};
            EpiCmp1 E{(bf16_t*)(ws + WS_HID), (const float*)(ws + WS_PEB)};
            pg8::gemm_phase(F.lds, g, S, E);
            asm volatile("s_waitcnt vmcnt(0)" ::: "memory"); __syncthreads();
            { pg8::Gemm g2{(const bf16_t*)(ws + WS_HID), (const bf16_t*)(ws + WS_WC2), 256, 256, 256}; SchedCmp2 S2{F.G, c, 128, 8};
              EpiCmp2 E2{ws + WS_KC}; pg8::gemm_phase(F.lds, g2, S2, E2); }
            PUBLISH(p34);
            XPUBLISH(1, p34 + 64);
        } else {
            const int gw = (c - 16) * NWAVES + F.wave, NGW = (F.G - 16) * NWAVES;
            for (int it = gw; it < MALL; it += NGW) ybin_row(p, it, F.lane);
            if (c < 144) { AWAIT(p34 + 128, F.G); for (int u = c - 16; u < 128; u += 128) att::sample_unit<0>(p, F, u); XPUBLISH(1, p34 + 64); }
            else { for (int u = c - 144; u < 128; u += F.G - 144) att::sample_unit<1>(p, F, u);
                XPUBLISH(1, p34 + 64);
                for (int it = (c - 144) * NWAVES + F.wave; it < N_WINC; it += (F.G - 144) * NWAVES) wincopy_item(p, it, F.lane); }
        }
    }
    TDONE(3); TSTART(4);
    if (IN(4)) {
        AWAIT(p34, 16);
        if ((F.vcu % (F.G >> 2)) == 0 && F.G >= 4 && F.vcu / (F.G >> 2) < 4) {
            AWAIT(p34 + 64, F.G);
            const int pn = F.vcu / (F.G >> 2); unsigned* gcnt = (unsigned*)(ws + WS_CTL + 49152);
            for (int gi = F.tid; gi < 128 * 512; gi += NTHR) { const float* sp = (const float*)(ws + WS_SPART); const size_t row = (size_t)MP + (gi >> 9); const int col = gi & 511;
                ((bf16_t*)(ws + WS_AOY))[row * 1024 + col] = (bf16_t)f2bf((sp[gi] + sp[128 * 512 + gi]) * bf2f(((const bf16_t*)(ws + WS_SA))[row * 512 + col])); }
            asm volatile("s_waitcnt vmcnt(0)" ::: "memory"); __syncthreads();
#define GROUP4_SYNC(k) do { asm volatile("s_waitcnt vmcnt(0)" ::: "memory"); __syncthreads(); \
            if (F.tid == 0) { __builtin_amdgcn_fence(__ATOMIC_RELEASE, "agent"); asm volatile("s_waitcnt vmcnt(0)" ::: "memory"); \
                __hip_atomic_fetch_add(gcnt + 64 * (k), 1u, __ATOMIC_RELAXED, __HIP_MEMORY_SCOPE_AGENT); unsigned sp_ = 0; \
                while (__hip_atomic_load(gcnt + 64 * (k), __ATOMIC_RELAXED, __HIP_MEMORY_SCOPE_AGENT) < 4u) { __builtin_amdgcn_s_sleep(2); if (++sp_ > (1u << 22)) break; } \
                __builtin_amdgcn_fence(__ATOMIC_ACQUIRE, "agent"); asm volatile("s_waitcnt vmcnt(0)" ::: "memory"); } \
            __syncthreads(); } while (0)
            { pg8::Gemm g{(const bf16_t*)(ws + WS_AOY), (const bf16_t*)(ws + WS_WBR), 1024, 1024, 1024}; SchedOne S{64, pn};
              EpiE1 E{(const bf16_t*)(ws + WS_GA), (const bf16_t*)(ws + WS_GB), (bf16_t*)(ws + WS_OPRE)}; pg8::gemm_phase(F.lds, g, S, E); }
            GROUP4_SYNC(0);
            { pg8::Gemm g{(const bf16_t*)(ws + WS_OPRE), (const bf16_t*)(ws + WS_WOUT), 1024, 1024, 1024}; SchedOne S{64, pn};
              EpiE2 E{(bf16_t*)(ws + WS_O), (float*)(ws + WS_SSQP)}; pg8::gemm_phase(F.lds, g, S, E); }
            GROUP4_SYNC(1);
            for (int r = F.wave; r < 32; r += NWAVES) final_row(p, p.out, MP + 32 * pn + r, F.lane);
#undef GROUP4_SYNC
        }
        { const int bgi = (F.vcu * 4) / F.G; unsigned* ctr = (unsigned*)(ws + WS_CTL + 32768) + 64 * bgi;
#pragma unroll 1
          for (;;) { unsigned k = 0; if (F.lane == 0) k = __hip_atomic_fetch_add(ctr, 1u, __ATOMIC_RELAXED, __HIP_MEMORY_SCOPE_AGENT);
              k = (unsigned)__builtin_amdgcn_readfirstlane((int)k); if (k >= 1024u) break;
              att::prompt_unit(p, F, bgi >> 1, bgi & 1, 127 - (int)(k >> 3), (int)(k & 7)); } }
    }
    SEAM(4);
    if (IN(5)) { pg8::Gemm g{(const bf16_t*)(ws + WS_AOY), (const bf16_t*)(ws + WS_WBR), 1024, 1024, 1024}; SchedE2 S{F.G, (int)blockIdx.x};
        EpiE1 E{(const bf16_t*)(ws + WS_GA), (const bf16_t*)(ws + WS_GB), (bf16_t*)(ws + WS_OPRE)};
        pg8::gemm_phase(F.lds, g, S, E); }
    SEAM(5);
    if (IN(6)) { pg8::Gemm g{(const bf16_t*)(ws + WS_OPRE), (const bf16_t*)(ws + WS_WOUT), 1024, 1024, 1024}; SchedE2 S{F.G, (int)blockIdx.x};
        EpiE2 E{(bf16_t*)(ws + WS_O), (float*)(ws + WS_SSQP)};
        pg8::gemm_phase(F.lds, g, S, E); }
    SEAM(6);
    if (IN(7)) { const int gw = F.vcu * NWAVES + F.wave, NGW = F.G * NWAVES;
        for (int row = gw; row < MP; row += NGW) final_row(p, p.out, row, F.lane); }
    TDONE(7);
#undef IN
#undef SEAM
}
}

static mk::Params make_params(void* const* d_in, float* out, unsigned char* ws) {
    mk::Params p{};
    p.xp = (const float*)d_in[0]; p.xs = (const float*)d_in[1]; p.cache = (const float*)d_in[2]; p.swin = (const float*)d_in[3]; p.sconv = (const float*)d_in[4]; p.ptab = (const int*)d_in[5];
    p.cp = (const float*)d_in[6]; p.cs = (const float*)d_in[7]; p.w_ada = (const float*)d_in[8]; p.b_ada = (const float*)d_in[9]; p.g_pre = (const float*)d_in[10]; p.g_post = (const float*)d_in[11];
    p.w_in = (const float*)d_in[12]; p.pe = (const float*)d_in[13]; p.w1 = (const float*)d_in[14]; p.w2 = (const float*)d_in[15]; p.conv_w = (const float*)d_in[16];
    p.wba = (const float*)d_in[17]; p.wbb = (const float*)d_in[18]; p.wout = (const float*)d_in[19];
    p.out = out; p.ws = ws; p.ph_lo = 0; p.ph_hi = mk::NPHASE;
    return p;
}
static int mk_grid() {
    static int grid = 0;
    if (grid == 0) {
        int dev = 0, cus = 0, per_cu = 0;
        (void)hipGetDevice(&dev); (void)hipDeviceGetAttribute(&cus, hipDeviceAttributeMultiprocessorCount, dev);
        (void)hipFuncSetAttribute((const void*)mk::mk_fwd, hipFuncAttributeMaxDynamicSharedMemorySize, mk::LDS_BYTES);
        (void)hipOccupancyMaxActiveBlocksPerMultiprocessor(&per_cu, (const void*)mk::mk_fwd, mk::NTHR, mk::LDS_BYTES);
        if (per_cu < 1) { fprintf(stderr, "mk: occupancy query says %d blocks per CU\n", per_cu); per_cu = 1; }
        grid = cus;
        (void)hipGetLastError();
    }
    return grid;
}
static void mk_launch(mk::Params p, int lo, int hi, hipStream_t stream) {
    p.ph_lo = lo; p.ph_hi = hi; const int grid = mk_grid();
    if (hi - lo > 1) { void* args[] = {&p}; hipError_t e = hipLaunchCooperativeKernel((const void*)mk::mk_fwd, dim3(grid), dim3(mk::NTHR), args, mk::LDS_BYTES, stream);
        if (e != hipSuccess) fprintf(stderr, "cooperative launch failed: %s (grid %d)\n", hipGetErrorString(e), grid); }
    else hipLaunchKernelGGL(mk::mk_fwd, dim3(grid), dim3(mk::NTHR), mk::LDS_BYTES, stream, p);
}
extern "C" void kernel_launch(void* const* d_in, const int* in_sizes, int n_in, void* d_out, int out_size, void* d_ws, size_t ws_size, hipStream_t stream) {
    (void)in_sizes; (void)n_in; (void)out_size; (void)ws_size;
    (void)hipMemsetAsync((unsigned char*)d_ws + mk::WS_CTL, 0, 65536, stream);
    mk::Params p = make_params(d_in, (float*)d_out, (unsigned char*)d_ws);
#if defined(MK_MULTI_LAUNCH)
    for (int ph = 0; ph < mk::NPHASE; ++ph) mk_launch(p, ph, ph + 1, stream);
#else
    mk_launch(p, 0, mk::NPHASE, stream);
#endif
}
```
